# Optimizing an MI355X kernel written in HIP

```python
import math
import jax, jax.numpy as jnp
from jax import lax
import numpy as np

D_MODEL = 2048
BATCH = 4
SEQ = 2048
DEPTH = 1

MIX_WIDTH = D_MODEL
MLA_V = 128
MLA_HEADS = (MIX_WIDTH // 2) // MLA_V
MLA_NOPE = 128
MLA_ROPE = 64
MLA_QK = MLA_NOPE + MLA_ROPE
Q_LORA = D_MODEL // 4
KV_LORA = D_MODEL // 4
DIFF_V = 128
DIFF_HEADS = (MIX_WIDTH - MLA_HEADS * MLA_V) // DIFF_V
DIFF_QK = 64
DIFF_ROT = DIFF_QK // 4
ROPE_THETA = 500000.0
D_FF = -(-8 * D_MODEL // (3 * 256)) * 256
Q_BLOCK = 128
EPS = 1e-6

IN_SPLITS = (Q_LORA, KV_LORA, MLA_ROPE,
             DIFF_HEADS * 2 * DIFF_QK, DIFF_HEADS * 2 * DIFF_QK, DIFF_HEADS * DIFF_V)
IN_COLS = sum(IN_SPLITS)

kernel_name = "hybrid_mla_diffattn_parallel_heads"


def rmsnorm(x, g):
    xf = x.astype(jnp.float32)
    y = xf * lax.rsqrt(jnp.mean(xf * xf, axis=-1, keepdims=True) + EPS)
    return (y * g.astype(jnp.float32)).astype(x.dtype)


def rope(x, pos):
    r = x.shape[-1]
    half = r // 2
    freqs = 1.0 / (ROPE_THETA ** (jnp.arange(0, r, 2, dtype=jnp.float32) / r))
    ang = pos.astype(jnp.float32)[:, None] * freqs[None, :]
    extra = x.ndim - 3
    ang = ang.reshape((1, ang.shape[0]) + (1,) * extra + (half,))
    cos, sin = jnp.cos(ang), jnp.sin(ang)
    xf = x.astype(jnp.float32)
    x1, x2 = xf[..., :half], xf[..., half:]
    out = jnp.concatenate([x1 * cos - x2 * sin, x2 * cos + x1 * sin], axis=-1)
    return out.astype(x.dtype)


def causal_mask(i, seq):
    qpos = i * Q_BLOCK + jnp.arange(Q_BLOCK)
    return jnp.arange(seq)[None, :] <= qpos[:, None]


def mla_attend(q, k, v):
    B, H, S, D = q.shape
    nb = S // Q_BLOCK
    scale = 1.0 / math.sqrt(D)
    qb = q.reshape(B, H, nb, Q_BLOCK, D).transpose(2, 0, 1, 3, 4)

    def one_block(args):
        qi, i = args
        s = jnp.einsum('bhqd,bhkd->bhqk', qi, k).astype(jnp.float32) * scale
        s = jnp.where(causal_mask(i, S)[None, None], s, -jnp.inf)
        p = jax.nn.softmax(s, axis=-1)
        return jnp.einsum('bhqk,bhkd->bhqd', p.astype(v.dtype), v)

    out = lax.map(one_block, (qb, jnp.arange(nb)))
    return out.transpose(1, 0, 3, 2, 4).reshape(B, S, H, v.shape[-1])


def diff_attend(q, k, v, lam):
    B, H, _, S, D = q.shape
    nb = S // Q_BLOCK
    scale = 1.0 / math.sqrt(D)
    qb = q.reshape(B, H, 2, nb, Q_BLOCK, D).transpose(3, 0, 1, 2, 4, 5)

    def one_block(args):
        qi, i = args
        s = jnp.einsum('bhcqd,bhckd->bhcqk', qi, k).astype(jnp.float32) * scale
        s = jnp.where(causal_mask(i, S)[None, None, None], s, -jnp.inf)
        p = jax.nn.softmax(s, axis=-1)
        a = p[:, :, 0] - lam * p[:, :, 1]
        return jnp.einsum('bhqk,bhkd->bhqd', a.astype(v.dtype), v)

    out = lax.map(one_block, (qb, jnp.arange(nb)))
    return out.transpose(1, 0, 3, 2, 4).reshape(B, S, H, v.shape[-1])


def setup_inputs(seed: int = 0) -> dict:
    key = jax.random.key(seed)
    ks = jax.random.split(key, 24)
    f = jnp.float32

    def nrm(k, shape, fan_in):
        return jax.random.normal(k, shape, f) * (fan_in ** -0.5)

    def gain(k, n):
        return 1.0 + 0.02 * jax.random.normal(k, (DEPTH, n), f)

    return {
        "x": jax.random.normal(ks[0], (BATCH, SEQ, D_MODEL), f),
        "attn_norm": gain(ks[1], D_MODEL),
        "w_in": nrm(ks[2], (DEPTH, D_MODEL, IN_COLS), D_MODEL),
        "q_latent_norm": gain(ks[3], Q_LORA),
        "w_q_up": nrm(ks[4], (DEPTH, Q_LORA, MLA_HEADS * MLA_QK), Q_LORA),
        "kv_latent_norm": gain(ks[5], KV_LORA),
        "w_kv_up": nrm(ks[6], (DEPTH, KV_LORA, MLA_HEADS * (MLA_NOPE + MLA_V)), KV_LORA),
        "mla_q_norm": gain(ks[7], MLA_QK),
        "mla_k_norm": gain(ks[8], MLA_QK),
        "mla_out_norm": gain(ks[9], MLA_V),
        "diff_q_norm": gain(ks[10], DIFF_QK),
        "diff_k_norm": gain(ks[11], DIFF_QK),
        "lambda_q1": 0.1 * jax.random.normal(ks[12], (DEPTH, DIFF_QK), f),
        "lambda_k1": 0.1 * jax.random.normal(ks[13], (DEPTH, DIFF_QK), f),
        "lambda_q2": 0.1 * jax.random.normal(ks[14], (DEPTH, DIFF_QK), f),
        "lambda_k2": 0.1 * jax.random.normal(ks[15], (DEPTH, DIFF_QK), f),
        "diff_out_norm": gain(ks[16], DIFF_V),
        "w_o": nrm(ks[17], (DEPTH, MIX_WIDTH, D_MODEL), MIX_WIDTH),
        "ffn_norm": gain(ks[18], D_MODEL),
        "w_gate": nrm(ks[19], (DEPTH, D_MODEL, D_FF), D_MODEL),
        "w_up": nrm(ks[20], (DEPTH, D_MODEL, D_FF), D_MODEL),
        "w_down": nrm(ks[21], (DEPTH, D_FF, D_MODEL), D_FF),
    }


def reference(x, attn_norm, w_in, q_latent_norm, w_q_up, kv_latent_norm, w_kv_up,
              mla_q_norm, mla_k_norm, mla_out_norm, diff_q_norm, diff_k_norm,
              lambda_q1, lambda_k1, lambda_q2, lambda_k2, diff_out_norm, w_o,
              ffn_norm, w_gate, w_up, w_down):
    B, S, _ = x.shape
    pos = jnp.arange(S, dtype=jnp.int32)
    offs = list(np.cumsum(IN_SPLITS)[:-1])

    for l in range(DEPTH):
        lambda_init = 0.8 - 0.6 * math.exp(-0.3 * l)

        h = rmsnorm(x, attn_norm[l])
        proj = h @ w_in[l]
        c_q, c_kv, k_pe, dq, dk, dv = jnp.split(proj, offs, axis=-1)

        q = (rmsnorm(c_q, q_latent_norm[l]) @ w_q_up[l]).reshape(B, S, MLA_HEADS, MLA_QK)
        kv = (rmsnorm(c_kv, kv_latent_norm[l]) @ w_kv_up[l]).reshape(
            B, S, MLA_HEADS, MLA_NOPE + MLA_V)
        k_nope, v_mla = kv[..., :MLA_NOPE], kv[..., MLA_NOPE:]
        k_pe = jnp.broadcast_to(k_pe[:, :, None, :], (B, S, MLA_HEADS, MLA_ROPE))
        k = jnp.concatenate([k_nope, k_pe], axis=-1)
        q = rmsnorm(q, mla_q_norm[l])
        k = rmsnorm(k, mla_k_norm[l])
        q = jnp.concatenate([q[..., :MLA_NOPE], rope(q[..., MLA_NOPE:], pos)], axis=-1)
        k = jnp.concatenate([k[..., :MLA_NOPE], rope(k[..., MLA_NOPE:], pos)], axis=-1)
        o_mla = mla_attend(q.transpose(0, 2, 1, 3), k.transpose(0, 2, 1, 3),
                           v_mla.transpose(0, 2, 1, 3))
        o_mla = rmsnorm(o_mla, mla_out_norm[l]).reshape(B, S, MLA_HEADS * MLA_V)

        dq = rmsnorm(dq.reshape(B, S, DIFF_HEADS, 2, DIFF_QK), diff_q_norm[l])
        dk = rmsnorm(dk.reshape(B, S, DIFF_HEADS, 2, DIFF_QK), diff_k_norm[l])
        dq = jnp.concatenate([rope(dq[..., :DIFF_ROT], pos), dq[..., DIFF_ROT:]], axis=-1)
        dk = jnp.concatenate([rope(dk[..., :DIFF_ROT], pos), dk[..., DIFF_ROT:]], axis=-1)
        lam = (jnp.exp(jnp.sum(lambda_q1[l].astype(jnp.float32) * lambda_k1[l].astype(jnp.float32)))
               - jnp.exp(jnp.sum(lambda_q2[l].astype(jnp.float32) * lambda_k2[l].astype(jnp.float32)))
               + lambda_init)
        dv = dv.reshape(B, S, DIFF_HEADS, DIFF_V).transpose(0, 2, 1, 3)
        o_diff = diff_attend(dq.transpose(0, 2, 3, 1, 4), dk.transpose(0, 2, 3, 1, 4), dv, lam)
        o_diff = (rmsnorm(o_diff, diff_out_norm[l]) * (1.0 - lambda_init)).astype(x.dtype)
        o_diff = o_diff.reshape(B, S, DIFF_HEADS * DIFF_V)

        x = x + jnp.concatenate([o_mla, o_diff], axis=-1) @ w_o[l]

        h = rmsnorm(x, ffn_norm[l])
        x = x + (jax.nn.silu(h @ w_gate[l]) * (h @ w_up[l])) @ w_down[l]

    return x
```

```cpp
#include <hip/hip_runtime.h>
#include <hip/hip_cooperative_groups.h>
#include <cstdio>
#include <cstdint>
namespace cg = cooperative_groups;
namespace pg8 {
#define PG8_LAS __attribute__((address_space(3)))
typedef unsigned short bf16_t;
typedef short bf16x8 __attribute__((ext_vector_type(8)));
typedef float f32x4 __attribute__((ext_vector_type(4)));
typedef unsigned u32x4 __attribute__((ext_vector_type(4)));
constexpr int BM = 256, BK = 64, HALF = 128, HTB = HALF * BK * 2  , STAGE_BYTES = 8 * HTB, NXCD = 8, WGM = 8;

__host__ __device__ __forceinline__ int lds_byte(int r, int c) { const int st = (r >> 4) * 2 + (c >> 5), rr = r & 15, cc = c & 31, ob = rr * 64 + cc * 2; return st * 1024 + (ob ^ (((ob >> 9) & 1) << 5)); }
__host__ __device__ __forceinline__ void stage_rc(int b, int& R, int& C) { const int st = b / 1024, sb = b % 1024, swz = sb ^ (((sb >> 9) & 1) << 5); R = (st >> 1) * 16 + swz / 64; C = (st & 1) * 32 + (swz % 64) / 2; }
__host__ __device__ __forceinline__ int perm32(int rho) { const int n = rho >> 4, i = rho & 15; return 8 * (i >> 2) + 4 * n + (i & 3); }

struct Unit { int pm, pn; };
struct Gemm { const bf16_t* A; const bf16_t* Bt; int M, N, K; };

struct StaticOrder {
    int nM, nN, nwg, G, c;
    __host__ __device__ void init(int M, int N, int G_, int c_) { nM = M / BM; nN = N / BM; nwg = nM * nN; G = G_; c = c_; }
    __host__ __device__ bool next(int i, Unit& u) const {
        const long L = (long)i * G + c; if (L >= nwg) return false;
        int wgid = (int)L; { const int q = nwg / NXCD, r = nwg % NXCD, xcd = wgid % NXCD, off = wgid / NXCD; wgid = (xcd < r ? xcd * (q + 1) : r * (q + 1) + (xcd - r) * q) + off; }
        const int nig = WGM * nN, gid = wgid / nig, fm = gid * WGM, gsz = (nM - fm) < WGM ? (nM - fm) : WGM;
        u.pm = fm + ((wgid % nig) % gsz); u.pn = (wgid % nig) / gsz; return true;
    }
    __device__ __forceinline__ void a_ready(const Unit&) const {}
    __device__ __forceinline__ void done(const Unit&) const {}
};

__device__ __forceinline__ unsigned cvt_pk_bf16(float lo, float hi) { unsigned r; asm volatile("v_cvt_pk_bf16_f32 %0, %1, %2" : "=v"(r) : "v"(lo), "v"(hi)); return r; }
typedef float f32x2 __attribute__((ext_vector_type(2)));
template <class Epi, class Sched, bool ALIGN_EPI = false, bool SP2 = false>
__device__ __forceinline__ void gemm_phase(PG8_LAS unsigned char* lds, const Gemm g, const Sched& S, const Epi& E) {
    const int tid = threadIdx.x, wid = __builtin_amdgcn_readfirstlane(tid >> 6), lane = tid & 63, wr = wid >> 2, wc = wid & 3, fr = lane & 15, fq = lane >> 4;
    const int K = g.K, nt = K / BK;
    unsigned voffA[2], voffB[2];
#pragma unroll
    for (int i = 0; i < 2; ++i) { int R, C; stage_rc(tid * 16 + i * 8192, R, C); const int Rb = Epi::PERM ? ((R & ~31) + perm32(R & 31)) : R;
        voffA[i] = (unsigned)(R * K + C) * 2u; voffB[i] = (unsigned)(Rb * K + C) * 2u; }
    const size_t kstep = (size_t)(BK * 2);
    const size_t hstep = (size_t)HALF * K * 2;
    const size_t tstep = 2 * hstep;
    const unsigned ldsw = (unsigned)wid * 1024u;
    const int aoff = lds_byte(wr * 64 + fr, fq * 8), boff = lds_byte(wc * 32 + fr, fq * 8);
#define PG8_SA(b, h) (((b) * 2 + (h)) * HTB)
#define PG8_SB(b, h) ((4 + (b) * 2 + (h)) * HTB)
#define PG8_STAGE(bufoff, gbase, voff) do { _Pragma("unroll") for (int _i = 0; _i < 2; ++_i) \
        __builtin_amdgcn_global_load_lds((const unsigned*)((const char*)(gbase) + (voff)[_i]), (PG8_LAS unsigned*)(lds + (bufoff) + ldsw + _i * 8192), 16, 0, 0); } while (0)
#define PG8_LDA(dst, b, h) do { _Pragma("unroll") for (int m = 0; m < 4; ++m) _Pragma("unroll") for (int k = 0; k < 2; ++k) dst[m][k] = *(const PG8_LAS bf16x8*)(lds + PG8_SA(b, h) + aoff + m * 2048 + k * 1024); } while (0)
#define PG8_LDB(dst, b, h) do { _Pragma("unroll") for (int n = 0; n < 2; ++n) _Pragma("unroll") for (int k = 0; k < 2; ++k) dst[n][k] = *(const PG8_LAS bf16x8*)(lds + PG8_SB(b, h) + boff + n * 2048 + k * 1024); } while (0)
#define PG8_MMA(ai, bj, At, Bt) do { __builtin_amdgcn_s_setprio(1); _Pragma("unroll") for (int m = 0; m < 4; ++m) _Pragma("unroll") for (int n = 0; n < 2; ++n) _Pragma("unroll") for (int k = 0; k < 2; ++k) \
        acc[ai][bj][m][n] = __builtin_amdgcn_mfma_f32_16x16x32_bf16(Bt[n][k], At[m][k], acc[ai][bj][m][n], 0, 0, 0); __builtin_amdgcn_s_setprio(0); } while (0)
#define PG8_WAIT_V(n) asm volatile("s_waitcnt vmcnt(" #n ")" ::: "memory")
#define PG8_WAIT_L(n) asm volatile("s_waitcnt lgkmcnt(" #n ")" ::: "memory")
#define PG8_BAR __builtin_amdgcn_s_barrier()
#define PG8_SCHED __builtin_amdgcn_sched_barrier(0)
    Unit cur, nxt; int ui = 0;
    if (!S.next(0, cur)) return;
    f32x4 acc[2][2][4][2];
#pragma unroll
    for (int a = 0; a < 2; ++a)
#pragma unroll
        for (int b = 0; b < 2; ++b)
#pragma unroll
            for (int m = 0; m < 4; ++m)
#pragma unroll
                for (int n = 0; n < 2; ++n) acc[a][b][m][n] = (f32x4){0.f, 0.f, 0.f, 0.f};
    bf16x8 At[4][2], B0[2][2], B1[2][2];
    const char* cA = (const char*)g.A + (size_t)cur.pm * tstep; const char* cB = (const char*)g.Bt + (size_t)cur.pn * tstep;
    S.a_ready(cur);
    if constexpr (SP2) {
        PG8_STAGE(PG8_SB(0, 0), cB, voffB); PG8_STAGE(PG8_SB(0, 1), cB + hstep, voffB); PG8_STAGE(PG8_SA(0, 0), cA, voffA); PG8_STAGE(PG8_SA(0, 1), cA + hstep, voffA);
        if (wr == 1) PG8_BAR;
        PG8_WAIT_V(2); PG8_BAR;
        PG8_STAGE(PG8_SB(1, 0), cB + kstep, voffB); PG8_STAGE(PG8_SA(1, 0), cA + kstep, voffA); PG8_STAGE(PG8_SB(1, 1), cB + hstep + kstep, voffB);
        PG8_WAIT_V(6); PG8_BAR;
    } else {
        PG8_STAGE(PG8_SB(0, 0), cB, voffB); PG8_STAGE(PG8_SA(0, 0), cA, voffA); PG8_STAGE(PG8_SB(0, 1), cB + hstep, voffB); PG8_STAGE(PG8_SA(0, 1), cA + hstep, voffA);
        if (wr == 1) PG8_BAR;
        PG8_WAIT_V(4); PG8_BAR;
        PG8_STAGE(PG8_SB(1, 0), cB + kstep, voffB); PG8_STAGE(PG8_SA(1, 0), cA + kstep, voffA); PG8_STAGE(PG8_SB(1, 1), cB + hstep + kstep, voffB);
        PG8_WAIT_V(6); PG8_BAR;
    }
    for (;;) {
        const bool has_next = S.next(ui + 1, nxt);
        const char* nA = has_next ? (const char*)g.A + (size_t)nxt.pm * tstep : cA; const char* nB = has_next ? (const char*)g.Bt + (size_t)nxt.pn * tstep : cB;
        for (int t = 0; t < nt; t += 2) {
            const bool last = (t == nt - 2);
            const char* a1 = cA + (size_t)(t + 1) * kstep;
            const char* a2 = last ? nA : cA + (size_t)(t + 2) * kstep; const char* b2 = last ? nB : cB + (size_t)(t + 2) * kstep;
            const char* a3 = a2 + kstep; const char* b3 = b2 + kstep;
            if (last && has_next) S.a_ready(nxt);
            if constexpr (SP2) {
            PG8_LDB(B0, 0, 0); PG8_LDB(B1, 0, 1); PG8_SCHED; PG8_LDA(At, 0, 0); PG8_STAGE(PG8_SA(1, 1), a1 + hstep, voffA);
            PG8_WAIT_V(8); PG8_WAIT_L(0); PG8_BAR; PG8_MMA(0, 0, At, B0); PG8_MMA(0, 1, At, B1); PG8_BAR; PG8_SCHED;
            PG8_LDA(At, 0, 1); PG8_STAGE(PG8_SB(0, 0), b2, voffB); PG8_STAGE(PG8_SB(0, 1), b2 + hstep, voffB); PG8_STAGE(PG8_SA(0, 0), a2, voffA);
            PG8_WAIT_V(8); PG8_WAIT_L(0); PG8_BAR; PG8_MMA(1, 0, At, B0); PG8_MMA(1, 1, At, B1); PG8_BAR; PG8_SCHED;
            PG8_LDB(B0, 1, 0); PG8_LDB(B1, 1, 1); PG8_SCHED; PG8_LDA(At, 1, 0); PG8_STAGE(PG8_SA(0, 1), a2 + hstep, voffA);
            PG8_WAIT_V(8); PG8_WAIT_L(0); PG8_BAR; PG8_MMA(0, 0, At, B0); PG8_MMA(0, 1, At, B1); PG8_BAR; PG8_SCHED;
            PG8_LDA(At, 1, 1); PG8_STAGE(PG8_SB(1, 0), b3, voffB); PG8_STAGE(PG8_SB(1, 1), b3 + hstep, voffB); PG8_STAGE(PG8_SA(1, 0), a3, voffA);
            PG8_WAIT_V(8); PG8_WAIT_L(0); PG8_BAR; PG8_MMA(1, 0, At, B0); PG8_MMA(1, 1, At, B1); PG8_BAR; PG8_SCHED;
            } else {
            PG8_LDB(B0, 0, 0); PG8_SCHED; PG8_LDA(At, 0, 0); PG8_STAGE(PG8_SA(1, 1), a1 + hstep, voffA);
            PG8_WAIT_L(8); PG8_BAR; PG8_WAIT_L(0); PG8_MMA(0, 0, At, B0); PG8_BAR; PG8_SCHED;
            PG8_LDB(B1, 0, 1); PG8_STAGE(PG8_SB(0, 0), b2, voffB);
            PG8_BAR; PG8_WAIT_L(0); PG8_MMA(0, 1, At, B1); PG8_BAR;
            PG8_LDA(At, 0, 1); PG8_STAGE(PG8_SA(0, 0), a2, voffA);
            PG8_BAR; PG8_WAIT_L(0); PG8_MMA(1, 0, At, B0); PG8_BAR; PG8_SCHED;
            PG8_STAGE(PG8_SB(0, 1), b2 + hstep, voffB);
            PG8_WAIT_V(6); PG8_BAR; PG8_MMA(1, 1, At, B1); PG8_BAR;
            PG8_LDB(B0, 1, 0); PG8_SCHED; PG8_LDA(At, 1, 0); PG8_STAGE(PG8_SA(0, 1), a2 + hstep, voffA);
            PG8_WAIT_L(8); PG8_BAR; PG8_WAIT_L(0); PG8_MMA(0, 0, At, B0); PG8_BAR; PG8_SCHED;
            PG8_LDB(B1, 1, 1); PG8_STAGE(PG8_SB(1, 0), b3, voffB);
            PG8_BAR; PG8_WAIT_L(0); PG8_MMA(0, 1, At, B1); PG8_BAR;
            PG8_LDA(At, 1, 1); PG8_STAGE(PG8_SA(1, 0), a3, voffA);
            PG8_BAR; PG8_WAIT_L(0); PG8_MMA(1, 0, At, B0); PG8_BAR; PG8_SCHED;
            PG8_STAGE(PG8_SB(1, 1), b3 + hstep, voffB);
            PG8_WAIT_V(6); PG8_BAR; PG8_MMA(1, 1, At, B1); PG8_BAR;
            }
        }
        if constexpr (ALIGN_EPI) { if (wr == 0) PG8_BAR; }
        if constexpr (!Epi::AFTER_DRAIN) { E(acc, cur, wr, wc, fr, fq); S.done(cur); }
        if (!has_next) break;
#pragma unroll
        for (int a = 0; a < 2; ++a)
#pragma unroll
            for (int b = 0; b < 2; ++b)
#pragma unroll
                for (int m = 0; m < 4; ++m)
#pragma unroll
                    for (int n = 0; n < 2; ++n) acc[a][b][m][n] = (f32x4){0.f, 0.f, 0.f, 0.f};
        cur = nxt; cA = nA; cB = nB; ++ui;
        if constexpr (ALIGN_EPI) { if (wr == 1) PG8_BAR; }
    }
    PG8_WAIT_V(0);
    if constexpr (!ALIGN_EPI) { if (wr == 0) PG8_BAR; }
    PG8_BAR;
    if constexpr (Epi::AFTER_DRAIN) { E.fused(acc, cur, wr, wc, fr, fq, lds, wid, lane); S.done(cur); }
#undef PG8_SA
#undef PG8_SB
#undef PG8_STAGE
#undef PG8_LDA
#undef PG8_LDB
#undef PG8_MMA
#undef PG8_WAIT_V
#undef PG8_WAIT_L
#undef PG8_BAR
#undef PG8_SCHED
}
}

#ifndef PROBE_REP
#define PROBE_REP -1
#endif
#ifndef MK_ONE_LAUNCH
#define MK_ONE_LAUNCH 1
#endif

namespace mk {
#define LAS __attribute__((address_space(3)))
typedef unsigned short bf16_t;
typedef short bf16x8 __attribute__((ext_vector_type(8)));
typedef float f32x4 __attribute__((ext_vector_type(4)));
typedef float f32x16 __attribute__((ext_vector_type(16)));
typedef unsigned u32x4 __attribute__((ext_vector_type(4)));
typedef unsigned u32x2 __attribute__((ext_vector_type(2)));
using pg8::Unit;
using pg8::cvt_pk_bf16;

constexpr int NWAVES = 8, NTHR = 512;
constexpr int M = 8192, DM = 2048, SEQ = 2048;
constexpr int NPROJ = 4096, PROJ_LD = 2048, DFF = 5632;
constexpr float EPS = 1e-6f;
constexpr float LOG2E = 1.4426950408889634f;
constexpr float LOG2_THETA = 18.931568569324174f;
constexpr float LAMBDA_INIT = 0.2f;

constexpr size_t MiB = 1u << 20;
constexpr size_t WS_CTL = 0;
constexpr size_t WS_WIN = 1 * MiB, WS_WQ = 18 * MiB, WS_WKV = 20 * MiB, WS_WO = 22 * MiB, WS_WGU = 30 * MiB, WS_WD = 74 * MiB;
constexpr size_t WS_VTM = 1 * MiB;
constexpr size_t WS_VTD = 74 * MiB;
constexpr size_t WS_HB = 96 * MiB, WS_PROJ = 128 * MiB, WS_QLAT = 160 * MiB, WS_KVLAT = 168 * MiB, WS_SSQL = 176 * MiB, WS_KPE = 177 * MiB;
constexpr size_t WS_QF = 178 * MiB, WS_KNOPE = 202 * MiB, WS_QD = 218 * MiB, WS_KD = 234 * MiB;
constexpr size_t WS_QM = 96 * MiB, WS_KM = 120 * MiB, WS_AO = 144 * MiB, WS_X1B = 96 * MiB, WS_SSQ = 128 * MiB, WS_HMID = 130 * MiB;
constexpr size_t WS_END = 256 * MiB;
constexpr int LDS_BYTES = 163840;

__device__ unsigned g_ctl[8192];
struct Params { const float* in[22]; float* out; unsigned char* ws; int ph_lo, ph_hi; };

__device__ __forceinline__ float bf2f(unsigned short b) { return __uint_as_float((unsigned)b << 16); }
__device__ __forceinline__ float bflo(unsigned w) { return __uint_as_float(w << 16); }
__device__ __forceinline__ float bfhi(unsigned w) { return __uint_as_float(w & 0xffff0000u); }
__device__ __forceinline__ float wave_sum(float v) {
#pragma unroll
    for (int o = 1; o < 64; o <<= 1) v += __shfl_xor(v, o);
    return v;
}
__device__ __forceinline__ int perm16(int s) { return (s & 3) | ((s & 4) << 1) | ((s & 8) >> 1); }
__device__ __forceinline__ void sincos_ang(float ang, float& s, float& c) {
    double rev = (double)ang * 0.15915494309189535;
    rev -= __builtin_rint(rev);
    const float fr = (float)rev;
    s = __builtin_amdgcn_sinf(fr); c = __builtin_amdgcn_cosf(fr);
}
__device__ __forceinline__ float rope_freq(int i, int r) { return exp2f(-(float)(2 * i) / (float)r * LOG2_THETA); }

__device__ __forceinline__ u32x4 pack8(const f32x4& a, const f32x4& b) {
    u32x4 w; w.x = cvt_pk_bf16(a[0], a[1]); w.y = cvt_pk_bf16(a[2], a[3]); w.z = cvt_pk_bf16(b[0], b[1]); w.w = cvt_pk_bf16(b[2], b[3]); return w;
}
__device__ __forceinline__ bf16_t f2bf1(float v) { return (bf16_t)(cvt_pk_bf16(v, v) & 0xffffu); }

__device__ __forceinline__ void store_v(bf16_t* v, int bh, int d0, int r, const f32x4& a, const f32x4& b) {
    *(u32x4*)(v + ((size_t)bh * 2048 + (r & 2047)) * 128 + d0) = pack8(a, b);
}

struct EpiProj {
    static constexpr bool PERM = true, AFTER_DRAIN = false;
    bf16_t* qlat; bf16_t* kvlat; float* ssql; bf16_t* proj; bf16_t* vtd;
    __device__ __forceinline__ void operator()(const f32x4 (&acc)[2][2][4][2], const Unit& u, int wr, int wc, int fr, int fq) const {
        const int row0 = u.pm * 256 + wr * 64 + fr;
        if (u.pn < 4) {
            bf16_t* dst = (u.pn < 2) ? qlat : kvlat; const int t2 = u.pn & 1, lat = u.pn >> 1, col0 = t2 * 256 + wc * 32 + 8 * fq;
#pragma unroll
            for (int ai = 0; ai < 2; ++ai)
#pragma unroll
                for (int m = 0; m < 4; ++m) { const int r = row0 + ai * 128 + m * 16; bf16_t* rowp = dst + (size_t)r * 512 + col0; float sq = 0.f;
#pragma unroll
                    for (int bj = 0; bj < 2; ++bj) { const f32x4 v0 = acc[ai][bj][m][0], v1 = acc[ai][bj][m][1]; *(u32x4*)(rowp + bj * 128) = pack8(v0, v1);
                        sq += (v0[0] * v0[0] + v0[1] * v0[1]) + (v0[2] * v0[2] + v0[3] * v0[3]) + (v1[0] * v1[0] + v1[1] * v1[1]) + (v1[2] * v1[2] + v1[3] * v1[3]); }
                    sq += __shfl_xor(sq, 16); sq += __shfl_xor(sq, 32);
                    if (fq == 0) ssql[(size_t)r * 16 + lat * 8 + t2 * 4 + wc] = sq; }
        } else if (u.pn < 12) {
            const int col0 = (u.pn - 4) * 256 + wc * 32 + 8 * fq;
#pragma unroll
            for (int ai = 0; ai < 2; ++ai)
#pragma unroll
                for (int m = 0; m < 4; ++m) { bf16_t* rowp = proj + (size_t)(row0 + ai * 128 + m * 16) * PROJ_LD + col0;
#pragma unroll
                    for (int bj = 0; bj < 2; ++bj) *(u32x4*)(rowp + bj * 128) = pack8(acc[ai][bj][m][0], acc[ai][bj][m][1]); }
        } else {
#pragma unroll
            for (int ai = 0; ai < 2; ++ai)
#pragma unroll
                for (int m = 0; m < 4; ++m) { const int r = row0 + ai * 128 + m * 16; const int b = r >> 11;
#pragma unroll
                    for (int bj = 0; bj < 2; ++bj) store_v(vtd, b * 8 + 2 * (u.pn - 12) + bj, wc * 32 + 8 * fq, r, acc[ai][bj][m][0], acc[ai][bj][m][1]); }
        }
    }
};
__device__ __forceinline__ float latent_rs(const float* ssql_row8) {
    const f32x4 a = *(const f32x4*)ssql_row8, b = *(const f32x4*)(ssql_row8 + 4);
    return 1.0f / sqrtf((((a[0] + a[1]) + (a[2] + a[3])) + ((b[0] + b[1]) + (b[2] + b[3]))) * (1.0f / 512.0f) + EPS);
}
struct EpiPlain {
    static constexpr bool PERM = true, AFTER_DRAIN = false;
    bf16_t* O; int ldc;
    __device__ __forceinline__ void operator()(const f32x4 (&acc)[2][2][4][2], const Unit& u, int wr, int wc, int fr, int fq) const {
        const int row0 = u.pm * 256 + wr * 64 + fr, col0 = u.pn * 256 + wc * 32 + 8 * fq;
#pragma unroll
        for (int ai = 0; ai < 2; ++ai)
#pragma unroll
            for (int m = 0; m < 4; ++m) { bf16_t* rowp = O + (size_t)(row0 + ai * 128 + m * 16) * ldc + col0;
#pragma unroll
                for (int bj = 0; bj < 2; ++bj) *(u32x4*)(rowp + bj * 128) = pack8(acc[ai][bj][m][0], acc[ai][bj][m][1]); }
    }
};
struct EpiKv {
    static constexpr bool PERM = true, AFTER_DRAIN = false;
    bf16_t* knope; bf16_t* vtm; const float* ssql;
    __device__ __forceinline__ void operator()(const f32x4 (&acc)[2][2][4][2], const Unit& u, int wr, int wc, int fr, int fq) const {
        const int row0 = u.pm * 256 + wr * 64 + fr;
        f32x4 sv[8][2];
#pragma unroll
        for (int k = 0; k < 8; ++k) { const f32x4* sp = (const f32x4*)(ssql + (size_t)(row0 + (k >> 2) * 128 + (k & 3) * 16) * 16 + 8); sv[k][0] = sp[0]; sv[k][1] = sp[1]; }
#pragma unroll
        for (int ai = 0; ai < 2; ++ai)
#pragma unroll
            for (int m = 0; m < 4; ++m) { const int r = row0 + ai * 128 + m * 16; const f32x4 a = sv[ai * 4 + m][0], b = sv[ai * 4 + m][1];
                const float rs = 1.0f / sqrtf((((a[0] + a[1]) + (a[2] + a[3])) + ((b[0] + b[1]) + (b[2] + b[3]))) * (1.0f / 512.0f) + EPS);
                *(u32x4*)(knope + (size_t)r * 1024 + u.pn * 128 + wc * 32 + 8 * fq) = pack8(acc[ai][0][m][0], acc[ai][0][m][1]);
                store_v(vtm, (r >> 11) * 8 + u.pn, wc * 32 + 8 * fq, r, acc[ai][1][m][0] * rs, acc[ai][1][m][1] * rs); }
    }
};
struct EpiWo {
    static constexpr bool PERM = false, AFTER_DRAIN = false;
    const float* x; float* out; bf16_t* x1b; float* ssq;
    __device__ __forceinline__ void operator()(const f32x4 (&acc)[2][2][4][2], const Unit& u, int wr, int wc, int fr, int fq) const {
        const int row0 = u.pm * 256 + wr * 64 + fr, col0 = u.pn * 256 + wc * 32 + 4 * fq;
#pragma unroll
        for (int ai = 0; ai < 2; ++ai) {
            f32x4 xv[4][2][2];
#pragma unroll
            for (int m = 0; m < 4; ++m)
#pragma unroll
                for (int bj = 0; bj < 2; ++bj)
#pragma unroll
                    for (int n = 0; n < 2; ++n) xv[m][bj][n] = *(const f32x4*)(x + (size_t)(row0 + ai * 128 + m * 16) * DM + col0 + bj * 128 + n * 16);
#pragma unroll
            for (int m = 0; m < 4; ++m) { const int r = row0 + ai * 128 + m * 16; const size_t off = (size_t)r * DM + col0; float s = 0.f;
#pragma unroll
                for (int bj = 0; bj < 2; ++bj)
#pragma unroll
                    for (int n = 0; n < 2; ++n) { const size_t o2 = off + bj * 128 + n * 16; const f32x4 v = xv[m][bj][n] + acc[ai][bj][m][n];
                        s += (v[0] * v[0] + v[1] * v[1]) + (v[2] * v[2] + v[3] * v[3]);
                        u32x2 w; w.x = cvt_pk_bf16(v[0], v[1]); w.y = cvt_pk_bf16(v[2], v[3]); *(u32x2*)(x1b + o2) = w; }
                s += __shfl_xor(s, 16); s += __shfl_xor(s, 32);
                if (fq == 0) ssq[(size_t)r * 32 + u.pn * 4 + wc] = s; }
        }
    }
};
struct EpiGateUp {
    static constexpr bool PERM = true, AFTER_DRAIN = false;
    const float* ssq; bf16_t* hmid;
    __device__ __forceinline__ void operator()(const f32x4 (&acc)[2][2][4][2], const Unit& u, int wr, int wc, int fr, int fq) const {
        const int row0 = u.pm * 256 + wr * 64 + fr, col0 = u.pn * 128 + wc * 32 + 8 * fq;
        f32x4 sv[8][2];
#pragma unroll
        for (int k = 0; k < 8; ++k) { const f32x4* sp = (const f32x4*)(ssq + (size_t)(row0 + (k >> 2) * 128 + (k & 3) * 16) * 32) + 2 * fq; sv[k][0] = sp[0]; sv[k][1] = sp[1]; }
        float r2[8];
#pragma unroll
        for (int k = 0; k < 8; ++k) { float s = ((sv[k][0][0] + sv[k][0][1]) + (sv[k][0][2] + sv[k][0][3])) + ((sv[k][1][0] + sv[k][1][1]) + (sv[k][1][2] + sv[k][1][3]));
            s += __shfl_xor(s, 16); s += __shfl_xor(s, 32); r2[k] = 1.0f / sqrtf(s * (1.0f / DM) + EPS); }
#pragma unroll
        for (int ai = 0; ai < 2; ++ai)
#pragma unroll
            for (int m = 0; m < 4; ++m) { const int r = row0 + ai * 128 + m * 16; const float rr = r2[ai * 4 + m];
                f32x4 hv[2];
#pragma unroll
                for (int n = 0; n < 2; ++n)
#pragma unroll
                    for (int e = 0; e < 4; ++e) { const float g = acc[ai][0][m][n][e] * rr, up = acc[ai][1][m][n][e] * rr;
                        const float sg = g * __builtin_amdgcn_rcpf(1.0f + __builtin_amdgcn_exp2f(-g * LOG2E)); hv[n][e] = sg * up; }
                *(u32x4*)(hmid + (size_t)r * DFF + col0) = pack8(hv[0], hv[1]); }
    }
};
struct EpiDown {
    static constexpr bool PERM = false, AFTER_DRAIN = false;
    const bf16_t* x1b; float* out;
    __device__ __forceinline__ void operator()(const f32x4 (&acc)[2][2][4][2], const Unit& u, int wr, int wc, int fr, int fq) const {
        const int row0 = u.pm * 256 + wr * 64 + fr, col0 = u.pn * 256 + wc * 32 + 4 * fq;
#pragma unroll
        for (int ai = 0; ai < 2; ++ai) {
            u32x2 xv[4][2][2];
#pragma unroll
            for (int m = 0; m < 4; ++m)
#pragma unroll
                for (int bj = 0; bj < 2; ++bj)
#pragma unroll
                    for (int n = 0; n < 2; ++n) xv[m][bj][n] = *(const u32x2*)(x1b + (size_t)(row0 + ai * 128 + m * 16) * DM + col0 + bj * 128 + n * 16);
#pragma unroll
            for (int m = 0; m < 4; ++m)
#pragma unroll
                for (int bj = 0; bj < 2; ++bj)
#pragma unroll
                    for (int n = 0; n < 2; ++n) { const u32x2 w = xv[m][bj][n]; const f32x4 r = {bflo(w.x), bfhi(w.x), bflo(w.y), bfhi(w.y)};
                        *(f32x4*)(out + (size_t)(row0 + ai * 128 + m * 16) * DM + col0 + bj * 128 + n * 16) = r + acc[ai][bj][m][n]; }
        }
    }
};

struct TItem { const float* src; const float* gain; bf16_t* dst; int ldw, K; bool zero; };
__device__ __forceinline__ TItem p0_item(const Params& p, unsigned char* ws, int it) {
    constexpr int I_IN = 32 * 65, I_Q = 8 * 24, I_KV = 8 * 32, I_O = 32 * 32, I_GU = 32 * 176;
    TItem t; t.gain = nullptr; t.zero = false; int r = it;
    if (r < I_IN) { const int kb = r / 65, nb = r % 65; const int nd = nb * 64; const int ns = nd < 1024 ? nd : (nd < 4096 ? nd + 64 : 1024);
        t.src = p.in[2] + (size_t)(kb * 64) * 4160 + ns; t.ldw = 4160; t.dst = (bf16_t*)(ws + WS_WIN) + (size_t)nd * 2048 + kb * 64; t.K = 2048; return t; } r -= I_IN;
    if (r < I_Q) { const int kb = r / 24, nb = r % 24; t.src = p.in[4] + (size_t)(kb * 64) * 1536 + nb * 64; t.ldw = 1536; t.gain = p.in[3] + kb * 64; t.dst = (bf16_t*)(ws + WS_WQ) + (size_t)(nb * 64) * 512 + kb * 64; t.K = 512; return t; } r -= I_Q;
    if (r < I_KV) { const int kb = r / 32, nb = r % 32; t.src = p.in[6] + (size_t)(kb * 64) * 2048 + nb * 64; t.ldw = 2048; t.gain = p.in[5] + kb * 64; t.dst = (bf16_t*)(ws + WS_WKV) + (size_t)(nb * 64) * 512 + kb * 64; t.K = 512; return t; } r -= I_KV;
    if (r < I_O) { const int kb = r / 32, nb = r % 32; t.src = p.in[17] + (size_t)(kb * 64) * 2048 + nb * 64; t.ldw = 2048; t.dst = (bf16_t*)(ws + WS_WO) + (size_t)(nb * 64) * 2048 + kb * 64; t.K = 2048; return t; } r -= I_O;
    if (r < I_GU) { const int kb = r / 176, nb = r % 176; const int nd = nb * 64; const int tt = nd >> 8, bj = (nd >> 7) & 1, j = nd & 127;
        t.src = (bj ? p.in[20] : p.in[19]) + (size_t)(kb * 64) * DFF + tt * 128 + j; t.ldw = DFF; t.gain = p.in[18] + kb * 64;
        t.dst = (bf16_t*)(ws + WS_WGU) + (size_t)nd * 2048 + kb * 64; t.K = 2048; return t; } r -= I_GU;
    { const int kb = r / 32, nb = r % 32; t.src = p.in[21] + (size_t)(kb * 64) * 2048 + nb * 64; t.ldw = 2048; t.dst = (bf16_t*)(ws + WS_WD) + (size_t)(nb * 64) * DFF + kb * 64; t.K = DFF; return t; }
}
constexpr int P0_NITEMS = 32 * 65 + 8 * 24 + 8 * 32 + 32 * 32 + 32 * 176 + 88 * 32, P0_ITEMS_WD = 88 * 32, P0_ITEMS_EARLY = 32 * 65 + 8 * 24 + 8 * 32, P0_ITEMS_MID = 32 * 32 + 32 * 176;
static_assert(P0_ITEMS_MID == 416 * 16 && P0_ITEMS_EARLY + P0_ITEMS_MID + P0_ITEMS_WD == P0_NITEMS, "conversion item split");
__device__ __forceinline__ void p0_convert(const Params& p, LAS unsigned char* lds, int it0, int NITEMS, int gw, int NGW, int wave, int lane) {
    unsigned char* ws = p.ws;
    LAS float* scr = (LAS float*)(lds + wave * 16640);
    const int ksub = lane >> 4, n4 = (lane & 15) * 4;
    f32x4 v[16];
#define P0_LOAD(T) do { const float* sp_ = (T).src + (size_t)ksub * (T).ldw + n4; \
        _Pragma("unroll") for (int i = 0; i < 16; ++i) v[i] = *(const f32x4*)(sp_ + (size_t)(4 * i) * (T).ldw); } while (0)
    int it = it0 + gw; TItem cur;
    if (it < NITEMS) { cur = p0_item(p, ws, it); P0_LOAD(cur); }
    while (it < NITEMS) {
        if (cur.gain) {
#pragma unroll
            for (int i = 0; i < 16; ++i) v[i] = v[i] * cur.gain[4 * i + ksub];
        }
#pragma unroll
        for (int i = 0; i < 16; ++i) { LAS float* d = scr + (4 * i + ksub) * 65 + n4; d[0] = v[i][0]; d[1] = v[i][1]; d[2] = v[i][2]; d[3] = v[i][3]; }
        const int itn = it + NGW; TItem nxt = cur;
        if (itn < NITEMS) { nxt = p0_item(p, ws, itn); P0_LOAD(nxt); }
        asm volatile("s_waitcnt lgkmcnt(0)" ::: "memory");
        const int c = lane & 7;
#pragma unroll
        for (int j = 0; j < 8; ++j) { const int n = (lane >> 3) + 8 * j; const LAS float* s = scr + (8 * c) * 65 + n;
            u32x4 o; o.x = cvt_pk_bf16(s[0 * 65], s[1 * 65]); o.y = cvt_pk_bf16(s[2 * 65], s[3 * 65]); o.z = cvt_pk_bf16(s[4 * 65], s[5 * 65]); o.w = cvt_pk_bf16(s[6 * 65], s[7 * 65]);
            *(u32x4*)(cur.dst + (size_t)n * cur.K + 8 * c) = o; }
        asm volatile("s_waitcnt lgkmcnt(0)" ::: "memory");
        it = itn; cur = nxt;
    }
#undef P0_LOAD
}
__device__ __forceinline__ void phase0(const Params& p, LAS unsigned char* lds, int gw, int NGW, int wave, int lane) {
    unsigned char* ws = p.ws;
    p0_convert(p, lds, 0, P0_ITEMS_EARLY, gw, NGW, wave, lane);
    const float* x = p.in[0]; const float* g = p.in[1]; bf16_t* hb = (bf16_t*)(ws + WS_HB);
    f32x4 v[8], vn[8];
    if (gw < M) {
#pragma unroll
        for (int j = 0; j < 8; ++j) vn[j] = ((const f32x4*)(x + (size_t)gw * DM) + lane)[64 * j];
    }
    for (int m = gw; m < M; m += NGW) {
        float s = 0.f;
#pragma unroll
        for (int j = 0; j < 8; ++j) { v[j] = vn[j]; s += (v[j][0] * v[j][0] + v[j][1] * v[j][1]) + (v[j][2] * v[j][2] + v[j][3] * v[j][3]); }
        if (m + NGW < M) {
#pragma unroll
            for (int j = 0; j < 8; ++j) vn[j] = ((const f32x4*)(x + (size_t)(m + NGW) * DM) + lane)[64 * j];
        }
        const float rs = 1.0f / sqrtf(wave_sum(s) * (1.0f / DM) + EPS);
        u32x2* o = (u32x2*)(hb + (size_t)m * DM) + lane;
#pragma unroll
        for (int j = 0; j < 8; ++j) { const f32x4 gv = ((const f32x4*)g)[lane + 64 * j]; u32x2 w;
            w.x = cvt_pk_bf16(v[j][0] * rs * gv[0], v[j][1] * rs * gv[1]); w.y = cvt_pk_bf16(v[j][2] * rs * gv[2], v[j][3] * rs * gv[3]); o[64 * j] = w; }
    }
}

__device__ __forceinline__ void unpack8(const u32x4& w, float (&f)[8]) {
    f[0] = bflo(w.x); f[1] = bfhi(w.x); f[2] = bflo(w.y); f[3] = bfhi(w.y); f[4] = bflo(w.z); f[5] = bfhi(w.z); f[6] = bflo(w.w); f[7] = bfhi(w.w);
}
__device__ __forceinline__ u32x4 pack8f(const float (&f)[8]) {
    u32x4 w; w.x = cvt_pk_bf16(f[0], f[1]); w.y = cvt_pk_bf16(f[2], f[3]); w.z = cvt_pk_bf16(f[4], f[5]); w.w = cvt_pk_bf16(f[6], f[7]); return w;
}
__device__ __forceinline__ void latent_norm(const bf16_t* src, const float* g, bf16_t* dst, int lane) {
    float f[8]; unpack8(*(const u32x4*)(src + lane * 8), f); float s = 0.f;
#pragma unroll
    for (int j = 0; j < 8; ++j) s += f[j] * f[j];
    const float rs = 1.0f / sqrtf(wave_sum(s) * (1.0f / 512.0f) + EPS);
#pragma unroll
    for (int j = 0; j < 8; ++j) f[j] = f[j] * rs * g[lane * 8 + j];
    *(u32x4*)(dst + lane * 8) = pack8f(f);
}
__device__ __forceinline__ void diff_row(const u32x4& raw0, const u32x4& raw1, const float (&g)[16], const float (&sn)[8], const float (&cs)[8], bf16_t* o, int sub) {
    float f[16]; { float t[8]; unpack8(raw0, t);
#pragma unroll
        for (int j = 0; j < 8; ++j) f[j] = t[j];
        unpack8(raw1, t);
#pragma unroll
        for (int j = 0; j < 8; ++j) f[8 + j] = t[j]; }
    float ss = 0.f;
#pragma unroll
    for (int j = 0; j < 16; ++j) ss += f[j] * f[j];
    ss += __shfl_xor(ss, 1); ss += __shfl_xor(ss, 2);
    const float rs = 1.0f / sqrtf(ss * (1.0f / 64.0f) + EPS);
#pragma unroll
    for (int j = 0; j < 16; ++j) f[j] = f[j] * rs * g[j];
    if (sub == 0) {
#pragma unroll
        for (int i = 0; i < 8; ++i) { const float a = f[i], bb = f[8 + i]; f[i] = a * cs[i] - bb * sn[i]; f[8 + i] = bb * cs[i] + a * sn[i]; }
    }
    { float t[8];
#pragma unroll
      for (int j = 0; j < 8; ++j) t[j] = f[j];
      *(u32x4*)o = pack8f(t);
#pragma unroll
      for (int j = 0; j < 8; ++j) t[j] = f[8 + j];
      *(u32x4*)(o + 8) = pack8f(t); }
}
__device__ __forceinline__ void kpe_gemm(unsigned char* ws, LAS unsigned char* lds, int blk0, int bstep, int bend, int tid, int wave, int lane) {
    const bf16_t* hb = (const bf16_t*)(ws + WS_HB); const bf16_t* wk = (const bf16_t*)(ws + WS_WIN) + (size_t)4096 * 2048; bf16_t* kpe = (bf16_t*)(ws + WS_KPE);
    const int r32 = lane & 31, h = lane >> 5;
    LAS float* red = (LAS float*)lds;
    for (int blk = blk0; blk < bend; blk += bstep) {
        const int m0 = blk * 32;
        const bf16_t* ap = hb + (size_t)(m0 + r32) * 2048 + wave * 256 + 8 * h;
        const bf16_t* bp = wk + (size_t)r32 * 2048 + wave * 256 + 8 * h;
        f32x16 c0, c1;
#pragma unroll
        for (int i = 0; i < 16; ++i) { c0[i] = 0.f; c1[i] = 0.f; }
#pragma unroll
        for (int ks = 0; ks < 16; ++ks) {
            const bf16x8 a = *(const bf16x8*)(ap + 16 * ks), b0 = *(const bf16x8*)(bp + 16 * ks), b1 = *(const bf16x8*)(bp + (size_t)32 * 2048 + 16 * ks);
            c0 = __builtin_amdgcn_mfma_f32_32x32x16_bf16(a, b0, c0, 0, 0, 0); c1 = __builtin_amdgcn_mfma_f32_32x32x16_bf16(a, b1, c1, 0, 0, 0);
        }
        __syncthreads();
#pragma unroll
        for (int i = 0; i < 16; ++i) { const int tok = (i & 3) + 8 * (i >> 2) + 4 * h; red[(wave * 32 + tok) * 64 + r32] = c0[i]; red[(wave * 32 + tok) * 64 + 32 + r32] = c1[i]; }
        __syncthreads();
        { const int tok = tid >> 4, n4 = (tid & 15) * 4; f32x4 sacc = {0.f, 0.f, 0.f, 0.f};
#pragma unroll
          for (int w8 = 0; w8 < 8; ++w8) sacc = sacc + *(const LAS f32x4*)(red + (w8 * 32 + tok) * 64 + n4);
          u32x2 w; w.x = cvt_pk_bf16(sacc[0], sacc[1]); w.y = cvt_pk_bf16(sacc[2], sacc[3]); *(u32x2*)(kpe + (size_t)(m0 + tok) * 64 + n4) = w; }
    }
}
__device__ __forceinline__ void p3_pre(const Params& p, LAS unsigned char* lds, int bx, int G, int tid, int wave, int lane) {
    unsigned char* ws = p.ws;
    const bf16_t* proj = (const bf16_t*)(ws + WS_PROJ); bf16_t* qd = (bf16_t*)(ws + WS_QD); bf16_t* kd = (bf16_t*)(ws + WS_KD);
    constexpr int NQU = (M / 256) * (1536 / 256);
    int row0, rstep, rend, blk0, bstep, bend;
    if (G == 256) {
        if (bx >= NQU) { row0 = (bx - NQU) * NWAVES + wave; rstep = (256 - NQU) * NWAVES; rend = 4096; blk0 = bx - NQU; bstep = 256 - NQU; bend = 128; }
        else { row0 = 4096 + bx * NWAVES + wave; rstep = NQU * NWAVES; rend = M; blk0 = 128 + bx; bstep = 256; bend = 256; }
    } else { row0 = bx * NWAVES + wave; rstep = G * NWAVES; rend = M; blk0 = bx; bstep = G; bend = 256; }
    kpe_gemm(ws, lds, blk0, bstep, bend, tid, wave, lane);
    const int sub = lane & 3, hc = lane >> 2;
    float gq[16], gk[16], frq[8];
#pragma unroll
    for (int j = 0; j < 16; ++j) { gq[j] = p.in[10][sub * 16 + j] * (0.125f * LOG2E); gk[j] = p.in[11][sub * 16 + j]; }
#pragma unroll
    for (int i = 0; i < 8; ++i) frq[i] = rope_freq(i, 16);
    for (int m = row0; m < rend; m += rstep) {
        const bf16_t* pr = proj + (size_t)m * PROJ_LD + lane * 16; const int b = m >> 11, sp = m & 2047;
        const u32x4 q0 = *(const u32x4*)(pr), q1 = *(const u32x4*)(pr + 8), k0 = *(const u32x4*)(pr + 1024), k1 = *(const u32x4*)(pr + 1032);
        float sn[8], cs[8];
#pragma unroll
        for (int i = 0; i < 8; ++i) sincos_ang((float)sp * frq[i], sn[i], cs[i]);
        const size_t off = ((size_t)((b * 16 + hc) * SEQ + sp)) * 64 + sub * 16;
        diff_row(q0, q1, gq, sn, cs, qd + off, sub);
        diff_row(k0, k1, gk, sn, cs, kd + off, sub);
    }
}

__device__ __forceinline__ void mla_row(const u32x4& n0, const u32x4& n1, const u32x4& r0, float rn, float rr, const float (&gn)[16], const float (&gr)[8], const float (&sns)[8], const float (&cs)[8], bf16_t* o, int sub) {
    float fn[16], fr[8];
    { float t[8]; unpack8(n0, t);
#pragma unroll
      for (int j = 0; j < 8; ++j) fn[j] = t[j] * rn;
      unpack8(n1, t);
#pragma unroll
      for (int j = 0; j < 8; ++j) fn[8 + j] = t[j] * rn;
      unpack8(r0, t);
#pragma unroll
      for (int j = 0; j < 8; ++j) fr[j] = t[j] * rr; }
    float ss = 0.f;
#pragma unroll
    for (int j = 0; j < 16; ++j) ss += fn[j] * fn[j];
#pragma unroll
    for (int j = 0; j < 8; ++j) ss += fr[j] * fr[j];
    ss += __shfl_xor(ss, 1); ss += __shfl_xor(ss, 2); ss += __shfl_xor(ss, 4);
    const float rs = 1.0f / sqrtf(ss * (1.0f / 192.0f) + EPS);
#pragma unroll
    for (int j = 0; j < 16; ++j) fn[j] = fn[j] * rs * gn[j];
    float ro[8];
#pragma unroll
    for (int j = 0; j < 8; ++j) { const float v = fr[j] * rs * gr[j]; const float pv = __shfl_xor(v, 4); ro[j] = v * cs[j] + pv * sns[j]; }
    { float t[8];
#pragma unroll
      for (int j = 0; j < 8; ++j) t[j] = fn[j];
      *(u32x4*)(o + sub * 16) = pack8f(t);
#pragma unroll
      for (int j = 0; j < 8; ++j) t[j] = fn[8 + j];
      *(u32x4*)(o + sub * 16 + 8) = pack8f(t); }
    *(u32x4*)(o + 128 + sub * 8) = pack8f(ro);
}
__device__ __forceinline__ void phase4(const Params& p, int gw, int NGW, int lane) {
    unsigned char* ws = p.ws;
    const bf16_t* qf = (const bf16_t*)(ws + WS_QF); const bf16_t* knope = (const bf16_t*)(ws + WS_KNOPE); const bf16_t* kpe = (const bf16_t*)(ws + WS_KPE);
    bf16_t* qm = (bf16_t*)(ws + WS_QM); bf16_t* km = (bf16_t*)(ws + WS_KM);
    const int h = lane >> 3, sub = lane & 7;
    const float qscale = LOG2E / sqrtf(192.0f), sgn = sub < 4 ? -1.0f : 1.0f;
    float gqn[16], gkn[16], gqr[8], gkr[8], frq[8];
#pragma unroll
    for (int j = 0; j < 16; ++j) { gqn[j] = p.in[7][sub * 16 + j] * qscale; gkn[j] = p.in[8][sub * 16 + j]; }
#pragma unroll
    for (int j = 0; j < 8; ++j) { gqr[j] = p.in[7][128 + sub * 8 + j] * qscale; gkr[j] = p.in[8][128 + sub * 8 + j]; frq[j] = rope_freq((sub * 8 + j) & 31, 64); }
    for (int m = gw; m < M; m += NGW) {
        const int b = m >> 11, sp = m & 2047;
        const bf16_t* q0 = qf + (size_t)m * 1536 + h * 192; const bf16_t* k0 = knope + (size_t)m * 1024 + h * 128 + sub * 16;
        const u32x4 qa = *(const u32x4*)(q0 + sub * 16), qb = *(const u32x4*)(q0 + sub * 16 + 8), qc = *(const u32x4*)(q0 + 128 + sub * 8);
        const u32x4 ka = *(const u32x4*)(k0), kb = *(const u32x4*)(k0 + 8), kc = *(const u32x4*)(kpe + (size_t)m * 64 + sub * 8);
        const float* sq = (const float*)(ws + WS_SSQL) + (size_t)m * 16; const float rq = latent_rs(sq), rkv = latent_rs(sq + 8);
        float sns[8], cs[8];
#pragma unroll
        for (int j = 0; j < 8; ++j) { float sv; sincos_ang((float)sp * frq[j], sv, cs[j]); sns[j] = sv * sgn; }
        const size_t off = ((size_t)((b * 8 + h) * SEQ + sp)) * 192;
        mla_row(qa, qb, qc, rq, rq, gqn, gqr, sns, cs, qm + off, sub);
        mla_row(ka, kb, kc, rkv, 1.0f, gkn, gkr, sns, cs, km + off, sub);
    }
}

#define MFMA32(a, b, c) __builtin_amdgcn_mfma_f32_32x32x16_bf16((a), (b), (c), 0, 0, 0)
typedef short s16x4 __attribute__((ext_vector_type(4)));
__device__ __forceinline__ s16x4 vtr(const LAS unsigned char* p) { return __builtin_bit_cast(s16x4, __builtin_amdgcn_ds_read_tr16_b64_v4i16((LAS s16x4*)p)); }
template <int DQK>
__device__ __forceinline__ void attn_pass(f32x16 (&o)[4], const bf16_t* Qh, const bf16_t* Kh, const bf16_t* Vth, int q0, LAS unsigned char* lds, int tid, int w, int lane) {
    constexpr int KSTR = DQK * 2 + 16, VSTR = 320, NKC = (64 * DQK * 2 / 16) / NTHR, CPR = DQK / 8, KB = 64 * KSTR, VB = 64 * VSTR;
    static_assert(NKC * NTHR * 16 == 64 * DQK * 2, "K tile chunks");
    constexpr bool PIPE = false; constexpr int KA = PIPE ? 1 : 0;
    constexpr float THR = 8.0f;
    LAS unsigned char* Ks = lds; LAS unsigned char* Vs = lds + 2 * KB;
    const int r32 = lane & 31, h = lane >> 5;
    bf16x8 qf[DQK / 16];
    { const bf16_t* qrow = Qh + (size_t)(q0 + 32 * w + r32) * DQK + 8 * h;
#pragma unroll
      for (int d0 = 0; d0 < DQK / 16; ++d0) qf[d0] = *(const bf16x8*)(qrow + 16 * d0); }
    float m_run = -INFINITY, l_lane = 0.f;
#pragma unroll
    for (int db = 0; db < 4; ++db)
#pragma unroll
        for (int i = 0; i < 16; ++i) o[db][i] = 0.f;
    const int NT = (q0 + 256) >> 6, tmax = (q0 >> 6) + (w >> 1);
    const int qg = q0 + 32 * w + r32;
    u32x4 kreg[NKC], vreg[2];
#define ATT_LDK(R, t) do { _Pragma("unroll") for (int j = 0; j < NKC; ++j) R[j] = ((const u32x4*)(Kh + (size_t)(t) * 64 * DQK))[tid + NTHR * j]; } while (0)
#define ATT_LDV(t) do { _Pragma("unroll") for (int j = 0; j < 2; ++j) vreg[j] = ((const u32x4*)(Vth + (size_t)(t) * 64 * 128))[tid + NTHR * j]; } while (0)
#define ATT_STK(R, buf) do { _Pragma("unroll") for (int j = 0; j < NKC; ++j) { const int c = tid + NTHR * j; *(LAS u32x4*)(Ks + (buf) * KB + (c / CPR) * KSTR + (c % CPR) * 16) = R[j]; } } while (0)
#define ATT_STV(buf) do { _Pragma("unroll") for (int j = 0; j < 2; ++j) { const int c = tid + NTHR * j; *(LAS u32x4*)(Vs + (buf) * VB + (c >> 4) * VSTR + (c & 15) * 16) = vreg[j]; } } while (0)
#define ATT_QK(P0, P1, buf) do { \
        _Pragma("unroll") for (int i = 0; i < 16; ++i) { P0[i] = 0.f; P1[i] = 0.f; } \
        const LAS unsigned char* ka = Ks + (buf) * KB + r32 * KSTR + h * 16; \
        _Pragma("unroll") for (int d0 = 0; d0 < DQK / 16; ++d0) { \
            const bf16x8 a0 = *(const LAS bf16x8*)(ka + d0 * 32), a1 = *(const LAS bf16x8*)(ka + 32 * KSTR + d0 * 32); \
            P0 = MFMA32(a0, qf[d0], P0); P1 = MFMA32(a1, qf[d0], P1); } } while (0)
#define ATT_SMPV(P0, P1, t, buf) do { \
        if ((t) == tmax) { const int kb = 64 * (t) + 4 * h; \
            _Pragma("unroll") for (int i = 0; i < 16; ++i) { const int kv = kb + (i & 3) + 8 * (i >> 2); if (kv > qg) P0[i] = -INFINITY; if (kv + 32 > qg) P1[i] = -INFINITY; } } \
        float mx = fmaxf(P0[0], P1[0]); \
        _Pragma("unroll") for (int i = 1; i < 16; ++i) mx = fmaxf(mx, fmaxf(P0[i], P1[i])); \
        mx = fmaxf(mx, __shfl_xor(mx, 32)); \
        const bool need = mx > m_run + THR; \
        if (__builtin_amdgcn_ballot_w64(need) != 0ull) { \
            const float mnew = need ? mx : m_run, alpha = __builtin_amdgcn_exp2f(m_run - mnew); m_run = mnew; l_lane *= alpha; \
            _Pragma("unroll") for (int db = 0; db < 4; ++db) _Pragma("unroll") for (int i = 0; i < 16; ++i) o[db][i] *= alpha; } \
        float rs = 0.f; \
        _Pragma("unroll") for (int i = 0; i < 16; ++i) { P0[i] = __builtin_amdgcn_exp2f(P0[i] - m_run); P1[i] = __builtin_amdgcn_exp2f(P1[i] - m_run); rs += P0[i] + P1[i]; } \
        l_lane += rs; \
        bf16x8 pb[4]; \
        { u32x4 t0, t1, t2, t3; \
          t0.x = cvt_pk_bf16(P0[0], P0[1]); t0.y = cvt_pk_bf16(P0[2], P0[3]); t0.z = cvt_pk_bf16(P0[4], P0[5]); t0.w = cvt_pk_bf16(P0[6], P0[7]); \
          t1.x = cvt_pk_bf16(P0[8], P0[9]); t1.y = cvt_pk_bf16(P0[10], P0[11]); t1.z = cvt_pk_bf16(P0[12], P0[13]); t1.w = cvt_pk_bf16(P0[14], P0[15]); \
          t2.x = cvt_pk_bf16(P1[0], P1[1]); t2.y = cvt_pk_bf16(P1[2], P1[3]); t2.z = cvt_pk_bf16(P1[4], P1[5]); t2.w = cvt_pk_bf16(P1[6], P1[7]); \
          t3.x = cvt_pk_bf16(P1[8], P1[9]); t3.y = cvt_pk_bf16(P1[10], P1[11]); t3.z = cvt_pk_bf16(P1[12], P1[13]); t3.w = cvt_pk_bf16(P1[14], P1[15]); \
          pb[0] = __builtin_bit_cast(bf16x8, t0); pb[1] = __builtin_bit_cast(bf16x8, t1); pb[2] = __builtin_bit_cast(bf16x8, t2); pb[3] = __builtin_bit_cast(bf16x8, t3); } \
        const LAS unsigned char* va = Vs + (buf) * VB + (4 * h + ((lane & 15) >> 2)) * VSTR + ((lane >> 4) & 1) * 32 + (lane & 3) * 8; \
        _Pragma("unroll") for (int db = 0; db < 4; ++db) _Pragma("unroll") for (int ks = 0; ks < 4; ++ks) { \
            const s16x4 lo = vtr(va + db * 64 + (ks * 16) * VSTR), hi = vtr(va + db * 64 + (ks * 16 + 8) * VSTR); \
            const bf16x8 a = (bf16x8){lo[0], lo[1], lo[2], lo[3], hi[0], hi[1], hi[2], hi[3]}; o[db] = MFMA32(a, pb[ks], o[db]); } } while (0)
#define ATT_ITER(C0, C1, N0, N1, tt, B, NB) do { \
        __syncthreads(); \
        if constexpr (PIPE) { if ((tt) + 2 < NT) ATT_STK(kreg, B); } else { if ((tt) + 1 < NT) ATT_STK(kreg, NB); } \
        if ((tt) + 1 < NT) ATT_STV(NB); \
        if ((tt) + 2 + KA < NT) ATT_LDK(kreg, (tt) + 2 + KA); \
        if ((tt) + 2 < NT) ATT_LDV((tt) + 2); \
        if constexpr (PIPE) { if ((tt) + 1 <= tmax) ATT_QK(N0, N1, NB); if ((tt) <= tmax) ATT_SMPV(C0, C1, tt, B); } \
        else { if ((tt) <= tmax) { ATT_QK(C0, C1, B); ATT_SMPV(C0, C1, tt, B); } } } while (0)
    f32x16 pA0, pA1, pB0, pB1;
    if constexpr (PIPE) {
        u32x4 kreg2[NKC];
        ATT_LDK(kreg, 0); ATT_LDV(0); ATT_LDK(kreg2, 1);
        __syncthreads();
        ATT_STK(kreg, 0); ATT_STV(0); ATT_STK(kreg2, 1);
        ATT_LDK(kreg, 2); ATT_LDV(1);
        __syncthreads();
        ATT_QK(pA0, pA1, 0);
        for (int t = 0; t < NT; t += 2) {
            ATT_ITER(pA0, pA1, pB0, pB1, t, 0, 1);
            ATT_ITER(pB0, pB1, pA0, pA1, t + 1, 1, 0);
        }
    } else {
        u32x4 kreg2[NKC], vreg2[2];
        ATT_LDK(kreg, 0); ATT_LDV(0);
        ATT_LDK(kreg2, 1);
#pragma unroll
        for (int j = 0; j < 2; ++j) vreg2[j] = ((const u32x4*)(Vth + (size_t)64 * 128))[tid + NTHR * j];
        __syncthreads();
        ATT_STK(kreg, 0); ATT_STV(0);
#pragma unroll
        for (int j = 0; j < NKC; ++j) kreg[j] = kreg2[j];
#pragma unroll
        for (int j = 0; j < 2; ++j) vreg[j] = vreg2[j];
        for (int t = 0; t < NT; t += 2) {
            ATT_ITER(pA0, pA1, pA0, pA1, t, 0, 1);
            ATT_ITER(pA0, pA1, pA0, pA1, t + 1, 1, 0);
        }
    }
#undef ATT_LDK
#undef ATT_LDV
#undef ATT_STK
#undef ATT_STV
#undef ATT_QK
#undef ATT_SMPV
#undef ATT_ITER
    float l = l_lane + __shfl_xor(l_lane, 32);
    const float inv = 1.0f / l;
#pragma unroll
    for (int db = 0; db < 4; ++db)
#pragma unroll
        for (int i = 0; i < 16; ++i) o[db][i] *= inv;
}
__device__ __forceinline__ void attn_out_store(const f32x16 (&o)[4], const float* gain, float scale, bf16_t* dst_row, int h) {
    float ss = 0.f;
#pragma unroll
    for (int db = 0; db < 4; ++db)
#pragma unroll
        for (int i = 0; i < 16; ++i) ss += o[db][i] * o[db][i];
    ss += __shfl_xor(ss, 32);
    const float rn = scale / sqrtf(ss * (1.0f / 128.0f) + EPS);
#pragma unroll
    for (int db = 0; db < 4; ++db)
#pragma unroll
        for (int g4 = 0; g4 < 4; ++g4) { const int d = 32 * db + 8 * g4 + 4 * h; const f32x4 gv = *(const f32x4*)(gain + d);
            u32x2 w; w.x = cvt_pk_bf16(o[db][4 * g4] * rn * gv[0], o[db][4 * g4 + 1] * rn * gv[1]); w.y = cvt_pk_bf16(o[db][4 * g4 + 2] * rn * gv[2], o[db][4 * g4 + 3] * rn * gv[3]);
            *(u32x2*)(dst_row + d) = w; }
}
__device__ __forceinline__ void phase5(const Params& p, LAS unsigned char* lds, unsigned* ctr, int tid, int wave, int lane) {
    unsigned char* ws = p.ws;
    const bf16_t* qm = (const bf16_t*)(ws + WS_QM); const bf16_t* km = (const bf16_t*)(ws + WS_KM); const bf16_t* vtm = (const bf16_t*)(ws + WS_VTM);
    const bf16_t* qd = (const bf16_t*)(ws + WS_QD); const bf16_t* kd = (const bf16_t*)(ws + WS_KD); const bf16_t* vtd = (const bf16_t*)(ws + WS_VTD);
    bf16_t* ao = (bf16_t*)(ws + WS_AO);
    LAS unsigned* shw = (LAS unsigned*)(lds + 163824);
    float lam;
    { const float a = p.in[12][lane] * p.in[13][lane], b2 = p.in[14][lane] * p.in[15][lane];
      lam = __expf(wave_sum(a)) - __expf(wave_sum(b2)) + LAMBDA_INIT; }
    const int r32 = lane & 31, h = lane >> 5;
    for (;;) {
        __syncthreads();
        if (tid == 0) shw[0] = atomicAdd(ctr, 1u);
        __syncthreads();
        const unsigned uq = shw[0];
        if (uq >= 928u) break;
        const unsigned grp = uq / 29u, ing = uq % 29u;
        if (ing >= 16u) {
            const int cj = (int)(grp * 13u + ing - 16u);
            p0_convert(p, lds, P0_ITEMS_EARLY + 16 * cj, P0_ITEMS_EARLY + 16 * cj + 16, wave, NWAVES, wave, lane);
            continue;
        }
        const unsigned u = grp * 16u + ing;
        const int cls = (int)(u >> 5), bh = (int)(u & 31u);
        const int isdiff = (0x552B >> cls) & 1, qb = (int)((0x0011223345465767ull >> (4 * cls)) & 15ull);
        const int q0 = qb * 256, b = bh >> 3, hd = bh & 7;
        bf16_t* orow = ao + (size_t)(b * SEQ + q0 + 32 * wave + r32) * DM + hd * 128;
        if (!isdiff) {
            f32x16 o[4];
            attn_pass<192>(o, qm + (size_t)bh * SEQ * 192, km + (size_t)bh * SEQ * 192, vtm + (size_t)bh * 128 * SEQ, q0, lds, tid, wave, lane);
            attn_out_store(o, p.in[9], 1.0f, orow, h);
        } else {
            f32x16 o[4];
            LAS unsigned* st = (LAS unsigned*)(lds + 59392) + wave * 2048 + lane;
            attn_pass<64>(o, qd + (size_t)(bh * 2 + 1) * SEQ * 64, kd + (size_t)(bh * 2 + 1) * SEQ * 64, vtd + (size_t)bh * 128 * SEQ, q0, lds, tid, wave, lane);
#pragma unroll
            for (int db = 0; db < 4; ++db)
#pragma unroll
                for (int i = 0; i < 16; i += 2) st[(db * 8 + (i >> 1)) * 64] = cvt_pk_bf16(o[db][i], o[db][i + 1]);
            attn_pass<64>(o, qd + (size_t)(bh * 2) * SEQ * 64, kd + (size_t)(bh * 2) * SEQ * 64, vtd + (size_t)bh * 128 * SEQ, q0, lds, tid, wave, lane);
#pragma unroll
            for (int db = 0; db < 4; ++db)
#pragma unroll
                for (int i = 0; i < 16; i += 2) { const unsigned wv = st[(db * 8 + (i >> 1)) * 64]; o[db][i] -= lam * bflo(wv); o[db][i + 1] -= lam * bfhi(wv); }
            attn_out_store(o, p.in[16], 1.0f - LAMBDA_INIT, orow + 1024, h);
        }
    }
}

#define XB_TMO      128
#define XB_XCNT(j)  (256  + 64 * (j))
#define XB_XSUB(j)  (1280 + 64 * (j))
#define XB_XGEN(j)  (2304 + 64 * (j))
#define XB_TOP      3328
#define XB_TOPGEN   3392
#define XCD_BAR_WORDS 3456
#define XB_SPIN_CAP (1u << 18)

__device__ __forceinline__ unsigned xb_ld(unsigned* p)              { return __hip_atomic_load(p, __ATOMIC_RELAXED, __HIP_MEMORY_SCOPE_AGENT); }
__device__ __forceinline__ unsigned xb_add(unsigned* p, unsigned v) { return __hip_atomic_fetch_add(p, v, __ATOMIC_RELAXED, __HIP_MEMORY_SCOPE_AGENT); }
__device__ __forceinline__ unsigned xb_xcc_id() { return (unsigned)__builtin_amdgcn_s_getreg((3 << 11) | 20) & 0xFu; }
#define XB_SPIN(cond, bar) do { unsigned _sp = 0; while (cond) { __builtin_amdgcn_s_sleep(1); \
    if ((++_sp & 255u) == 0u) { if (xb_ld(&(bar)[XB_TMO])) break; if (_sp > XB_SPIN_CAP) { atomicAdd(&(bar)[XB_TMO], 1u); break; } } } } while (0)

struct XcdBarrier {
    unsigned* bar; unsigned x;
    volatile LAS unsigned* st;
};

__device__ __forceinline__ XcdBarrier xcd_barrier_post(unsigned* bar, volatile LAS unsigned* st) {
    XcdBarrier b; b.bar = bar; b.x = xb_xcc_id(); b.st = st;
    if (threadIdx.x == 0) (void)xb_add(&bar[XB_XCNT(b.x)], 1u);
    return b;
}
__device__ __forceinline__ void xcd_barrier_complete(unsigned* bar, unsigned x, unsigned& nloc, unsigned& nx) {
    const unsigned G = gridDim.x * gridDim.y * gridDim.z;
    unsigned sum, cnt, mine, sp = 0u;
    for (;;) {
        sum = 0u; cnt = 0u; mine = 0u;
#pragma unroll
        for (unsigned j = 0; j < 16; ++j) { const unsigned c = xb_ld(&bar[XB_XCNT(j)]); sum += c; cnt += (c > 0u) ? 1u : 0u; mine = (j == x) ? c : mine; }
        if (sum == G) break;
        __builtin_amdgcn_s_sleep(1);
        if ((++sp & 255u) == 0u) { if (xb_ld(&bar[XB_TMO])) break; if (sp > XB_SPIN_CAP) { atomicAdd(&bar[XB_TMO], 1u); break; } }
    }
    nloc = mine > 0u ? mine : 1u; nx = cnt > 0u ? cnt : 1u;
}

__device__ __forceinline__ void xcd_barrier(const XcdBarrier& b) {
    asm volatile("s_waitcnt vmcnt(0)" ::: "memory");
    __syncthreads();
    if (threadIdx.x == 0) {
        unsigned* bar = b.bar;
        __builtin_amdgcn_s_waitcnt(0);
        unsigned nloc = b.st[0], nx = b.st[1];
        if (nloc == 0u) { xcd_barrier_complete(bar, b.x, nloc, nx); b.st[0] = nloc; b.st[1] = nx; }
        const unsigned old = xb_add(&bar[XB_XSUB(b.x)], 1u);
        const unsigned gen = old / nloc;
        if (old + 1u == (gen + 1u) * nloc) {
            __builtin_amdgcn_fence(__ATOMIC_RELEASE, "agent");
            asm volatile("s_waitcnt vmcnt(0)" ::: "memory");
            const unsigned og = xb_add(&bar[XB_TOP], 1u);
            const unsigned tg = og / nx;
            if (og + 1u == (tg + 1u) * nx) xb_add(&bar[XB_TOPGEN], 1u);
            else XB_SPIN(xb_ld(&bar[XB_TOPGEN]) == tg, bar);
            __builtin_amdgcn_fence(__ATOMIC_ACQUIRE, "agent");
            xb_add(&bar[XB_XGEN(b.x)], 1u);
            asm volatile("s_waitcnt vmcnt(0)" ::: "memory");
        } else {
            XB_SPIN(xb_ld(&bar[XB_XGEN(b.x)]) == gen, bar);
            __builtin_amdgcn_fence(__ATOMIC_ACQUIRE, "agent");
            asm volatile("s_waitcnt vmcnt(0)" ::: "memory");
        }
    }
    __syncthreads();
}

__global__ void __launch_bounds__(NTHR, 2) fwd_kernel(Params p) {
    extern __shared__ __attribute__((aligned(16))) unsigned char lds_raw[];
    LAS unsigned char* lds = (LAS unsigned char*)lds_raw;
    const int tid = threadIdx.x, lane = tid & 63, wave = __builtin_amdgcn_readfirstlane(tid >> 6);
    const int G = gridDim.x, bx = blockIdx.x;
    const int gw = bx * NWAVES + wave, NGW = G * NWAVES;
    unsigned char* ws = p.ws;
    unsigned* ctl = MK_ONE_LAUNCH ? g_ctl : (unsigned*)(ws + WS_CTL);
    const int lo = p.ph_lo, hi = p.ph_hi;
    volatile LAS unsigned* bst = (volatile LAS unsigned*)(lds + 163808);
    if (tid == 0) { bst[0] = 0u; bst[1] = 0u; }
    __syncthreads();
    XcdBarrier bar; bar.bar = ctl + 1024; bar.x = 0; bar.st = bst;
    if (hi > lo) bar = xcd_barrier_post(ctl + 1024, bst);
    if (hi > 1000) cg::this_grid().sync();
#define IN(k) (lo <= (k) && (k) < hi)
#define SEAM(k) do { if (IN(k) && IN((k) + 1)) { xcd_barrier(bar); } } while (0)
    if (IN(0)) { if (bx == 0 && tid == 0) { ctl[0] = 0u; ctl[64] = 0u; }
#if PROBE_REP == 0
        phase0(p, lds, gw, NGW, wave, lane); xcd_barrier(bar);
#endif
        phase0(p, lds, gw, NGW, wave, lane); }
    SEAM(0);
    if (IN(1)) {
        pg8::Gemm g{(const bf16_t*)(ws + WS_HB), (const bf16_t*)(ws + WS_WIN), M, NPROJ, 2048}; pg8::StaticOrder S; S.init(M, NPROJ, G, bx);
        EpiProj E{(bf16_t*)(ws + WS_QLAT), (bf16_t*)(ws + WS_KVLAT), (float*)(ws + WS_SSQL), (bf16_t*)(ws + WS_PROJ), (bf16_t*)(ws + WS_VTD)};
        pg8::gemm_phase<EpiProj, pg8::StaticOrder, true, true>(lds, g, S, E);
#if PROBE_REP == 1
        xcd_barrier(bar); pg8::gemm_phase<EpiProj, pg8::StaticOrder, true, true>(lds, g, S, E);
#endif
    }
    SEAM(1);
    if (IN(3)) {
        p3_pre(p, lds, bx, G, tid, wave, lane);
        __syncthreads();
        { pg8::Gemm g{(const bf16_t*)(ws + WS_QLAT), (const bf16_t*)(ws + WS_WQ), M, 1536, 512}; pg8::StaticOrder S; S.init(M, 1536, G, bx);
          EpiPlain E{(bf16_t*)(ws + WS_QF), 1536};
          pg8::gemm_phase<EpiPlain, pg8::StaticOrder, true, true>(lds, g, S, E); }
        __syncthreads();
        { pg8::Gemm g{(const bf16_t*)(ws + WS_KVLAT), (const bf16_t*)(ws + WS_WKV), M, 2048, 512}; pg8::StaticOrder S; S.init(M, 2048, G, bx);
          EpiKv E{(bf16_t*)(ws + WS_KNOPE), (bf16_t*)(ws + WS_VTM), (const float*)(ws + WS_SSQL)};
          pg8::gemm_phase<EpiKv, pg8::StaticOrder, true, true>(lds, g, S, E); }
    }
#if PROBE_REP == 3
    xcd_barrier(bar);
    if (IN(3)) {
        p3_pre(p, lds, bx, G, tid, wave, lane);
        __syncthreads();
        { pg8::Gemm g{(const bf16_t*)(ws + WS_QLAT), (const bf16_t*)(ws + WS_WQ), M, 1536, 512}; pg8::StaticOrder S; S.init(M, 1536, G, bx);
          EpiPlain E{(bf16_t*)(ws + WS_QF), 1536};
          pg8::gemm_phase<EpiPlain, pg8::StaticOrder, true, true>(lds, g, S, E); }
        __syncthreads();
        { pg8::Gemm g{(const bf16_t*)(ws + WS_KVLAT), (const bf16_t*)(ws + WS_WKV), M, 2048, 512}; pg8::StaticOrder S; S.init(M, 2048, G, bx);
          EpiKv E{(bf16_t*)(ws + WS_KNOPE), (bf16_t*)(ws + WS_VTM), (const float*)(ws + WS_SSQL)};
          pg8::gemm_phase<EpiKv, pg8::StaticOrder, true, true>(lds, g, S, E); }
    }
#endif
#if PROBE_REP == 33
    xcd_barrier(bar);
    if (IN(3)) {
        __syncthreads();
        { pg8::Gemm g{(const bf16_t*)(ws + WS_QLAT), (const bf16_t*)(ws + WS_WQ), M, 1536, 512}; pg8::StaticOrder S; S.init(M, 1536, G, bx);
          EpiPlain E{(bf16_t*)(ws + WS_QF), 1536};
          pg8::gemm_phase<EpiPlain, pg8::StaticOrder, true, true>(lds, g, S, E); }
        __syncthreads();
        { pg8::Gemm g{(const bf16_t*)(ws + WS_KVLAT), (const bf16_t*)(ws + WS_WKV), M, 2048, 512}; pg8::StaticOrder S; S.init(M, 2048, G, bx);
          EpiKv E{(bf16_t*)(ws + WS_KNOPE), (bf16_t*)(ws + WS_VTM), (const float*)(ws + WS_SSQL)};
          pg8::gemm_phase<EpiKv, pg8::StaticOrder, true, true>(lds, g, S, E); }
    }
#endif
    SEAM(3);
    if (IN(4)) phase4(p, gw, NGW, lane);
#if PROBE_REP == 4
    xcd_barrier(bar); phase4(p, gw, NGW, lane);
#endif
#if PROBE_REP == 99
    for (int rep = 0; rep < 10; ++rep) xcd_barrier(bar);
#endif
    SEAM(4);
    if (IN(5)) phase5(p, lds, ctl, tid, wave, lane);
#if PROBE_REP == 5
    xcd_barrier(bar); phase5(p, lds, ctl + 64, tid, wave, lane);
#endif
    SEAM(5);
    if (IN(6)) {
        pg8::Gemm g{(const bf16_t*)(ws + WS_AO), (const bf16_t*)(ws + WS_WO), M, DM, 2048}; pg8::StaticOrder S; S.init(M, DM, G, bx);
        EpiWo E{p.in[0], p.out, (bf16_t*)(ws + WS_X1B), (float*)(ws + WS_SSQ)};
        pg8::gemm_phase<EpiWo, pg8::StaticOrder, true, true>(lds, g, S, E);
#if PROBE_REP == 6
        xcd_barrier(bar); pg8::gemm_phase<EpiWo, pg8::StaticOrder, true, true>(lds, g, S, E);
#endif
    }
    SEAM(6);
    if (IN(7)) {
        pg8::Gemm g{(const bf16_t*)(ws + WS_X1B), (const bf16_t*)(ws + WS_WGU), M, 2 * DFF, 2048}; pg8::StaticOrder S; S.init(M, 2 * DFF, G, bx);
        EpiGateUp E{(const float*)(ws + WS_SSQ), (bf16_t*)(ws + WS_HMID)};
        pg8::gemm_phase<EpiGateUp, pg8::StaticOrder, true, true>(lds, g, S, E);
        { const int nwg = (M / 256) * (2 * DFF / 256), rem = nwg % G;
          if (rem == 0) p0_convert(p, lds, P0_NITEMS - P0_ITEMS_WD, P0_NITEMS, gw, NGW, wave, lane);
          else if (bx >= rem) p0_convert(p, lds, P0_NITEMS - P0_ITEMS_WD, P0_NITEMS, (bx - rem) * NWAVES + wave, (G - rem) * NWAVES, wave, lane); }
#if PROBE_REP == 7
        xcd_barrier(bar); pg8::gemm_phase<EpiGateUp, pg8::StaticOrder, true, true>(lds, g, S, E);
#endif
    }
    SEAM(7);
    if (IN(8)) {
        pg8::Gemm g{(const bf16_t*)(ws + WS_HMID), (const bf16_t*)(ws + WS_WD), M, DM, DFF}; pg8::StaticOrder S; S.init(M, DM, G, bx);
        EpiDown E{(const bf16_t*)(ws + WS_X1B), p.out};
#if PROBE_REP == 8
        { EpiPlain E2{(bf16_t*)(ws + WS_QM), 2048}; pg8::gemm_phase<EpiPlain, pg8::StaticOrder, true, true>(lds, g, S, E2); xcd_barrier(bar); }
#endif
        pg8::gemm_phase<EpiDown, pg8::StaticOrder, true, true>(lds, g, S, E);
    }
#if MK_ONE_LAUNCH
    if (hi > lo) {
        LAS unsigned* shx = (LAS unsigned*)(lds + 163828);
        __syncthreads();
        if (tid == 0) { __threadfence(); shx[0] = (atomicAdd(&ctl[128], 1u) == (unsigned)(G - 1)) ? 1u : 0u; }
        __syncthreads();
        if (shx[0]) { for (int i = tid; i < 8192; i += NTHR) __hip_atomic_store(&ctl[i], 0u, __ATOMIC_RELAXED, __HIP_MEMORY_SCOPE_AGENT); }
    }
#endif
#undef IN
#undef SEAM
}
}

extern "C" void kernel_launch(void* const* d_in, const int* in_sizes, int n_in, void* d_out, int out_size, void* d_ws, size_t ws_size, hipStream_t stream) {
    static int grid = 0;
    if (grid == 0) {
        if (n_in != 22 || out_size != mk::M * mk::DM || ws_size < mk::WS_END) { fprintf(stderr, "kernel_launch: unexpected shapes (n_in %d out %d ws %zu)\n", n_in, out_size, ws_size); grid = -1; return; }
        int dev = 0, cus = 0, per_cu = 0;
        if (hipGetDevice(&dev) != hipSuccess || hipDeviceGetAttribute(&cus, hipDeviceAttributeMultiprocessorCount, dev) != hipSuccess) { grid = -1; return; }
        if (hipFuncSetAttribute((const void*)mk::fwd_kernel, hipFuncAttributeMaxDynamicSharedMemorySize, mk::LDS_BYTES) != hipSuccess) { fprintf(stderr, "kernel_launch: hipFuncSetAttribute failed\n"); grid = -1; return; }
        if (hipOccupancyMaxActiveBlocksPerMultiprocessor(&per_cu, (const void*)mk::fwd_kernel, mk::NTHR, mk::LDS_BYTES) != hipSuccess || per_cu < 1) { fprintf(stderr, "kernel_launch: occupancy query says %d\n", per_cu); per_cu = 1; }
        (void)hipGetLastError();
        grid = cus * per_cu;
    }
    if (grid < 0) return;
#if !MK_ONE_LAUNCH
    if (hipMemsetAsync((char*)d_ws + mk::WS_CTL, 0, 32768, stream) != hipSuccess) { fprintf(stderr, "kernel_launch: hipMemsetAsync failed\n"); return; }
#endif
    mk::Params p{};
    for (int i = 0; i < 22; ++i) p.in[i] = (const float*)d_in[i];
    p.out = (float*)d_out; p.ws = (unsigned char*)d_ws;
#if MK_ONE_LAUNCH
    p.ph_lo = 0; p.ph_hi = 9;
#if PROBE_REP == 77
    { mk::Params p0 = p; p0.ph_lo = 50; p0.ph_hi = 50; void* a0[] = {&p0};
      (void)hipLaunchCooperativeKernel((const void*)mk::fwd_kernel, dim3(grid), dim3(mk::NTHR), a0, mk::LDS_BYTES, stream); }
#endif
    void* args[] = {&p};
    hipError_t e = hipLaunchCooperativeKernel((const void*)mk::fwd_kernel, dim3(grid), dim3(mk::NTHR), args, mk::LDS_BYTES, stream);
    if (e != hipSuccess) fprintf(stderr, "cooperative launch failed: %s (grid %d)\n", hipGetErrorString(e), grid);
#else
    for (int k = 0; k < 9; ++k) { p.ph_lo = k; p.ph_hi = k + 1; hipLaunchKernelGGL(mk::fwd_kernel, dim3(grid), dim3(mk::NTHR), mk::LDS_BYTES, stream, p); }
#endif
}
```

```cpp
#include <hip/hip_runtime.h>
#include <hip/hip_cooperative_groups.h>
#include <cstdio>
#include <cstdint>
namespace cg = cooperative_groups;
namespace pg8 {
#define PG8_LAS __attribute__((address_space(3)))
typedef unsigned short bf16_t;
typedef short bf16x8 __attribute__((ext_vector_type(8)));
typedef float f32x4 __attribute__((ext_vector_type(4)));
typedef unsigned u32x4 __attribute__((ext_vector_type(4)));
constexpr int BM = 256, BK = 64, HALF = 128, HTB = HALF * BK * 2  , STAGE_BYTES = 8 * HTB, NXCD = 8, WGM = 8;

__host__ __device__ __forceinline__ int lds_byte(int r, int c) { const int st = (r >> 4) * 2 + (c >> 5), rr = r & 15, cc = c & 31, ob = rr * 64 + cc * 2; return st * 1024 + (ob ^ (((ob >> 9) & 1) << 5)); }
__host__ __device__ __forceinline__ void stage_rc(int b, int& R, int& C) { const int st = b / 1024, sb = b % 1024, swz = sb ^ (((sb >> 9) & 1) << 5); R = (st >> 1) * 16 + swz / 64; C = (st & 1) * 32 + (swz % 64) / 2; }
__host__ __device__ __forceinline__ int perm32(int rho) { const int n = rho >> 4, i = rho & 15; return 8 * (i >> 2) + 4 * n + (i & 3); }

struct Unit { int pm, pn; };
struct Gemm { const bf16_t* A; const bf16_t* Bt; int M, N, K; };

struct StaticOrder {
    int nM, nN, nwg, G, c;
    __host__ __device__ void init(int M, int N, int G_, int c_) { nM = M / BM; nN = N / BM; nwg = nM * nN; G = G_; c = c_; }
    __host__ __device__ bool next(int i, Unit& u) const {
        const long L = (long)i * G + c; if (L >= nwg) return false;
        int wgid = (int)L; { const int q = nwg / NXCD, r = nwg % NXCD, xcd = wgid % NXCD, off = wgid / NXCD; wgid = (xcd < r ? xcd * (q + 1) : r * (q + 1) + (xcd - r) * q) + off; }
        const int nig = WGM * nN, gid = wgid / nig, fm = gid * WGM, gsz = (nM - fm) < WGM ? (nM - fm) : WGM;
        u.pm = fm + ((wgid % nig) % gsz); u.pn = (wgid % nig) / gsz; return true;
    }
    __device__ __forceinline__ void a_ready(const Unit&) const {}
    __device__ __forceinline__ void done(const Unit&) const {}
};

__device__ __forceinline__ unsigned cvt_pk_bf16(float lo, float hi) { unsigned r; asm volatile("v_cvt_pk_bf16_f32 %0, %1, %2" : "=v"(r) : "v"(lo), "v"(hi)); return r; }
typedef float f32x2 __attribute__((ext_vector_type(2)));
template <class Epi, class Sched, bool ALIGN_EPI = false, bool SP2 = false>
__device__ __forceinline__ void gemm_phase(PG8_LAS unsigned char* lds, const Gemm g, const Sched& S, const Epi& E) {
    const int tid = threadIdx.x, wid = __builtin_amdgcn_readfirstlane(tid >> 6), lane = tid & 63, wr = wid >> 2, wc = wid & 3, fr = lane & 15, fq = lane >> 4;
    const int K = g.K, nt = K / BK;
    unsigned voffA[2], voffB[2];
#pragma unroll
    for (int i = 0; i < 2; ++i) { int R, C; stage_rc(tid * 16 + i * 8192, R, C); const int Rb = Epi::PERM ? ((R & ~31) + perm32(R & 31)) : R;
        voffA[i] = (unsigned)(R * K + C) * 2u; voffB[i] = (unsigned)(Rb * K + C) * 2u; }
    const size_t kstep = (size_t)(BK * 2);
    const size_t hstep = (size_t)HALF * K * 2;
    const size_t tstep = 2 * hstep;
    const unsigned ldsw = (unsigned)wid * 1024u;
    const int aoff = lds_byte(wr * 64 + fr, fq * 8), boff = lds_byte(wc * 32 + fr, fq * 8);
#define PG8_SA(b, h) (((b) * 2 + (h)) * HTB)
#define PG8_SB(b, h) ((4 + (b) * 2 + (h)) * HTB)
#define PG8_STAGE(bufoff, gbase, voff) do { _Pragma("unroll") for (int _i = 0; _i < 2; ++_i) \
        __builtin_amdgcn_global_load_lds((const unsigned*)((const char*)(gbase) + (voff)[_i]), (PG8_LAS unsigned*)(lds + (bufoff) + ldsw + _i * 8192), 16, 0, 0); } while (0)
#define PG8_LDA(dst, b, h) do { _Pragma("unroll") for (int m = 0; m < 4; ++m) _Pragma("unroll") for (int k = 0; k < 2; ++k) dst[m][k] = *(const PG8_LAS bf16x8*)(lds + PG8_SA(b, h) + aoff + m * 2048 + k * 1024); } while (0)
#define PG8_LDB(dst, b, h) do { _Pragma("unroll") for (int n = 0; n < 2; ++n) _Pragma("unroll") for (int k = 0; k < 2; ++k) dst[n][k] = *(const PG8_LAS bf16x8*)(lds + PG8_SB(b, h) + boff + n * 2048 + k * 1024); } while (0)
#define PG8_MMA(ai, bj, At, Bt) do { __builtin_amdgcn_s_setprio(1); _Pragma("unroll") for (int m = 0; m < 4; ++m) _Pragma("unroll") for (int n = 0; n < 2; ++n) _Pragma("unroll") for (int k = 0; k < 2; ++k) \
        acc[ai][bj][m][n] = __builtin_amdgcn_mfma_f32_16x16x32_bf16(Bt[n][k], At[m][k], acc[ai][bj][m][n], 0, 0, 0); __builtin_amdgcn_s_setprio(0); } while (0)
#define PG8_WAIT_V(n) asm volatile("s_waitcnt vmcnt(" #n ")" ::: "memory")
#define PG8_WAIT_L(n) asm volatile("s_waitcnt lgkmcnt(" #n ")" ::: "memory")
#define PG8_BAR __builtin_amdgcn_s_barrier()
#define PG8_SCHED __builtin_amdgcn_sched_barrier(0)
    Unit cur, nxt; int ui = 0;
    if (!S.next(0, cur)) return;
    f32x4 acc[2][2][4][2];
#pragma unroll
    for (int a = 0; a < 2; ++a)
#pragma unroll
        for (int b = 0; b < 2; ++b)
#pragma unroll
            for (int m = 0; m < 4; ++m)
#pragma unroll
                for (int n = 0; n < 2; ++n) acc[a][b][m][n] = (f32x4){0.f, 0.f, 0.f, 0.f};
    bf16x8 At[4][2], B0[2][2], B1[2][2];
    const char* cA = (const char*)g.A + (size_t)cur.pm * tstep; const char* cB = (const char*)g.Bt + (size_t)cur.pn * tstep;
    S.a_ready(cur);
    if constexpr (SP2) {
        PG8_STAGE(PG8_SB(0, 0), cB, voffB); PG8_STAGE(PG8_SB(0, 1), cB + hstep, voffB); PG8_STAGE(PG8_SA(0, 0), cA, voffA); PG8_STAGE(PG8_SA(0, 1), cA + hstep, voffA);
        if (wr == 1) PG8_BAR;
        PG8_WAIT_V(2); PG8_BAR;
        PG8_STAGE(PG8_SB(1, 0), cB + kstep, voffB); PG8_STAGE(PG8_SA(1, 0), cA + kstep, voffA); PG8_STAGE(PG8_SB(1, 1), cB + hstep + kstep, voffB);
        PG8_WAIT_V(6); PG8_BAR;
    } else {
        PG8_STAGE(PG8_SB(0, 0), cB, voffB); PG8_STAGE(PG8_SA(0, 0), cA, voffA); PG8_STAGE(PG8_SB(0, 1), cB + hstep, voffB); PG8_STAGE(PG8_SA(0, 1), cA + hstep, voffA);
        if (wr == 1) PG8_BAR;
        PG8_WAIT_V(4); PG8_BAR;
        PG8_STAGE(PG8_SB(1, 0), cB + kstep, voffB); PG8_STAGE(PG8_SA(1, 0), cA + kstep, voffA); PG8_STAGE(PG8_SB(1, 1), cB + hstep + kstep, voffB);
        PG8_WAIT_V(6); PG8_BAR;
    }
    for (;;) {
        const bool has_next = S.next(ui + 1, nxt);
        const char* nA = has_next ? (const char*)g.A + (size_t)nxt.pm * tstep : cA; const char* nB = has_next ? (const char*)g.Bt + (size_t)nxt.pn * tstep : cB;
        for (int t = 0; t < nt; t += 2) {
            const bool last = (t == nt - 2);
            const char* a1 = cA + (size_t)(t + 1) * kstep;
            const char* a2 = last ? nA : cA + (size_t)(t + 2) * kstep; const char* b2 = last ? nB : cB + (size_t)(t + 2) * kstep;
            const char* a3 = a2 + kstep; const char* b3 = b2 + kstep;
            if (last && has_next) S.a_ready(nxt);
            if constexpr (SP2) {
            PG8_LDB(B0, 0, 0); PG8_LDB(B1, 0, 1); PG8_SCHED; PG8_LDA(At, 0, 0); PG8_STAGE(PG8_SA(1, 1), a1 + hstep, voffA);
            PG8_WAIT_V(8); PG8_WAIT_L(0); PG8_BAR; PG8_MMA(0, 0, At, B0); PG8_MMA(0, 1, At, B1); PG8_BAR; PG8_SCHED;
            PG8_LDA(At, 0, 1); PG8_STAGE(PG8_SB(0, 0), b2, voffB); PG8_STAGE(PG8_SB(0, 1), b2 + hstep, voffB); PG8_STAGE(PG8_SA(0, 0), a2, voffA);
            PG8_WAIT_V(8); PG8_WAIT_L(0); PG8_BAR; PG8_MMA(1, 0, At, B0); PG8_MMA(1, 1, At, B1); PG8_BAR; PG8_SCHED;
            PG8_LDB(B0, 1, 0); PG8_LDB(B1, 1, 1); PG8_SCHED; PG8_LDA(At, 1, 0); PG8_STAGE(PG8_SA(0, 1), a2 + hstep, voffA);
            PG8_WAIT_V(8); PG8_WAIT_L(0); PG8_BAR; PG8_MMA(0, 0, At, B0); PG8_MMA(0, 1, At, B1); PG8_BAR; PG8_SCHED;
            PG8_LDA(At, 1, 1); PG8_STAGE(PG8_SB(1, 0), b3, voffB); PG8_STAGE(PG8_SB(1, 1), b3 + hstep, voffB); PG8_STAGE(PG8_SA(1, 0), a3, voffA);
            PG8_WAIT_V(8); PG8_WAIT_L(0); PG8_BAR; PG8_MMA(1, 0, At, B0); PG8_MMA(1, 1, At, B1); PG8_BAR; PG8_SCHED;
            } else {
            PG8_LDB(B0, 0, 0); PG8_SCHED; PG8_LDA(At, 0, 0); PG8_STAGE(PG8_SA(1, 1), a1 + hstep, voffA);
            PG8_WAIT_L(8); PG8_BAR; PG8_WAIT_L(0); PG8_MMA(0, 0, At, B0); PG8_BAR; PG8_SCHED;
            PG8_LDB(B1, 0, 1); PG8_STAGE(PG8_SB(0, 0), b2, voffB);
            PG8_BAR; PG8_WAIT_L(0); PG8_MMA(0, 1, At, B1); PG8_BAR;
            PG8_LDA(At, 0, 1); PG8_STAGE(PG8_SA(0, 0), a2, voffA);
            PG8_BAR; PG8_WAIT_L(0); PG8_MMA(1, 0, At, B0); PG8_BAR; PG8_SCHED;
            PG8_STAGE(PG8_SB(0, 1), b2 + hstep, voffB);
            PG8_WAIT_V(6); PG8_BAR; PG8_MMA(1, 1, At, B1); PG8_BAR;
            PG8_LDB(B0, 1, 0); PG8_SCHED; PG8_LDA(At, 1, 0); PG8_STAGE(PG8_SA(0, 1), a2 + hstep, voffA);
            PG8_WAIT_L(8); PG8_BAR; PG8_WAIT_L(0); PG8_MMA(0, 0, At, B0); PG8_BAR; PG8_SCHED;
            PG8_LDB(B1, 1, 1); PG8_STAGE(PG8_SB(1, 0), b3, voffB);
            PG8_BAR; PG8_WAIT_L(0); PG8_MMA(0, 1, At, B1); PG8_BAR;
            PG8_LDA(At, 1, 1); PG8_STAGE(PG8_SA(1, 0), a3, voffA);
            PG8_BAR; PG8_WAIT_L(0); PG8_MMA(1, 0, At, B0); PG8_BAR; PG8_SCHED;
            PG8_STAGE(PG8_SB(1, 1), b3 + hstep, voffB);
            PG8_WAIT_V(6); PG8_BAR; PG8_MMA(1, 1, At, B1); PG8_BAR;
            }
        }
        if constexpr (ALIGN_EPI) { if (wr == 0) PG8_BAR; }
        if constexpr (!Epi::AFTER_DRAIN) { E(acc, cur, wr, wc, fr, fq); S.done(cur); }
        if (!has_next) break;
#pragma unroll
        for (int a = 0; a < 2; ++a)
#pragma unroll
            for (int b = 0; b < 2; ++b)
#pragma unroll
                for (int m = 0; m < 4; ++m)
#pragma unroll
                    for (int n = 0; n < 2; ++n) acc[a][b][m][n] = (f32x4){0.f, 0.f, 0.f, 0.f};
        cur = nxt; cA = nA; cB = nB; ++ui;
        if constexpr (ALIGN_EPI) { if (wr == 1) PG8_BAR; }
    }
    PG8_WAIT_V(0);
    if constexpr (!ALIGN_EPI) { if (wr == 0) PG8_BAR; }
    PG8_BAR;
    if constexpr (Epi::AFTER_DRAIN) { E.fused(acc, cur, wr, wc, fr, fq, lds, wid, lane); S.done(cur); }
#undef PG8_SA
#undef PG8_SB
#undef PG8_STAGE
#undef PG8_LDA
#undef PG8_LDB
#undef PG8_MMA
#undef PG8_WAIT_V
#undef PG8_WAIT_L
#undef PG8_BAR
#undef PG8_SCHED
}
}

#ifndef PROBE_REP
#define PROBE_REP -1
#endif
#ifndef MK_ONE_LAUNCH
#define MK_ONE_LAUNCH 1
#endif

namespace mk {
#define LAS __attribute__((address_space(3)))
typedef unsigned short bf16_t;
typedef short bf16x8 __attribute__((ext_vector_type(8)));
typedef float f32x4 __attribute__((ext_vector_type(4)));
typedef float f32x16 __attribute__((ext_vector_type(16)));
typedef unsigned u32x4 __attribute__((ext_vector_type(4)));
typedef unsigned u32x2 __attribute__((ext_vector_type(2)));
using pg8::Unit;
using pg8::cvt_pk_bf16;

constexpr int NWAVES = 8, NTHR = 512;
constexpr int M = 8192, DM = 2048, SEQ = 2048;
constexpr int NPROJ = 4096, PROJ_LD = 2048, DFF = 5632;
constexpr float EPS = 1e-6f;
constexpr float LOG2E = 1.4426950408889634f;
constexpr float LOG2_THETA = 18.931568569324174f;
constexpr float LAMBDA_INIT = 0.2f;

constexpr size_t MiB = 1u << 20;
constexpr size_t WS_CTL = 0;
constexpr size_t WS_WIN = 1 * MiB, WS_WQ = 18 * MiB, WS_WKV = 20 * MiB, WS_WO = 22 * MiB, WS_WGU = 30 * MiB, WS_WD = 74 * MiB;
constexpr size_t WS_VTM = 1 * MiB;
constexpr size_t WS_VTD = 74 * MiB;
constexpr size_t WS_HB = 96 * MiB, WS_PROJ = 128 * MiB, WS_QLAT = 160 * MiB, WS_KVLAT = 168 * MiB, WS_SSQL = 176 * MiB, WS_KPE = 177 * MiB;
constexpr size_t WS_QF = 178 * MiB, WS_KNOPE = 202 * MiB, WS_QD = 218 * MiB, WS_KD = 234 * MiB;
constexpr size_t WS_QM = 96 * MiB, WS_KM = 120 * MiB, WS_AO = 144 * MiB, WS_X1B = 96 * MiB, WS_SSQ = 128 * MiB, WS_HMID = 130 * MiB;
constexpr size_t WS_END = 256 * MiB;
constexpr int LDS_BYTES = 163840;

__device__ unsigned g_ctl[8192];
struct Params { const float* in[22]; float* out; unsigned char* ws; int ph_lo, ph_hi; };

__device__ __forceinline__ float bf2f(unsigned short b) { return __uint_as_float((unsigned)b << 16); }
__device__ __forceinline__ float bflo(unsigned w) { return __uint_as_float(w << 16); }
__device__ __forceinline__ float bfhi(unsigned w) { return __uint_as_float(w & 0xffff0000u); }
__device__ __forceinline__ float wave_sum(float v) {
#pragma unroll
    for (int o = 1; o < 64; o <<= 1) v += __shfl_xor(v, o);
    return v;
}
__device__ __forceinline__ int perm16(int s) { return (s & 3) | ((s & 4) << 1) | ((s & 8) >> 1); }
__device__ __forceinline__ void sincos_ang(float ang, float& s, float& c) {
    double rev = (double)ang * 0.15915494309189535;
    rev -= __builtin_rint(rev);
    const float fr = (float)rev;
    s = __builtin_amdgcn_sinf(fr); c = __builtin_amdgcn_cosf(fr);
}
__device__ __forceinline__ float rope_freq(int i, int r) { return exp2f(-(float)(2 * i) / (float)r * LOG2_THETA); }

__device__ __forceinline__ u32x4 pack8(const f32x4& a, const f32x4& b) {
    u32x4 w; w.x = cvt_pk_bf16(a[0], a[1]); w.y = cvt_pk_bf16(a[2], a[3]); w.z = cvt_pk_bf16(b[0], b[1]); w.w = cvt_pk_bf16(b[2], b[3]); return w;
}
__device__ __forceinline__ bf16_t f2bf1(float v) { return (bf16_t)(cvt_pk_bf16(v, v) & 0xffffu); }

__device__ __forceinline__ void store_v(bf16_t* v, int bh, int d0, int r, const f32x4& a, const f32x4& b) {
    *(u32x4*)(v + ((size_t)bh * 2048 + (r & 2047)) * 128 + d0) = pack8(a, b);
}

struct EpiProj {
    static constexpr bool PERM = true, AFTER_DRAIN = false;
    bf16_t* qlat; bf16_t* kvlat; float* ssql; bf16_t* proj; bf16_t* vtd;
    __device__ __forceinline__ void operator()(const f32x4 (&acc)[2][2][4][2], const Unit& u, int wr, int wc, int fr, int fq) const {
        const int row0 = u.pm * 256 + wr * 64 + fr;
        if (u.pn < 4) {
            bf16_t* dst = (u.pn < 2) ? qlat : kvlat; const int t2 = u.pn & 1, lat = u.pn >> 1, col0 = t2 * 256 + wc * 32 + 8 * fq;
#pragma unroll
            for (int ai = 0; ai < 2; ++ai)
#pragma unroll
                for (int m = 0; m < 4; ++m) { const int r = row0 + ai * 128 + m * 16; bf16_t* rowp = dst + (size_t)r * 512 + col0; float sq = 0.f;
#pragma unroll
                    for (int bj = 0; bj < 2; ++bj) { const f32x4 v0 = acc[ai][bj][m][0], v1 = acc[ai][bj][m][1]; *(u32x4*)(rowp + bj * 128) = pack8(v0, v1);
                        sq += (v0[0] * v0[0] + v0[1] * v0[1]) + (v0[2] * v0[2] + v0[3] * v0[3]) + (v1[0] * v1[0] + v1[1] * v1[1]) + (v1[2] * v1[2] + v1[3] * v1[3]); }
                    sq += __shfl_xor(sq, 16); sq += __shfl_xor(sq, 32);
                    if (fq == 0) ssql[(size_t)r * 16 + lat * 8 + t2 * 4 + wc] = sq; }
        } else if (u.pn < 12) {
            const int col0 = (u.pn - 4) * 256 + wc * 32 + 8 * fq;
#pragma unroll
            for (int ai = 0; ai < 2; ++ai)
#pragma unroll
                for (int m = 0; m < 4; ++m) { bf16_t* rowp = proj + (size_t)(row0 + ai * 128 + m * 16) * PROJ_LD + col0;
#pragma unroll
                    for (int bj = 0; bj < 2; ++bj) *(u32x4*)(rowp + bj * 128) = pack8(acc[ai][bj][m][0], acc[ai][bj][m][1]); }
        } else {
#pragma unroll
            for (int ai = 0; ai < 2; ++ai)
#pragma unroll
                for (int m = 0; m < 4; ++m) { const int r = row0 + ai * 128 + m * 16; const int b = r >> 11;
#pragma unroll
                    for (int bj = 0; bj < 2; ++bj) store_v(vtd, b * 8 + 2 * (u.pn - 12) + bj, wc * 32 + 8 * fq, r, acc[ai][bj][m][0], acc[ai][bj][m][1]); }
        }
    }
};
__device__ __forceinline__ float latent_rs(const float* ssql_row8) {
    const f32x4 a = *(const f32x4*)ssql_row8, b = *(const f32x4*)(ssql_row8 + 4);
    return 1.0f / sqrtf((((a[0] + a[1]) + (a[2] + a[3])) + ((b[0] + b[1]) + (b[2] + b[3]))) * (1.0f / 512.0f) + EPS);
}
struct EpiPlain {
    static constexpr bool PERM = true, AFTER_DRAIN = false;
    bf16_t* O; int ldc;
    __device__ __forceinline__ void operator()(const f32x4 (&acc)[2][2][4][2], const Unit& u, int wr, int wc, int fr, int fq) const {
        const int row0 = u.pm * 256 + wr * 64 + fr, col0 = u.pn * 256 + wc * 32 + 8 * fq;
#pragma unroll
        for (int ai = 0; ai < 2; ++ai)
#pragma unroll
            for (int m = 0; m < 4; ++m) { bf16_t* rowp = O + (size_t)(row0 + ai * 128 + m * 16) * ldc + col0;
#pragma unroll
                for (int bj = 0; bj < 2; ++bj) *(u32x4*)(rowp + bj * 128) = pack8(acc[ai][bj][m][0], acc[ai][bj][m][1]); }
    }
};
struct EpiKv {
    static constexpr bool PERM = true, AFTER_DRAIN = false;
    bf16_t* knope; bf16_t* vtm; const float* ssql;
    __device__ __forceinline__ void operator()(const f32x4 (&acc)[2][2][4][2], const Unit& u, int wr, int wc, int fr, int fq) const {
        const int row0 = u.pm * 256 + wr * 64 + fr;
        f32x4 sv[8][2];
#pragma unroll
        for (int k = 0; k < 8; ++k) { const f32x4* sp = (const f32x4*)(ssql + (size_t)(row0 + (k >> 2) * 128 + (k & 3) * 16) * 16 + 8); sv[k][0] = sp[0]; sv[k][1] = sp[1]; }
#pragma unroll
        for (int ai = 0; ai < 2; ++ai)
#pragma unroll
            for (int m = 0; m < 4; ++m) { const int r = row0 + ai * 128 + m * 16; const f32x4 a = sv[ai * 4 + m][0], b = sv[ai * 4 + m][1];
                const float rs = 1.0f / sqrtf((((a[0] + a[1]) + (a[2] + a[3])) + ((b[0] + b[1]) + (b[2] + b[3]))) * (1.0f / 512.0f) + EPS);
                *(u32x4*)(knope + (size_t)r * 1024 + u.pn * 128 + wc * 32 + 8 * fq) = pack8(acc[ai][0][m][0], acc[ai][0][m][1]);
                store_v(vtm, (r >> 11) * 8 + u.pn, wc * 32 + 8 * fq, r, acc[ai][1][m][0] * rs, acc[ai][1][m][1] * rs); }
    }
};
struct EpiWo {
    static constexpr bool PERM = false, AFTER_DRAIN = false;
    const float* x; float* out; bf16_t* x1b; float* ssq;
    __device__ __forceinline__ void operator()(const f32x4 (&acc)[2][2][4][2], const Unit& u, int wr, int wc, int fr, int fq) const {
        const int row0 = u.pm * 256 + wr * 64 + fr, col0 = u.pn * 256 + wc * 32 + 4 * fq;
#pragma unroll
        for (int ai = 0; ai < 2; ++ai) {
            f32x4 xv[4][2][2];
#pragma unroll
            for (int m = 0; m < 4; ++m)
#pragma unroll
                for (int bj = 0; bj < 2; ++bj)
#pragma unroll
                    for (int n = 0; n < 2; ++n) xv[m][bj][n] = *(const f32x4*)(x + (size_t)(row0 + ai * 128 + m * 16) * DM + col0 + bj * 128 + n * 16);
#pragma unroll
            for (int m = 0; m < 4; ++m) { const int r = row0 + ai * 128 + m * 16; const size_t off = (size_t)r * DM + col0; float s = 0.f;
#pragma unroll
                for (int bj = 0; bj < 2; ++bj)
#pragma unroll
                    for (int n = 0; n < 2; ++n) { const size_t o2 = off + bj * 128 + n * 16; const f32x4 v = xv[m][bj][n] + acc[ai][bj][m][n];
                        s += (v[0] * v[0] + v[1] * v[1]) + (v[2] * v[2] + v[3] * v[3]);
                        u32x2 w; w.x = cvt_pk_bf16(v[0], v[1]); w.y = cvt_pk_bf16(v[2], v[3]); *(u32x2*)(x1b + o2) = w; }
                s += __shfl_xor(s, 16); s += __shfl_xor(s, 32);
                if (fq == 0) ssq[(size_t)r * 32 + u.pn * 4 + wc] = s; }
        }
    }
};
struct EpiGateUp {
    static constexpr bool PERM = true, AFTER_DRAIN = false;
    const float* ssq; bf16_t* hmid;
    __device__ __forceinline__ void operator()(const f32x4 (&acc)[2][2][4][2], const Unit& u, int wr, int wc, int fr, int fq) const {
        const int row0 = u.pm * 256 + wr * 64 + fr, col0 = u.pn * 128 + wc * 32 + 8 * fq;
        f32x4 sv[8][2];
#pragma unroll
        for (int k = 0; k < 8; ++k) { const f32x4* sp = (const f32x4*)(ssq + (size_t)(row0 + (k >> 2) * 128 + (k & 3) * 16) * 32) + 2 * fq; sv[k][0] = sp[0]; sv[k][1] = sp[1]; }
        float r2[8];
#pragma unroll
        for (int k = 0; k < 8; ++k) { float s = ((sv[k][0][0] + sv[k][0][1]) + (sv[k][0][2] + sv[k][0][3])) + ((sv[k][1][0] + sv[k][1][1]) + (sv[k][1][2] + sv[k][1][3]));
            s += __shfl_xor(s, 16); s += __shfl_xor(s, 32); r2[k] = 1.0f / sqrtf(s * (1.0f / DM) + EPS); }
#pragma unroll
        for (int ai = 0; ai < 2; ++ai)
#pragma unroll
            for (int m = 0; m < 4; ++m) { const int r = row0 + ai * 128 + m * 16; const float rr = r2[ai * 4 + m];
                f32x4 hv[2];
#pragma unroll
                for (int n = 0; n < 2; ++n)
#pragma unroll
                    for (int e = 0; e < 4; ++e) { const float g = acc[ai][0][m][n][e] * rr, up = acc[ai][1][m][n][e] * rr;
                        const float sg = g * __builtin_amdgcn_rcpf(1.0f + __builtin_amdgcn_exp2f(-g * LOG2E)); hv[n][e] = sg * up; }
                *(u32x4*)(hmid + (size_t)r * DFF + col0) = pack8(hv[0], hv[1]); }
    }
};
struct EpiDown {
    static constexpr bool PERM = false, AFTER_DRAIN = false;
    const bf16_t* x1b; float* out;
    __device__ __forceinline__ void operator()(const f32x4 (&acc)[2][2][4][2], const Unit& u, int wr, int wc, int fr, int fq) const {
        const int row0 = u.pm * 256 + wr * 64 + fr, col0 = u.pn * 256 + wc * 32 + 4 * fq;
#pragma unroll
        for (int ai = 0; ai < 2; ++ai) {
            u32x2 xv[4][2][2];
#pragma unroll
            for (int m = 0; m < 4; ++m)
#pragma unroll
                for (int bj = 0; bj < 2; ++bj)
#pragma unroll
                    for (int n = 0; n < 2; ++n) xv[m][bj][n] = *(const u32x2*)(x1b + (size_t)(row0 + ai * 128 + m * 16) * DM + col0 + bj * 128 + n * 16);
#pragma unroll
            for (int m = 0; m < 4; ++m)
#pragma unroll
                for (int bj = 0; bj < 2; ++bj)
#pragma unroll
                    for (int n = 0; n < 2; ++n) { const u32x2 w = xv[m][bj][n]; const f32x4 r = {bflo(w.x), bfhi(w.x), bflo(w.y), bfhi(w.y)};
                        *(f32x4*)(out + (size_t)(row0 + ai * 128 + m * 16) * DM + col0 + bj * 128 + n * 16) = r + acc[ai][bj][m][n]; }
        }
    }
};

struct TItem { const float* src; const float* gain; bf16_t* dst; int ldw, K; bool zero; };
__device__ __forceinline__ TItem p0_item(const Params& p, unsigned char* ws, int it) {
    constexpr int I_IN = 32 * 65, I_Q = 8 * 24, I_KV = 8 * 32, I_O = 32 * 32, I_GU = 32 * 176;
    TItem t; t.gain = nullptr; t.zero = false; int r = it;
    if (r < I_IN) { const int kb = r / 65, nb = r % 65; const int nd = nb * 64; const int ns = nd < 1024 ? nd : (nd < 4096 ? nd + 64 : 1024);
        t.src = p.in[2] + (size_t)(kb * 64) * 4160 + ns; t.ldw = 4160; t.dst = (bf16_t*)(ws + WS_WIN) + (size_t)nd * 2048 + kb * 64; t.K = 2048; return t; } r -= I_IN;
    if (r < I_Q) { const int kb = r / 24, nb = r % 24; t.src = p.in[4] + (size_t)(kb * 64) * 1536 + nb * 64; t.ldw = 1536; t.gain = p.in[3] + kb * 64; t.dst = (bf16_t*)(ws + WS_WQ) + (size_t)(nb * 64) * 512 + kb * 64; t.K = 512; return t; } r -= I_Q;
    if (r < I_KV) { const int kb = r / 32, nb = r % 32; t.src = p.in[6] + (size_t)(kb * 64) * 2048 + nb * 64; t.ldw = 2048; t.gain = p.in[5] + kb * 64; t.dst = (bf16_t*)(ws + WS_WKV) + (size_t)(nb * 64) * 512 + kb * 64; t.K = 512; return t; } r -= I_KV;
    if (r < I_O) { const int kb = r / 32, nb = r % 32; t.src = p.in[17] + (size_t)(kb * 64) * 2048 + nb * 64; t.ldw = 2048; t.dst = (bf16_t*)(ws + WS_WO) + (size_t)(nb * 64) * 2048 + kb * 64; t.K = 2048; return t; } r -= I_O;
    if (r < I_GU) { const int kb = r / 176, nb = r % 176; const int nd = nb * 64; const int tt = nd >> 8, bj = (nd >> 7) & 1, j = nd & 127;
        t.src = (bj ? p.in[20] : p.in[19]) + (size_t)(kb * 64) * DFF + tt * 128 + j; t.ldw = DFF; t.gain = p.in[18] + kb * 64;
        t.dst = (bf16_t*)(ws + WS_WGU) + (size_t)nd * 2048 + kb * 64; t.K = 2048; return t; } r -= I_GU;
    { const int kb = r / 32, nb = r % 32; t.src = p.in[21] + (size_t)(kb * 64) * 2048 + nb * 64; t.ldw = 2048; t.dst = (bf16_t*)(ws + WS_WD) + (size_t)(nb * 64) * DFF + kb * 64; t.K = DFF; return t; }
}
constexpr int P0_NITEMS = 32 * 65 + 8 * 24 + 8 * 32 + 32 * 32 + 32 * 176 + 88 * 32, P0_ITEMS_WD = 88 * 32, P0_ITEMS_EARLY = 32 * 65 + 8 * 24 + 8 * 32, P0_ITEMS_MID = 32 * 32 + 32 * 176;
static_assert(P0_ITEMS_MID == 416 * 16 && P0_ITEMS_EARLY + P0_ITEMS_MID + P0_ITEMS_WD == P0_NITEMS, "conversion item split");
__device__ __forceinline__ void p0_convert(const Params& p, LAS unsigned char* lds, int it0, int NITEMS, int gw, int NGW, int wave, int lane) {
    unsigned char* ws = p.ws;
    LAS float* scr = (LAS float*)(lds + wave * 16640);
    const int ksub = lane >> 4, n4 = (lane & 15) * 4;
    f32x4 v[16];
#define P0_LOAD(T) do { const float* sp_ = (T).src + (size_t)ksub * (T).ldw + n4; \
        _Pragma("unroll") for (int i = 0; i < 16; ++i) v[i] = *(const f32x4*)(sp_ + (size_t)(4 * i) * (T).ldw); } while (0)
    int it = it0 + gw; TItem cur;
    if (it < NITEMS) { cur = p0_item(p, ws, it); P0_LOAD(cur); }
    while (it < NITEMS) {
        if (cur.gain) {
#pragma unroll
            for (int i = 0; i < 16; ++i) v[i] = v[i] * cur.gain[4 * i + ksub];
        }
#pragma unroll
        for (int i = 0; i < 16; ++i) { LAS float* d = scr + (4 * i + ksub) * 65 + n4; d[0] = v[i][0]; d[1] = v[i][1]; d[2] = v[i][2]; d[3] = v[i][3]; }
        const int itn = it + NGW; TItem nxt = cur;
        if (itn < NITEMS) { nxt = p0_item(p, ws, itn); P0_LOAD(nxt); }
        asm volatile("s_waitcnt lgkmcnt(0)" ::: "memory");
        const int c = lane & 7;
#pragma unroll
        for (int j = 0; j < 8; ++j) { const int n = (lane >> 3) + 8 * j; const LAS float* s = scr + (8 * c) * 65 + n;
            u32x4 o; o.x = cvt_pk_bf16(s[0 * 65], s[1 * 65]); o.y = cvt_pk_bf16(s[2 * 65], s[3 * 65]); o.z = cvt_pk_bf16(s[4 * 65], s[5 * 65]); o.w = cvt_pk_bf16(s[6 * 65], s[7 * 65]);
            *(u32x4*)(cur.dst + (size_t)n * cur.K + 8 * c) = o; }
        asm volatile("s_waitcnt lgkmcnt(0)" ::: "memory");
        it = itn; cur = nxt;
    }
#undef P0_LOAD
}
__device__ __forceinline__ void phase0(const Params& p, LAS unsigned char* lds, int gw, int NGW, int wave, int lane) {
    unsigned char* ws = p.ws;
    p0_convert(p, lds, 0, P0_ITEMS_EARLY, gw, NGW, wave, lane);
    const float* x = p.in[0]; const float* g = p.in[1]; bf16_t* hb = (bf16_t*)(ws + WS_HB);
    f32x4 v[8], vn[8];
    if (gw < M) {
#pragma unroll
        for (int j = 0; j < 8; ++j) vn[j] = ((const f32x4*)(x + (size_t)gw * DM) + lane)[64 * j];
    }
    for (int m = gw; m < M; m += NGW) {
        float s = 0.f;
#pragma unroll
        for (int j = 0; j < 8; ++j) { v[j] = vn[j]; s += (v[j][0] * v[j][0] + v[j][1] * v[j][1]) + (v[j][2] * v[j][2] + v[j][3] * v[j][3]); }
        if (m + NGW < M) {
#pragma unroll
            for (int j = 0; j < 8; ++j) vn[j] = ((const f32x4*)(x + (size_t)(m + NGW) * DM) + lane)[64 * j];
        }
        const float rs = 1.0f / sqrtf(wave_sum(s) * (1.0f / DM) + EPS);
        u32x2* o = (u32x2*)(hb + (size_t)m * DM) + lane;
#pragma unroll
        for (int j = 0; j < 8; ++j) { const f32x4 gv = ((const f32x4*)g)[lane + 64 * j]; u32x2 w;
            w.x = cvt_pk_bf16(v[j][0] * rs * gv[0], v[j][1] * rs * gv[1]); w.y = cvt_pk_bf16(v[j][2] * rs * gv[2], v[j][3] * rs * gv[3]); o[64 * j] = w; }
    }
}

__device__ __forceinline__ void unpack8(const u32x4& w, float (&f)[8]) {
    f[0] = bflo(w.x); f[1] = bfhi(w.x); f[2] = bflo(w.y); f[3] = bfhi(w.y); f[4] = bflo(w.z); f[5] = bfhi(w.z); f[6] = bflo(w.w); f[7] = bfhi(w.w);
}
__device__ __forceinline__ u32x4 pack8f(const float (&f)[8]) {
    u32x4 w; w.x = cvt_pk_bf16(f[0], f[1]); w.y = cvt_pk_bf16(f[2], f[3]); w.z = cvt_pk_bf16(f[4], f[5]); w.w = cvt_pk_bf16(f[6], f[7]); return w;
}
__device__ __forceinline__ void latent_norm(const bf16_t* src, const float* g, bf16_t* dst, int lane) {
    float f[8]; unpack8(*(const u32x4*)(src + lane * 8), f); float s = 0.f;
#pragma unroll
    for (int j = 0; j < 8; ++j) s += f[j] * f[j];
    const float rs = 1.0f / sqrtf(wave_sum(s) * (1.0f / 512.0f) + EPS);
#pragma unroll
    for (int j = 0; j < 8; ++j) f[j] = f[j] * rs * g[lane * 8 + j];
    *(u32x4*)(dst + lane * 8) = pack8f(f);
}
__device__ __forceinline__ void diff_row(const u32x4& raw0, const u32x4& raw1, const float (&g)[16], const float (&sn)[8], const float (&cs)[8], bf16_t* o, int sub) {
    float f[16]; { float t[8]; unpack8(raw0, t);
#pragma unroll
        for (int j = 0; j < 8; ++j) f[j] = t[j];
        unpack8(raw1, t);
#pragma unroll
        for (int j = 0; j < 8; ++j) f[8 + j] = t[j]; }
    float ss = 0.f;
#pragma unroll
    for (int j = 0; j < 16; ++j) ss += f[j] * f[j];
    ss += __shfl_xor(ss, 1); ss += __shfl_xor(ss, 2);
    const float rs = 1.0f / sqrtf(ss * (1.0f / 64.0f) + EPS);
#pragma unroll
    for (int j = 0; j < 16; ++j) f[j] = f[j] * rs * g[j];
    if (sub == 0) {
#pragma unroll
        for (int i = 0; i < 8; ++i) { const float a = f[i], bb = f[8 + i]; f[i] = a * cs[i] - bb * sn[i]; f[8 + i] = bb * cs[i] + a * sn[i]; }
    }
    { float t[8];
#pragma unroll
      for (int j = 0; j < 8; ++j) t[j] = f[j];
      *(u32x4*)o = pack8f(t);
#pragma unroll
      for (int j = 0; j < 8; ++j) t[j] = f[8 + j];
      *(u32x4*)(o + 8) = pack8f(t); }
}
__device__ __forceinline__ void kpe_gemm(unsigned char* ws, LAS unsigned char* lds, int blk0, int bstep, int bend, int tid, int wave, int lane) {
    const bf16_t* hb = (const bf16_t*)(ws + WS_HB); const bf16_t* wk = (const bf16_t*)(ws + WS_WIN) + (size_t)4096 * 2048; bf16_t* kpe = (bf16_t*)(ws + WS_KPE);
    const int r32 = lane & 31, h = lane >> 5;
    LAS float* red = (LAS float*)lds;
    for (int blk = blk0; blk < bend; blk += bstep) {
        const int m0 = blk * 32;
        const bf16_t* ap = hb + (size_t)(m0 + r32) * 2048 + wave * 256 + 8 * h;
        const bf16_t* bp = wk + (size_t)r32 * 2048 + wave * 256 + 8 * h;
        f32x16 c0, c1;
#pragma unroll
        for (int i = 0; i < 16; ++i) { c0[i] = 0.f; c1[i] = 0.f; }
#pragma unroll
        for (int ks = 0; ks < 16; ++ks) {
            const bf16x8 a = *(const bf16x8*)(ap + 16 * ks), b0 = *(const bf16x8*)(bp + 16 * ks), b1 = *(const bf16x8*)(bp + (size_t)32 * 2048 + 16 * ks);
            c0 = __builtin_amdgcn_mfma_f32_32x32x16_bf16(a, b0, c0, 0, 0, 0); c1 = __builtin_amdgcn_mfma_f32_32x32x16_bf16(a, b1, c1, 0, 0, 0);
        }
        __syncthreads();
#pragma unroll
        for (int i = 0; i < 16; ++i) { const int tok = (i & 3) + 8 * (i >> 2) + 4 * h; red[(wave * 32 + tok) * 64 + r32] = c0[i]; red[(wave * 32 + tok) * 64 + 32 + r32] = c1[i]; }
        __syncthreads();
        { const int tok = tid >> 4, n4 = (tid & 15) * 4; f32x4 sacc = {0.f, 0.f, 0.f, 0.f};
#pragma unroll
          for (int w8 = 0; w8 < 8; ++w8) sacc = sacc + *(const LAS f32x4*)(red + (w8 * 32 + tok) * 64 + n4);
          u32x2 w; w.x = cvt_pk_bf16(sacc[0], sacc[1]); w.y = cvt_pk_bf16(sacc[2], sacc[3]); *(u32x2*)(kpe + (size_t)(m0 + tok) * 64 + n4) = w; }
    }
}
__device__ __forceinline__ void p3_pre(const Params& p, LAS unsigned char* lds, int bx, int G, int tid, int wave, int lane) {
    unsigned char* ws = p.ws;
    const bf16_t* proj = (const bf16_t*)(ws + WS_PROJ); bf16_t* qd = (bf16_t*)(ws + WS_QD); bf16_t* kd = (bf16_t*)(ws + WS_KD);
    constexpr int NQU = (M / 256) * (1536 / 256);
    int row0, rstep, rend, blk0, bstep, bend;
    if (G == 256) {
        if (bx >= NQU) { row0 = (bx - NQU) * NWAVES + wave; rstep = (256 - NQU) * NWAVES; rend = 4096; blk0 = bx - NQU; bstep = 256 - NQU; bend = 128; }
        else { row0 = 4096 + bx * NWAVES + wave; rstep = NQU * NWAVES; rend = M; blk0 = 128 + bx; bstep = 256; bend = 256; }
    } else { row0 = bx * NWAVES + wave; rstep = G * NWAVES; rend = M; blk0 = bx; bstep = G; bend = 256; }
    kpe_gemm(ws, lds, blk0, bstep, bend, tid, wave, lane);
    const int sub = lane & 3, hc = lane >> 2;
    float gq[16], gk[16], frq[8];
#pragma unroll
    for (int j = 0; j < 16; ++j) { gq[j] = p.in[10][sub * 16 + j] * (0.125f * LOG2E); gk[j] = p.in[11][sub * 16 + j]; }
#pragma unroll
    for (int i = 0; i < 8; ++i) frq[i] = rope_freq(i, 16);
    for (int m = row0; m < rend; m += rstep) {
        const bf16_t* pr = proj + (size_t)m * PROJ_LD + lane * 16; const int b = m >> 11, sp = m & 2047;
        const u32x4 q0 = *(const u32x4*)(pr), q1 = *(const u32x4*)(pr + 8), k0 = *(const u32x4*)(pr + 1024), k1 = *(const u32x4*)(pr + 1032);
        float sn[8], cs[8];
#pragma unroll
        for (int i = 0; i < 8; ++i) sincos_ang((float)sp * frq[i], sn[i], cs[i]);
        const size_t off = ((size_t)((b * 16 + hc) * SEQ + sp)) * 64 + sub * 16;
        diff_row(q0, q1, gq, sn, cs, qd + off, sub);
        diff_row(k0, k1, gk, sn, cs, kd + off, sub);
    }
}

__device__ __forceinline__ void mla_row(const u32x4& n0, const u32x4& n1, const u32x4& r0, float rn, float rr, const float (&gn)[16], const float (&gr)[8], const float (&sns)[8], const float (&cs)[8], bf16_t* o, int sub) {
    float fn[16], fr[8];
    { float t[8]; unpack8(n0, t);
#pragma unroll
      for (int j = 0; j < 8; ++j) fn[j] = t[j] * rn;
      unpack8(n1, t);
#pragma unroll
      for (int j = 0; j < 8; ++j) fn[8 + j] = t[j] * rn;
      unpack8(r0, t);
#pragma unroll
      for (int j = 0; j < 8; ++j) fr[j] = t[j] * rr; }
    float ss = 0.f;
#pragma unroll
    for (int j = 0; j < 16; ++j) ss += fn[j] * fn[j];
#pragma unroll
    for (int j = 0; j < 8; ++j) ss += fr[j] * fr[j];
    ss += __shfl_xor(ss, 1); ss += __shfl_xor(ss, 2); ss += __shfl_xor(ss, 4);
    const float rs = 1.0f / sqrtf(ss * (1.0f / 192.0f) + EPS);
#pragma unroll
    for (int j = 0; j < 16; ++j) fn[j] = fn[j] * rs * gn[j];
    float ro[8];
#pragma unroll
    for (int j = 0; j < 8; ++j) { const float v = fr[j] * rs * gr[j]; const float pv = __shfl_xor(v, 4); ro[j] = v * cs[j] + pv * sns[j]; }
    { float t[8];
#pragma unroll
      for (int j = 0; j < 8; ++j) t[j] = fn[j];
      *(u32x4*)(o + sub * 16) = pack8f(t);
#pragma unroll
      for (int j = 0; j < 8; ++j) t[j] = fn[8 + j];
      *(u32x4*)(o + sub * 16 + 8) = pack8f(t); }
    *(u32x4*)(o + 128 + sub * 8) = pack8f(ro);
}
__device__ __forceinline__ void phase4(const Params& p, int gw, int NGW, int lane) {
    unsigned char* ws = p.ws;
    const bf16_t* qf = (const bf16_t*)(ws + WS_QF); const bf16_t* knope = (const bf16_t*)(ws + WS_KNOPE); const bf16_t* kpe = (const bf16_t*)(ws + WS_KPE);
    bf16_t* qm = (bf16_t*)(ws + WS_QM); bf16_t* km = (bf16_t*)(ws + WS_KM);
    const int h = lane >> 3, sub = lane & 7;
    const float qscale = LOG2E / sqrtf(192.0f), sgn = sub < 4 ? -1.0f : 1.0f;
    float gqn[16], gkn[16], gqr[8], gkr[8], frq[8];
#pragma unroll
    for (int j = 0; j < 16; ++j) { gqn[j] = p.in[7][sub * 16 + j] * qscale; gkn[j] = p.in[8][sub * 16 + j]; }
#pragma unroll
    for (int j = 0; j < 8; ++j) { gqr[j] = p.in[7][128 + sub * 8 + j] * qscale; gkr[j] = p.in[8][128 + sub * 8 + j]; frq[j] = rope_freq((sub * 8 + j) & 31, 64); }
    for (int m = gw; m < M; m += NGW) {
        const int b = m >> 11, sp = m & 2047;
        const bf16_t* q0 = qf + (size_t)m * 1536 + h * 192; const bf16_t* k0 = knope + (size_t)m * 1024 + h * 128 + sub * 16;
        const u32x4 qa = *(const u32x4*)(q0 + sub * 16), qb = *(const u32x4*)(q0 + sub * 16 + 8), qc = *(const u32x4*)(q0 + 128 + sub * 8);
        const u32x4 ka = *(const u32x4*)(k0), kb = *(const u32x4*)(k0 + 8), kc = *(const u32x4*)(kpe + (size_t)m * 64 + sub * 8);
        const float* sq = (const float*)(ws + WS_SSQL) + (size_t)m * 16; const float rq = latent_rs(sq), rkv = latent_rs(sq + 8);
        float sns[8], cs[8];
#pragma unroll
        for (int j = 0; j < 8; ++j) { float sv; sincos_ang((float)sp * frq[j], sv, cs[j]); sns[j] = sv * sgn; }
        const size_t off = ((size_t)((b * 8 + h) * SEQ + sp)) * 192;
        mla_row(qa, qb, qc, rq, rq, gqn, gqr, sns, cs, qm + off, sub);
        mla_row(ka, kb, kc, rkv, 1.0f, gkn, gkr, sns, cs, km + off, sub);
    }
}

#define MFMA32(a, b, c) __builtin_amdgcn_mfma_f32_32x32x16_bf16((a), (b), (c), 0, 0, 0)
typedef short s16x4 __attribute__((ext_vector_type(4)));
__device__ __forceinline__ s16x4 vtr(const LAS unsigned char* p) { return __builtin_bit_cast(s16x4, __builtin_amdgcn_ds_read_tr16_b64_v4i16((LAS s16x4*)p)); }
template <int DQK>
__device__ __forceinline__ void attn_pass(f32x16 (&o)[4], const bf16_t* Qh, const bf16_t* Kh, const bf16_t* Vth, int q0, LAS unsigned char* lds, int tid, int w, int lane) {
    constexpr int KSTR = DQK * 2 + 16, VSTR = 320, NKC = (64 * DQK * 2 / 16) / NTHR, CPR = DQK / 8, KB = 64 * KSTR, VB = 64 * VSTR;
    static_assert(NKC * NTHR * 16 == 64 * DQK * 2, "K tile chunks");
    constexpr bool PIPE = false; constexpr int KA = PIPE ? 1 : 0;
    constexpr int QKB = (DQK == 64) ? 4 : 2, PVB = (DQK == 64) ? 2 : 1;
    constexpr float THR = 8.0f;
    LAS unsigned char* Ks = lds; LAS unsigned char* Vs = lds + 2 * KB;
    const int r32 = lane & 31, h = lane >> 5;
    bf16x8 qf[DQK / 16];
    { const bf16_t* qrow = Qh + (size_t)(q0 + 32 * w + r32) * DQK + 8 * h;
#pragma unroll
      for (int d0 = 0; d0 < DQK / 16; ++d0) qf[d0] = *(const bf16x8*)(qrow + 16 * d0); }
    float m_run = -INFINITY, l_lane = 0.f;
#pragma unroll
    for (int db = 0; db < 4; ++db)
#pragma unroll
        for (int i = 0; i < 16; ++i) o[db][i] = 0.f;
    const int NT = (q0 + 256) >> 6, tmax = (q0 >> 6) + (w >> 1);
    const int qg = q0 + 32 * w + r32;
    u32x4 kreg[NKC], vreg[2];
#define ATT_LDK(R, t) do { _Pragma("unroll") for (int j = 0; j < NKC; ++j) R[j] = ((const u32x4*)(Kh + (size_t)(t) * 64 * DQK))[tid + NTHR * j]; } while (0)
#define ATT_LDV(t) do { _Pragma("unroll") for (int j = 0; j < 2; ++j) vreg[j] = ((const u32x4*)(Vth + (size_t)(t) * 64 * 128))[tid + NTHR * j]; } while (0)
#define ATT_STK(R, buf) do { _Pragma("unroll") for (int j = 0; j < NKC; ++j) { const int c = tid + NTHR * j; *(LAS u32x4*)(Ks + (buf) * KB + (c / CPR) * KSTR + (c % CPR) * 16) = R[j]; } } while (0)
#define ATT_STV(buf) do { _Pragma("unroll") for (int j = 0; j < 2; ++j) { const int c = tid + NTHR * j; *(LAS u32x4*)(Vs + (buf) * VB + (c >> 4) * VSTR + (c & 15) * 16) = vreg[j]; } } while (0)
#define ATT_QK(P0, P1, buf) do { \
        _Pragma("unroll") for (int i = 0; i < 16; ++i) { P0[i] = 0.f; P1[i] = 0.f; } \
        const LAS unsigned char* ka = Ks + (buf) * KB + r32 * KSTR + h * 16; \
        _Pragma("unroll") for (int g0 = 0; g0 < DQK / 16; g0 += QKB) {         \
            bf16x8 fa[QKB], fb[QKB]; \
            _Pragma("unroll") for (int d = 0; d < QKB; ++d) { fa[d] = *(const LAS bf16x8*)(ka + (g0 + d) * 32); fb[d] = *(const LAS bf16x8*)(ka + 32 * KSTR + (g0 + d) * 32); } \
            _Pragma("unroll") for (int d = 0; d < QKB; ++d) { P0 = MFMA32(fa[d], qf[g0 + d], P0); P1 = MFMA32(fb[d], qf[g0 + d], P1); } \
            __builtin_amdgcn_sched_group_barrier(0x100, 2 * QKB, 0); __builtin_amdgcn_sched_group_barrier(0x008, 2 * QKB, 0); } } while (0)
#define ATT_SMPV(P0, P1, t, buf) do { \
        if ((t) == tmax) { const int kb = 64 * (t) + 4 * h; \
            _Pragma("unroll") for (int i = 0; i < 16; ++i) { const int kv = kb + (i & 3) + 8 * (i >> 2); if (kv > qg) P0[i] = -INFINITY; if (kv + 32 > qg) P1[i] = -INFINITY; } } \
        float mx = fmaxf(P0[0], P1[0]); \
        _Pragma("unroll") for (int i = 1; i < 16; ++i) mx = fmaxf(mx, fmaxf(P0[i], P1[i])); \
        mx = fmaxf(mx, __shfl_xor(mx, 32)); \
        const bool need = mx > m_run + THR; \
        if (__builtin_amdgcn_ballot_w64(need) != 0ull) { \
            const float mnew = need ? mx : m_run, alpha = __builtin_amdgcn_exp2f(m_run - mnew); m_run = mnew; l_lane *= alpha; \
            _Pragma("unroll") for (int db = 0; db < 4; ++db) _Pragma("unroll") for (int i = 0; i < 16; ++i) o[db][i] *= alpha; } \
        float rs = 0.f; \
        _Pragma("unroll") for (int i = 0; i < 16; ++i) { P0[i] = __builtin_amdgcn_exp2f(P0[i] - m_run); P1[i] = __builtin_amdgcn_exp2f(P1[i] - m_run); rs += P0[i] + P1[i]; } \
        l_lane += rs; \
        bf16x8 pb[4]; \
        { u32x4 t0, t1, t2, t3; \
          t0.x = cvt_pk_bf16(P0[0], P0[1]); t0.y = cvt_pk_bf16(P0[2], P0[3]); t0.z = cvt_pk_bf16(P0[4], P0[5]); t0.w = cvt_pk_bf16(P0[6], P0[7]); \
          t1.x = cvt_pk_bf16(P0[8], P0[9]); t1.y = cvt_pk_bf16(P0[10], P0[11]); t1.z = cvt_pk_bf16(P0[12], P0[13]); t1.w = cvt_pk_bf16(P0[14], P0[15]); \
          t2.x = cvt_pk_bf16(P1[0], P1[1]); t2.y = cvt_pk_bf16(P1[2], P1[3]); t2.z = cvt_pk_bf16(P1[4], P1[5]); t2.w = cvt_pk_bf16(P1[6], P1[7]); \
          t3.x = cvt_pk_bf16(P1[8], P1[9]); t3.y = cvt_pk_bf16(P1[10], P1[11]); t3.z = cvt_pk_bf16(P1[12], P1[13]); t3.w = cvt_pk_bf16(P1[14], P1[15]); \
          pb[0] = __builtin_bit_cast(bf16x8, t0); pb[1] = __builtin_bit_cast(bf16x8, t1); pb[2] = __builtin_bit_cast(bf16x8, t2); pb[3] = __builtin_bit_cast(bf16x8, t3); } \
        const LAS unsigned char* va = Vs + (buf) * VB + (4 * h + ((lane & 15) >> 2)) * VSTR + ((lane >> 4) & 1) * 32 + (lane & 3) * 8; \
        _Pragma("unroll") for (int dp = 0; dp < 4; dp += PVB) { \
            s16x4 lo[PVB][4], hi[PVB][4]; \
            _Pragma("unroll") for (int d2 = 0; d2 < PVB; ++d2) _Pragma("unroll") for (int ks = 0; ks < 4; ++ks) { lo[d2][ks] = vtr(va + (dp + d2) * 64 + (ks * 16) * VSTR); hi[d2][ks] = vtr(va + (dp + d2) * 64 + (ks * 16 + 8) * VSTR); } \
            _Pragma("unroll") for (int ks = 0; ks < 4; ++ks) _Pragma("unroll") for (int d2 = 0; d2 < PVB; ++d2) { \
                const bf16x8 a = (bf16x8){lo[d2][ks][0], lo[d2][ks][1], lo[d2][ks][2], lo[d2][ks][3], hi[d2][ks][0], hi[d2][ks][1], hi[d2][ks][2], hi[d2][ks][3]}; o[dp + d2] = MFMA32(a, pb[ks], o[dp + d2]); } \
            __builtin_amdgcn_sched_group_barrier(0x100, 8 * PVB, 0); __builtin_amdgcn_sched_group_barrier(0x008, 4 * PVB, 0); } } while (0)
#define ATT_ITER(C0, C1, N0, N1, tt, B, NB) do { \
        __syncthreads(); \
        if constexpr (PIPE) { if ((tt) + 2 < NT) ATT_STK(kreg, B); } else { if ((tt) + 1 < NT) ATT_STK(kreg, NB); } \
        if ((tt) + 1 < NT) ATT_STV(NB); \
        if ((tt) + 2 + KA < NT) ATT_LDK(kreg, (tt) + 2 + KA); \
        if ((tt) + 2 < NT) ATT_LDV((tt) + 2); \
        if constexpr (PIPE) { if ((tt) + 1 <= tmax) ATT_QK(N0, N1, NB); if ((tt) <= tmax) ATT_SMPV(C0, C1, tt, B); } \
        else { if ((tt) <= tmax) { ATT_QK(C0, C1, B); ATT_SMPV(C0, C1, tt, B); } } } while (0)
    f32x16 pA0, pA1, pB0, pB1;
    if constexpr (PIPE) {
        u32x4 kreg2[NKC];
        ATT_LDK(kreg, 0); ATT_LDV(0); ATT_LDK(kreg2, 1);
        __syncthreads();
        ATT_STK(kreg, 0); ATT_STV(0); ATT_STK(kreg2, 1);
        ATT_LDK(kreg, 2); ATT_LDV(1);
        __syncthreads();
        ATT_QK(pA0, pA1, 0);
        for (int t = 0; t < NT; t += 2) {
            ATT_ITER(pA0, pA1, pB0, pB1, t, 0, 1);
            ATT_ITER(pB0, pB1, pA0, pA1, t + 1, 1, 0);
        }
    } else {
        u32x4 kreg2[NKC], vreg2[2];
        ATT_LDK(kreg, 0); ATT_LDV(0);
        ATT_LDK(kreg2, 1);
#pragma unroll
        for (int j = 0; j < 2; ++j) vreg2[j] = ((const u32x4*)(Vth + (size_t)64 * 128))[tid + NTHR * j];
        __syncthreads();
        ATT_STK(kreg, 0); ATT_STV(0);
#pragma unroll
        for (int j = 0; j < NKC; ++j) kreg[j] = kreg2[j];
#pragma unroll
        for (int j = 0; j < 2; ++j) vreg[j] = vreg2[j];
        for (int t = 0; t < NT; t += 2) {
            ATT_ITER(pA0, pA1, pA0, pA1, t, 0, 1);
            ATT_ITER(pA0, pA1, pA0, pA1, t + 1, 1, 0);
        }
    }
#undef ATT_LDK
#undef ATT_LDV
#undef ATT_STK
#undef ATT_STV
#undef ATT_QK
#undef ATT_SMPV
#undef ATT_ITER
    float l = l_lane + __shfl_xor(l_lane, 32);
    const float inv = 1.0f / l;
#pragma unroll
    for (int db = 0; db < 4; ++db)
#pragma unroll
        for (int i = 0; i < 16; ++i) o[db][i] *= inv;
}
__device__ __forceinline__ void attn_out_store(const f32x16 (&o)[4], const float* gain, float scale, bf16_t* dst_row, int h) {
    float ss = 0.f;
#pragma unroll
    for (int db = 0; db < 4; ++db)
#pragma unroll
        for (int i = 0; i < 16; ++i) ss += o[db][i] * o[db][i];
    ss += __shfl_xor(ss, 32);
    const float rn = scale / sqrtf(ss * (1.0f / 128.0f) + EPS);
#pragma unroll
    for (int db = 0; db < 4; ++db)
#pragma unroll
        for (int g4 = 0; g4 < 4; ++g4) { const int d = 32 * db + 8 * g4 + 4 * h; const f32x4 gv = *(const f32x4*)(gain + d);
            u32x2 w; w.x = cvt_pk_bf16(o[db][4 * g4] * rn * gv[0], o[db][4 * g4 + 1] * rn * gv[1]); w.y = cvt_pk_bf16(o[db][4 * g4 + 2] * rn * gv[2], o[db][4 * g4 + 3] * rn * gv[3]);
            *(u32x2*)(dst_row + d) = w; }
}
__device__ __forceinline__ void phase5(const Params& p, LAS unsigned char* lds, unsigned* ctr, int tid, int wave, int lane) {
    unsigned char* ws = p.ws;
    const bf16_t* qm = (const bf16_t*)(ws + WS_QM); const bf16_t* km = (const bf16_t*)(ws + WS_KM); const bf16_t* vtm = (const bf16_t*)(ws + WS_VTM);
    const bf16_t* qd = (const bf16_t*)(ws + WS_QD); const bf16_t* kd = (const bf16_t*)(ws + WS_KD); const bf16_t* vtd = (const bf16_t*)(ws + WS_VTD);
    bf16_t* ao = (bf16_t*)(ws + WS_AO);
    LAS unsigned* shw = (LAS unsigned*)(lds + 163824);
    float lam;
    { const float a = p.in[12][lane] * p.in[13][lane], b2 = p.in[14][lane] * p.in[15][lane];
      lam = __expf(wave_sum(a)) - __expf(wave_sum(b2)) + LAMBDA_INIT; }
    const int r32 = lane & 31, h = lane >> 5;
    for (;;) {
        __syncthreads();
        if (tid == 0) shw[0] = atomicAdd(ctr, 1u);
        __syncthreads();
        const unsigned uq = shw[0];
        if (uq >= 928u) break;
        const unsigned grp = uq / 29u, ing = uq % 29u;
        if (ing >= 16u) {
            const int cj = (int)(grp * 13u + ing - 16u);
            p0_convert(p, lds, P0_ITEMS_EARLY + 16 * cj, P0_ITEMS_EARLY + 16 * cj + 16, wave, NWAVES, wave, lane);
            continue;
        }
        const unsigned u = grp * 16u + ing;
        const int cls = (int)(u >> 5), bh = (int)(u & 31u);
        const int isdiff = (0x552B >> cls) & 1, qb = (int)((0x0011223345465767ull >> (4 * cls)) & 15ull);
        const int q0 = qb * 256, b = bh >> 3, hd = bh & 7;
        if (!isdiff) {
            f32x16 o[4];
            attn_pass<192>(o, qm + (size_t)bh * SEQ * 192, km + (size_t)bh * SEQ * 192, vtm + (size_t)bh * 128 * SEQ, q0, lds, tid, wave, lane);
            attn_out_store(o, p.in[9], 1.0f, ao + (size_t)(b * SEQ + q0 + 32 * wave + r32) * DM + hd * 128, h);
        } else {
            f32x16 o[4];
            LAS unsigned* st = (LAS unsigned*)(lds + 59392) + wave * 2048 + lane;
            attn_pass<64>(o, qd + (size_t)(bh * 2 + 1) * SEQ * 64, kd + (size_t)(bh * 2 + 1) * SEQ * 64, vtd + (size_t)bh * 128 * SEQ, q0, lds, tid, wave, lane);
#pragma unroll
            for (int db = 0; db < 4; ++db)
#pragma unroll
                for (int i = 0; i < 16; i += 2) st[(db * 8 + (i >> 1)) * 64] = cvt_pk_bf16(o[db][i], o[db][i + 1]);
            attn_pass<64>(o, qd + (size_t)(bh * 2) * SEQ * 64, kd + (size_t)(bh * 2) * SEQ * 64, vtd + (size_t)bh * 128 * SEQ, q0, lds, tid, wave, lane);
#pragma unroll
            for (int db = 0; db < 4; ++db)
#pragma unroll
                for (int i = 0; i < 16; i += 2) { const unsigned wv = st[(db * 8 + (i >> 1)) * 64]; o[db][i] -= lam * bflo(wv); o[db][i + 1] -= lam * bfhi(wv); }
            attn_out_store(o, p.in[16], 1.0f - LAMBDA_INIT, ao + (size_t)(b * SEQ + q0 + 32 * wave + r32) * DM + hd * 128 + 1024, h);
        }
    }
}

#define XB_TMO      128
#define XB_XCNT(j)  (256  + 64 * (j))
#define XB_XSUB(j)  (1280 + 64 * (j))
#define XB_XGEN(j)  (2304 + 64 * (j))
#define XB_TOP      3328
#define XB_TOPGEN   3392
#define XCD_BAR_WORDS 3456
#define XB_SPIN_CAP (1u << 18)

__device__ __forceinline__ unsigned xb_ld(unsigned* p)              { return __hip_atomic_load(p, __ATOMIC_RELAXED, __HIP_MEMORY_SCOPE_AGENT); }
__device__ __forceinline__ unsigned xb_add(unsigned* p, unsigned v) { return __hip_atomic_fetch_add(p, v, __ATOMIC_RELAXED, __HIP_MEMORY_SCOPE_AGENT); }
__device__ __forceinline__ unsigned xb_xcc_id() { return (unsigned)__builtin_amdgcn_s_getreg((3 << 11) | 20) & 0xFu; }
#define XB_SPIN(cond, bar) do { unsigned _sp = 0; while (cond) { __builtin_amdgcn_s_sleep(1); \
    if ((++_sp & 255u) == 0u) { if (xb_ld(&(bar)[XB_TMO])) break; if (_sp > XB_SPIN_CAP) { atomicAdd(&(bar)[XB_TMO], 1u); break; } } } } while (0)

struct XcdBarrier {
    unsigned* bar; unsigned x;
    volatile LAS unsigned* st;
};

__device__ __forceinline__ XcdBarrier xcd_barrier_post(unsigned* bar, volatile LAS unsigned* st) {
    XcdBarrier b; b.bar = bar; b.x = xb_xcc_id(); b.st = st;
    if (threadIdx.x == 0) (void)xb_add(&bar[XB_XCNT(b.x)], 1u);
    return b;
}
__device__ __forceinline__ void xcd_barrier_complete(unsigned* bar, unsigned x, unsigned& nloc, unsigned& nx) {
    const unsigned G = gridDim.x * gridDim.y * gridDim.z;
    unsigned sum, cnt, mine, sp = 0u;
    for (;;) {
        sum = 0u; cnt = 0u; mine = 0u;
#pragma unroll
        for (unsigned j = 0; j < 16; ++j) { const unsigned c = xb_ld(&bar[XB_XCNT(j)]); sum += c; cnt += (c > 0u) ? 1u : 0u; mine = (j == x) ? c : mine; }
        if (sum == G) break;
        __builtin_amdgcn_s_sleep(1);
        if ((++sp & 255u) == 0u) { if (xb_ld(&bar[XB_TMO])) break; if (sp > XB_SPIN_CAP) { atomicAdd(&bar[XB_TMO], 1u); break; } }
    }
    nloc = mine > 0u ? mine : 1u; nx = cnt > 0u ? cnt : 1u;
}

__device__ __forceinline__ void xcd_barrier(const XcdBarrier& b) {
    asm volatile("s_waitcnt vmcnt(0)" ::: "memory");
    __syncthreads();
    if (threadIdx.x == 0) {
        unsigned* bar = b.bar;
        __builtin_amdgcn_s_waitcnt(0);
        unsigned nloc = b.st[0], nx = b.st[1];
        if (nloc == 0u) { xcd_barrier_complete(bar, b.x, nloc, nx); b.st[0] = nloc; b.st[1] = nx; }
        const unsigned old = xb_add(&bar[XB_XSUB(b.x)], 1u);
        const unsigned gen = old / nloc;
        if (old + 1u == (gen + 1u) * nloc) {
            __builtin_amdgcn_fence(__ATOMIC_RELEASE, "agent");
            asm volatile("s_waitcnt vmcnt(0)" ::: "memory");
            const unsigned og = xb_add(&bar[XB_TOP], 1u);
            const unsigned tg = og / nx;
            if (og + 1u == (tg + 1u) * nx) xb_add(&bar[XB_TOPGEN], 1u);
            else XB_SPIN(xb_ld(&bar[XB_TOPGEN]) == tg, bar);
            __builtin_amdgcn_fence(__ATOMIC_ACQUIRE, "agent");
            xb_add(&bar[XB_XGEN(b.x)], 1u);
            asm volatile("s_waitcnt vmcnt(0)" ::: "memory");
        } else {
            XB_SPIN(xb_ld(&bar[XB_XGEN(b.x)]) == gen, bar);
            __builtin_amdgcn_fence(__ATOMIC_ACQUIRE, "agent");
            asm volatile("s_waitcnt vmcnt(0)" ::: "memory");
        }
    }
    __syncthreads();
}

__global__ void __launch_bounds__(NTHR, 2) fwd_kernel(Params p) {
    extern __shared__ __attribute__((aligned(16))) unsigned char lds_raw[];
    LAS unsigned char* lds = (LAS unsigned char*)lds_raw;
    const int tid = threadIdx.x, lane = tid & 63, wave = __builtin_amdgcn_readfirstlane(tid >> 6);
    const int G = gridDim.x, bx = blockIdx.x;
    const int gw = bx * NWAVES + wave, NGW = G * NWAVES;
    unsigned char* ws = p.ws;
    unsigned* ctl = MK_ONE_LAUNCH ? g_ctl : (unsigned*)(ws + WS_CTL);
    const int lo = p.ph_lo, hi = p.ph_hi;
    volatile LAS unsigned* bst = (volatile LAS unsigned*)(lds + 163808);
    if (tid == 0) { bst[0] = 0u; bst[1] = 0u; }
    __syncthreads();
    XcdBarrier bar; bar.bar = ctl + 1024; bar.x = 0; bar.st = bst;
    if (hi > lo) bar = xcd_barrier_post(ctl + 1024, bst);
    if (hi > 1000) cg::this_grid().sync();
#define IN(k) (lo <= (k) && (k) < hi)
#define SEAM(k) do { if (IN(k) && IN((k) + 1)) { xcd_barrier(bar); } } while (0)
    if (IN(0)) { if (bx == 0 && tid == 0) { ctl[0] = 0u; ctl[64] = 0u; }
#if PROBE_REP == 0
        phase0(p, lds, gw, NGW, wave, lane); xcd_barrier(bar);
#endif
        phase0(p, lds, gw, NGW, wave, lane); }
    SEAM(0);
    if (IN(1)) {
        pg8::Gemm g{(const bf16_t*)(ws + WS_HB), (const bf16_t*)(ws + WS_WIN), M, NPROJ, 2048}; pg8::StaticOrder S; S.init(M, NPROJ, G, bx);
        EpiProj E{(bf16_t*)(ws + WS_QLAT), (bf16_t*)(ws + WS_KVLAT), (float*)(ws + WS_SSQL), (bf16_t*)(ws + WS_PROJ), (bf16_t*)(ws + WS_VTD)};
        pg8::gemm_phase<EpiProj, pg8::StaticOrder, true, true>(lds, g, S, E);
#if PROBE_REP == 1
        xcd_barrier(bar); pg8::gemm_phase<EpiProj, pg8::StaticOrder, true, true>(lds, g, S, E);
#endif
    }
    SEAM(1);
    if (IN(3)) {
        p3_pre(p, lds, bx, G, tid, wave, lane);
        __syncthreads();
        { pg8::Gemm g{(const bf16_t*)(ws + WS_QLAT), (const bf16_t*)(ws + WS_WQ), M, 1536, 512}; pg8::StaticOrder S; S.init(M, 1536, G, bx);
          EpiPlain E{(bf16_t*)(ws + WS_QF), 1536};
          pg8::gemm_phase<EpiPlain, pg8::StaticOrder, true, true>(lds, g, S, E); }
        __syncthreads();
        { pg8::Gemm g{(const bf16_t*)(ws + WS_KVLAT), (const bf16_t*)(ws + WS_WKV), M, 2048, 512}; pg8::StaticOrder S; S.init(M, 2048, G, bx);
          EpiKv E{(bf16_t*)(ws + WS_KNOPE), (bf16_t*)(ws + WS_VTM), (const float*)(ws + WS_SSQL)};
          pg8::gemm_phase<EpiKv, pg8::StaticOrder, true, true>(lds, g, S, E); }
    }
#if PROBE_REP == 3
    xcd_barrier(bar);
    if (IN(3)) {
        p3_pre(p, lds, bx, G, tid, wave, lane);
        __syncthreads();
        { pg8::Gemm g{(const bf16_t*)(ws + WS_QLAT), (const bf16_t*)(ws + WS_WQ), M, 1536, 512}; pg8::StaticOrder S; S.init(M, 1536, G, bx);
          EpiPlain E{(bf16_t*)(ws + WS_QF), 1536};
          pg8::gemm_phase<EpiPlain, pg8::StaticOrder, true, true>(lds, g, S, E); }
        __syncthreads();
        { pg8::Gemm g{(const bf16_t*)(ws + WS_KVLAT), (const bf16_t*)(ws + WS_WKV), M, 2048, 512}; pg8::StaticOrder S; S.init(M, 2048, G, bx);
          EpiKv E{(bf16_t*)(ws + WS_KNOPE), (bf16_t*)(ws + WS_VTM), (const float*)(ws + WS_SSQL)};
          pg8::gemm_phase<EpiKv, pg8::StaticOrder, true, true>(lds, g, S, E); }
    }
#endif
#if PROBE_REP == 33
    xcd_barrier(bar);
    if (IN(3)) {
        __syncthreads();
        { pg8::Gemm g{(const bf16_t*)(ws + WS_QLAT), (const bf16_t*)(ws + WS_WQ), M, 1536, 512}; pg8::StaticOrder S; S.init(M, 1536, G, bx);
          EpiPlain E{(bf16_t*)(ws + WS_QF), 1536};
          pg8::gemm_phase<EpiPlain, pg8::StaticOrder, true, true>(lds, g, S, E); }
        __syncthreads();
        { pg8::Gemm g{(const bf16_t*)(ws + WS_KVLAT), (const bf16_t*)(ws + WS_WKV), M, 2048, 512}; pg8::StaticOrder S; S.init(M, 2048, G, bx);
          EpiKv E{(bf16_t*)(ws + WS_KNOPE), (bf16_t*)(ws + WS_VTM), (const float*)(ws + WS_SSQL)};
          pg8::gemm_phase<EpiKv, pg8::StaticOrder, true, true>(lds, g, S, E); }
    }
#endif
    SEAM(3);
    if (IN(4)) phase4(p, gw, NGW, lane);
#if PROBE_REP == 4
    xcd_barrier(bar); phase4(p, gw, NGW, lane);
#endif
#if PROBE_REP == 99
    for (int rep = 0; rep < 10; ++rep) xcd_barrier(bar);
#endif
    SEAM(4);
    if (IN(5)) phase5(p, lds, ctl, tid, wave, lane);
#if PROBE_REP == 5
    xcd_barrier(bar); phase5(p, lds, ctl + 64, tid, wave, lane);
#endif
    SEAM(5);
    if (IN(6)) {
        pg8::Gemm g{(const bf16_t*)(ws + WS_AO), (const bf16_t*)(ws + WS_WO), M, DM, 2048}; pg8::StaticOrder S; S.init(M, DM, G, bx);
        EpiWo E{p.in[0], p.out, (bf16_t*)(ws + WS_X1B), (float*)(ws + WS_SSQ)};
        pg8::gemm_phase<EpiWo, pg8::StaticOrder, true, true>(lds, g, S, E);
#if PROBE_REP == 6
        xcd_barrier(bar); pg8::gemm_phase<EpiWo, pg8::StaticOrder, true, true>(lds, g, S, E);
#endif
    }
    SEAM(6);
    if (IN(7)) {
        pg8::Gemm g{(const bf16_t*)(ws + WS_X1B), (const bf16_t*)(ws + WS_WGU), M, 2 * DFF, 2048}; pg8::StaticOrder S; S.init(M, 2 * DFF, G, bx);
        EpiGateUp E{(const float*)(ws + WS_SSQ), (bf16_t*)(ws + WS_HMID)};
        pg8::gemm_phase<EpiGateUp, pg8::StaticOrder, true, true>(lds, g, S, E);
        { const int nwg = (M / 256) * (2 * DFF / 256), rem = nwg % G;
          if (rem == 0) p0_convert(p, lds, P0_NITEMS - P0_ITEMS_WD, P0_NITEMS, gw, NGW, wave, lane);
          else if (bx >= rem) p0_convert(p, lds, P0_NITEMS - P0_ITEMS_WD, P0_NITEMS, (bx - rem) * NWAVES + wave, (G - rem) * NWAVES, wave, lane); }
#if PROBE_REP == 7
        xcd_barrier(bar); pg8::gemm_phase<EpiGateUp, pg8::StaticOrder, true, true>(lds, g, S, E);
#endif
    }
    SEAM(7);
    if (IN(8)) {
        pg8::Gemm g{(const bf16_t*)(ws + WS_HMID), (const bf16_t*)(ws + WS_WD), M, DM, DFF}; pg8::StaticOrder S; S.init(M, DM, G, bx);
        EpiDown E{(const bf16_t*)(ws + WS_X1B), p.out};
#if PROBE_REP == 8
        { EpiPlain E2{(bf16_t*)(ws + WS_QM), 2048}; pg8::gemm_phase<EpiPlain, pg8::StaticOrder, true, true>(lds, g, S, E2); xcd_barrier(bar); }
#endif
        pg8::gemm_phase<EpiDown, pg8::StaticOrder, true, true>(lds, g, S, E);
    }
#if MK_ONE_LAUNCH
    if (hi > lo) {
        LAS unsigned* shx = (LAS unsigned*)(lds + 163828);
        __syncthreads();
        if (tid == 0) { __threadfence(); shx[0] = (atomicAdd(&ctl[128], 1u) == (unsigned)(G - 1)) ? 1u : 0u; }
        __syncthreads();
        if (shx[0]) { for (int i = tid; i < 8192; i += NTHR) __hip_atomic_store(&ctl[i], 0u, __ATOMIC_RELAXED, __HIP_MEMORY_SCOPE_AGENT); }
    }
#endif
#undef IN
#undef SEAM
}
}

extern "C" void kernel_launch(void* const* d_in, const int* in_sizes, int n_in, void* d_out, int out_size, void* d_ws, size_t ws_size, hipStream_t stream) {
    static int grid = 0;
    if (grid == 0) {
        if (n_in != 22 || out_size != mk::M * mk::DM || ws_size < mk::WS_END) { fprintf(stderr, "kernel_launch: unexpected shapes (n_in %d out %d ws %zu)\n", n_in, out_size, ws_size); grid = -1; return; }
        int dev = 0, cus = 0, per_cu = 0;
        if (hipGetDevice(&dev) != hipSuccess || hipDeviceGetAttribute(&cus, hipDeviceAttributeMultiprocessorCount, dev) != hipSuccess) { grid = -1; return; }
        if (hipFuncSetAttribute((const void*)mk::fwd_kernel, hipFuncAttributeMaxDynamicSharedMemorySize, mk::LDS_BYTES) != hipSuccess) { fprintf(stderr, "kernel_launch: hipFuncSetAttribute failed\n"); grid = -1; return; }
        if (hipOccupancyMaxActiveBlocksPerMultiprocessor(&per_cu, (const void*)mk::fwd_kernel, mk::NTHR, mk::LDS_BYTES) != hipSuccess || per_cu < 1) { fprintf(stderr, "kernel_launch: occupancy query says %d\n", per_cu); per_cu = 1; }
        (void)hipGetLastError();
        grid = cus * per_cu;
    }
    if (grid < 0) return;
#if !MK_ONE_LAUNCH
    if (hipMemsetAsync((char*)d_ws + mk::WS_CTL, 0, 32768, stream) != hipSuccess) { fprintf(stderr, "kernel_launch: hipMemsetAsync failed\n"); return; }
#endif
    mk::Params p{};
    for (int i = 0; i < 22; ++i) p.in[i] = (const float*)d_in[i];
    p.out = (float*)d_out; p.ws = (unsigned char*)d_ws;
#if MK_ONE_LAUNCH
    p.ph_lo = 0; p.ph_hi = 9;
#if PROBE_REP == 77
    { mk::Params p0 = p; p0.ph_lo = 50; p0.ph_hi = 50; void* a0[] = {&p0};
      (void)hipLaunchCooperativeKernel((const void*)mk::fwd_kernel, dim3(grid), dim3(mk::NTHR), a0, mk::LDS_BYTES, stream); }
#endif
    void* args[] = {&p};
    hipError_t e = hipLaunchCooperativeKernel((const void*)mk::fwd_kernel, dim3(grid), dim3(mk::NTHR), args, mk::LDS_BYTES, stream);
    if (e != hipSuccess) fprintf(stderr, "cooperative launch failed: %s (grid %d)\n", hipGetErrorString(e), grid);
#else
    for (int k = 0; k < 9; ++k) { p.ph_lo = k; p.ph_hi = k + 1; hipLaunchKernelGGL(mk::fwd_kernel, dim3(grid), dim3(mk::NTHR), mk::LDS_BYTES, stream, p); }
#endif
}
```

```cpp
#include <hip/hip_runtime.h>
#include <hip/hip_cooperative_groups.h>
#include <cstdio>
#include <cstdint>
namespace cg = cooperative_groups;
namespace pg8 {
#define PG8_LAS __attribute__((address_space(3)))
typedef unsigned short bf16_t;
typedef short bf16x8 __attribute__((ext_vector_type(8)));
typedef float f32x4 __attribute__((ext_vector_type(4)));
typedef unsigned u32x4 __attribute__((ext_vector_type(4)));
constexpr int BM = 256, BK = 64, HALF = 128, HTB = HALF * BK * 2  , STAGE_BYTES = 8 * HTB, NXCD = 8, WGM = 8;

__host__ __device__ __forceinline__ int lds_byte(int r, int c) { const int st = (r >> 4) * 2 + (c >> 5), rr = r & 15, cc = c & 31, ob = rr * 64 + cc * 2; return st * 1024 + (ob ^ (((ob >> 9) & 1) << 5)); }
__host__ __device__ __forceinline__ void stage_rc(int b, int& R, int& C) { const int st = b / 1024, sb = b % 1024, swz = sb ^ (((sb >> 9) & 1) << 5); R = (st >> 1) * 16 + swz / 64; C = (st & 1) * 32 + (swz % 64) / 2; }
__host__ __device__ __forceinline__ int perm32(int rho) { const int n = rho >> 4, i = rho & 15; return 8 * (i >> 2) + 4 * n + (i & 3); }

struct Unit { int pm, pn; };
struct Gemm { const bf16_t* A; const bf16_t* Bt; int M, N, K; };

struct StaticOrder {
    int nM, nN, nwg, G, c;
    __host__ __device__ void init(int M, int N, int G_, int c_) { nM = M / BM; nN = N / BM; nwg = nM * nN; G = G_; c = c_; }
    __host__ __device__ bool next(int i, Unit& u) const {
        const long L = (long)i * G + c; if (L >= nwg) return false;
        int wgid = (int)L; { const int q = nwg / NXCD, r = nwg % NXCD, xcd = wgid % NXCD, off = wgid / NXCD; wgid = (xcd < r ? xcd * (q + 1) : r * (q + 1) + (xcd - r) * q) + off; }
        const int nig = WGM * nN, gid = wgid / nig, fm = gid * WGM, gsz = (nM - fm) < WGM ? (nM - fm) : WGM;
        u.pm = fm + ((wgid % nig) % gsz); u.pn = (wgid % nig) / gsz; return true;
    }
    __device__ __forceinline__ void a_ready(const Unit&) const {}
    __device__ __forceinline__ void done(const Unit&) const {}
};

__device__ __forceinline__ unsigned cvt_pk_bf16(float lo, float hi) { unsigned r; asm volatile("v_cvt_pk_bf16_f32 %0, %1, %2" : "=v"(r) : "v"(lo), "v"(hi)); return r; }
typedef float f32x2 __attribute__((ext_vector_type(2)));
template <class Epi, class Sched, bool ALIGN_EPI = false, bool SP2 = false>
__device__ __forceinline__ void gemm_phase(PG8_LAS unsigned char* lds, const Gemm g, const Sched& S, const Epi& E) {
    const int tid = threadIdx.x, wid = __builtin_amdgcn_readfirstlane(tid >> 6), lane = tid & 63, wr = wid >> 2, wc = wid & 3, fr = lane & 15, fq = lane >> 4;
    const int K = g.K, nt = K / BK;
    unsigned voffA[2], voffB[2];
#pragma unroll
    for (int i = 0; i < 2; ++i) { int R, C; stage_rc(tid * 16 + i * 8192, R, C); const int Rb = Epi::PERM ? ((R & ~31) + perm32(R & 31)) : R;
        voffA[i] = (unsigned)(R * K + C) * 2u; voffB[i] = (unsigned)(Rb * K + C) * 2u; }
    const size_t kstep = (size_t)(BK * 2);
    const size_t hstep = (size_t)HALF * K * 2;
    const size_t tstep = 2 * hstep;
    const unsigned ldsw = (unsigned)wid * 1024u;
    const int aoff = lds_byte(wr * 64 + fr, fq * 8), boff = lds_byte(wc * 32 + fr, fq * 8);
#define PG8_SA(b, h) (((b) * 2 + (h)) * HTB)
#define PG8_SB(b, h) ((4 + (b) * 2 + (h)) * HTB)
#define PG8_STAGE(bufoff, gbase, voff) do { _Pragma("unroll") for (int _i = 0; _i < 2; ++_i) \
        __builtin_amdgcn_global_load_lds((const unsigned*)((const char*)(gbase) + (voff)[_i]), (PG8_LAS unsigned*)(lds + (bufoff) + ldsw + _i * 8192), 16, 0, 0); } while (0)
#define PG8_LDA(dst, b, h) do { _Pragma("unroll") for (int m = 0; m < 4; ++m) _Pragma("unroll") for (int k = 0; k < 2; ++k) dst[m][k] = *(const PG8_LAS bf16x8*)(lds + PG8_SA(b, h) + aoff + m * 2048 + k * 1024); } while (0)
#define PG8_LDB(dst, b, h) do { _Pragma("unroll") for (int n = 0; n < 2; ++n) _Pragma("unroll") for (int k = 0; k < 2; ++k) dst[n][k] = *(const PG8_LAS bf16x8*)(lds + PG8_SB(b, h) + boff + n * 2048 + k * 1024); } while (0)
#define PG8_MMA(ai, bj, At, Bt) do { __builtin_amdgcn_s_setprio(1); _Pragma("unroll") for (int m = 0; m < 4; ++m) _Pragma("unroll") for (int n = 0; n < 2; ++n) _Pragma("unroll") for (int k = 0; k < 2; ++k) \
        acc[ai][bj][m][n] = __builtin_amdgcn_mfma_f32_16x16x32_bf16(Bt[n][k], At[m][k], acc[ai][bj][m][n], 0, 0, 0); __builtin_amdgcn_s_setprio(0); } while (0)
#define PG8_WAIT_V(n) asm volatile("s_waitcnt vmcnt(" #n ")" ::: "memory")
#define PG8_WAIT_L(n) asm volatile("s_waitcnt lgkmcnt(" #n ")" ::: "memory")
#define PG8_BAR __builtin_amdgcn_s_barrier()
#define PG8_SCHED __builtin_amdgcn_sched_barrier(0)
    Unit cur, nxt; int ui = 0;
    if (!S.next(0, cur)) return;
    f32x4 acc[2][2][4][2];
#pragma unroll
    for (int a = 0; a < 2; ++a)
#pragma unroll
        for (int b = 0; b < 2; ++b)
#pragma unroll
            for (int m = 0; m < 4; ++m)
#pragma unroll
                for (int n = 0; n < 2; ++n) acc[a][b][m][n] = (f32x4){0.f, 0.f, 0.f, 0.f};
    bf16x8 At[4][2], B0[2][2], B1[2][2];
    const char* cA = (const char*)g.A + (size_t)cur.pm * tstep; const char* cB = (const char*)g.Bt + (size_t)cur.pn * tstep;
    S.a_ready(cur);
    if constexpr (SP2) {
        PG8_STAGE(PG8_SB(0, 0), cB, voffB); PG8_STAGE(PG8_SB(0, 1), cB + hstep, voffB); PG8_STAGE(PG8_SA(0, 0), cA, voffA); PG8_STAGE(PG8_SA(0, 1), cA + hstep, voffA);
        if (wr == 1) PG8_BAR;
        PG8_WAIT_V(2); PG8_BAR;
        PG8_STAGE(PG8_SB(1, 0), cB + kstep, voffB); PG8_STAGE(PG8_SA(1, 0), cA + kstep, voffA); PG8_STAGE(PG8_SB(1, 1), cB + hstep + kstep, voffB);
        PG8_WAIT_V(6); PG8_BAR;
    } else {
        PG8_STAGE(PG8_SB(0, 0), cB, voffB); PG8_STAGE(PG8_SA(0, 0), cA, voffA); PG8_STAGE(PG8_SB(0, 1), cB + hstep, voffB); PG8_STAGE(PG8_SA(0, 1), cA + hstep, voffA);
        if (wr == 1) PG8_BAR;
        PG8_WAIT_V(4); PG8_BAR;
        PG8_STAGE(PG8_SB(1, 0), cB + kstep, voffB); PG8_STAGE(PG8_SA(1, 0), cA + kstep, voffA); PG8_STAGE(PG8_SB(1, 1), cB + hstep + kstep, voffB);
        PG8_WAIT_V(6); PG8_BAR;
    }
    for (;;) {
        const bool has_next = S.next(ui + 1, nxt);
        const char* nA = has_next ? (const char*)g.A + (size_t)nxt.pm * tstep : cA; const char* nB = has_next ? (const char*)g.Bt + (size_t)nxt.pn * tstep : cB;
        for (int t = 0; t < nt; t += 2) {
            const bool last = (t == nt - 2);
            const char* a1 = cA + (size_t)(t + 1) * kstep;
            const char* a2 = last ? nA : cA + (size_t)(t + 2) * kstep; const char* b2 = last ? nB : cB + (size_t)(t + 2) * kstep;
            const char* a3 = a2 + kstep; const char* b3 = b2 + kstep;
            if (last && has_next) S.a_ready(nxt);
            if constexpr (SP2) {
            PG8_LDB(B0, 0, 0); PG8_LDB(B1, 0, 1); PG8_SCHED; PG8_LDA(At, 0, 0); PG8_STAGE(PG8_SA(1, 1), a1 + hstep, voffA);
            PG8_WAIT_V(8); PG8_WAIT_L(0); PG8_BAR; PG8_MMA(0, 0, At, B0); PG8_MMA(0, 1, At, B1); PG8_BAR; PG8_SCHED;
            PG8_LDA(At, 0, 1); PG8_STAGE(PG8_SB(0, 0), b2, voffB); PG8_STAGE(PG8_SB(0, 1), b2 + hstep, voffB); PG8_STAGE(PG8_SA(0, 0), a2, voffA);
            PG8_WAIT_V(8); PG8_WAIT_L(0); PG8_BAR; PG8_MMA(1, 0, At, B0); PG8_MMA(1, 1, At, B1); PG8_BAR; PG8_SCHED;
            PG8_LDB(B0, 1, 0); PG8_LDB(B1, 1, 1); PG8_SCHED; PG8_LDA(At, 1, 0); PG8_STAGE(PG8_SA(0, 1), a2 + hstep, voffA);
            PG8_WAIT_V(8); PG8_WAIT_L(0); PG8_BAR; PG8_MMA(0, 0, At, B0); PG8_MMA(0, 1, At, B1); PG8_BAR; PG8_SCHED;
            PG8_LDA(At, 1, 1); PG8_STAGE(PG8_SB(1, 0), b3, voffB); PG8_STAGE(PG8_SB(1, 1), b3 + hstep, voffB); PG8_STAGE(PG8_SA(1, 0), a3, voffA);
            PG8_WAIT_V(8); PG8_WAIT_L(0); PG8_BAR; PG8_MMA(1, 0, At, B0); PG8_MMA(1, 1, At, B1); PG8_BAR; PG8_SCHED;
            } else {
            PG8_LDB(B0, 0, 0); PG8_SCHED; PG8_LDA(At, 0, 0); PG8_STAGE(PG8_SA(1, 1), a1 + hstep, voffA);
            PG8_WAIT_L(8); PG8_BAR; PG8_WAIT_L(0); PG8_MMA(0, 0, At, B0); PG8_BAR; PG8_SCHED;
            PG8_LDB(B1, 0, 1); PG8_STAGE(PG8_SB(0, 0), b2, voffB);
            PG8_BAR; PG8_WAIT_L(0); PG8_MMA(0, 1, At, B1); PG8_BAR;
            PG8_LDA(At, 0, 1); PG8_STAGE(PG8_SA(0, 0), a2, voffA);
            PG8_BAR; PG8_WAIT_L(0); PG8_MMA(1, 0, At, B0); PG8_BAR; PG8_SCHED;
            PG8_STAGE(PG8_SB(0, 1), b2 + hstep, voffB);
            PG8_WAIT_V(6); PG8_BAR; PG8_MMA(1, 1, At, B1); PG8_BAR;
            PG8_LDB(B0, 1, 0); PG8_SCHED; PG8_LDA(At, 1, 0); PG8_STAGE(PG8_SA(0, 1), a2 + hstep, voffA);
            PG8_WAIT_L(8); PG8_BAR; PG8_WAIT_L(0); PG8_MMA(0, 0, At, B0); PG8_BAR; PG8_SCHED;
            PG8_LDB(B1, 1, 1); PG8_STAGE(PG8_SB(1, 0), b3, voffB);
            PG8_BAR; PG8_WAIT_L(0); PG8_MMA(0, 1, At, B1); PG8_BAR;
            PG8_LDA(At, 1, 1); PG8_STAGE(PG8_SA(1, 0), a3, voffA);
            PG8_BAR; PG8_WAIT_L(0); PG8_MMA(1, 0, At, B0); PG8_BAR; PG8_SCHED;
            PG8_STAGE(PG8_SB(1, 1), b3 + hstep, voffB);
            PG8_WAIT_V(6); PG8_BAR; PG8_MMA(1, 1, At, B1); PG8_BAR;
            }
        }
        if constexpr (ALIGN_EPI) { if (wr == 0) PG8_BAR; }
        if constexpr (!Epi::AFTER_DRAIN) { E(acc, cur, wr, wc, fr, fq); S.done(cur); }
        if (!has_next) break;
#pragma unroll
        for (int a = 0; a < 2; ++a)
#pragma unroll
            for (int b = 0; b < 2; ++b)
#pragma unroll
                for (int m = 0; m < 4; ++m)
#pragma unroll
                    for (int n = 0; n < 2; ++n) acc[a][b][m][n] = (f32x4){0.f, 0.f, 0.f, 0.f};
        cur = nxt; cA = nA; cB = nB; ++ui;
        if constexpr (ALIGN_EPI) { if (wr == 1) PG8_BAR; }
    }
    PG8_WAIT_V(0);
    if constexpr (!ALIGN_EPI) { if (wr == 0) PG8_BAR; }
    PG8_BAR;
    if constexpr (Epi::AFTER_DRAIN) { E.fused(acc, cur, wr, wc, fr, fq, lds, wid, lane); S.done(cur); }
#undef PG8_SA
#undef PG8_SB
#undef PG8_STAGE
#undef PG8_LDA
#undef PG8_LDB
#undef PG8_MMA
#undef PG8_WAIT_V
#undef PG8_WAIT_L
#undef PG8_BAR
#undef PG8_SCHED
}
}

#ifndef PROBE_REP
#define PROBE_REP -1
#endif
#ifndef MK_ONE_LAUNCH
#define MK_ONE_LAUNCH 1
#endif

namespace mk {
#define LAS __attribute__((address_space(3)))
typedef unsigned short bf16_t;
typedef short bf16x8 __attribute__((ext_vector_type(8)));
typedef float f32x4 __attribute__((ext_vector_type(4)));
typedef float f32x16 __attribute__((ext_vector_type(16)));
typedef unsigned u32x4 __attribute__((ext_vector_type(4)));
typedef unsigned u32x2 __attribute__((ext_vector_type(2)));
using pg8::Unit;
using pg8::cvt_pk_bf16;

constexpr int NWAVES = 8, NTHR = 512;
constexpr int M = 8192, DM = 2048, SEQ = 2048;
constexpr int NPROJ = 4096, PROJ_LD = 2048, DFF = 5632;
constexpr float EPS = 1e-6f;
constexpr float LOG2E = 1.4426950408889634f;
constexpr float LOG2_THETA = 18.931568569324174f;
constexpr float LAMBDA_INIT = 0.2f;

constexpr size_t MiB = 1u << 20;
constexpr size_t WS_CTL = 0;
constexpr size_t WS_WIN = 1 * MiB, WS_WQ = 18 * MiB, WS_WKV = 18 * MiB + 1536 * 1024, WS_WO = 22 * MiB, WS_WGU = 30 * MiB, WS_WD = 74 * MiB;
constexpr size_t WS_VTM = 1 * MiB;
constexpr size_t WS_VTD = 74 * MiB;
constexpr size_t WS_HB = 96 * MiB, WS_PROJ = 128 * MiB, WS_QLAT = 160 * MiB, WS_KVLAT = 168 * MiB, WS_SSQL = 176 * MiB, WS_KPE = 177 * MiB;
constexpr size_t WS_QF = 178 * MiB, WS_KNOPE = 202 * MiB, WS_QD = 218 * MiB, WS_KD = 234 * MiB;
constexpr size_t WS_QM = 96 * MiB, WS_KM = 120 * MiB, WS_AO = 144 * MiB, WS_X1B = 96 * MiB, WS_SSQ = 128 * MiB, WS_HMID = 130 * MiB;
constexpr size_t WS_END = 256 * MiB;
constexpr int LDS_BYTES = 163840;

__device__ unsigned g_ctl[8192];
struct Params { const float* in[22]; float* out; unsigned char* ws; int ph_lo, ph_hi; };

__device__ __forceinline__ float bf2f(unsigned short b) { return __uint_as_float((unsigned)b << 16); }
__device__ __forceinline__ float bflo(unsigned w) { return __uint_as_float(w << 16); }
__device__ __forceinline__ float bfhi(unsigned w) { return __uint_as_float(w & 0xffff0000u); }
__device__ __forceinline__ float wave_sum(float v) {
#pragma unroll
    for (int o = 1; o < 64; o <<= 1) v += __shfl_xor(v, o);
    return v;
}
__device__ __forceinline__ int perm16(int s) { return (s & 3) | ((s & 4) << 1) | ((s & 8) >> 1); }
__device__ __forceinline__ void sincos_ang(float ang, float& s, float& c) {
    double rev = (double)ang * 0.15915494309189535;
    rev -= __builtin_rint(rev);
    const float fr = (float)rev;
    s = __builtin_amdgcn_sinf(fr); c = __builtin_amdgcn_cosf(fr);
}
__device__ __forceinline__ float rope_freq(int i, int r) { return exp2f(-(float)(2 * i) / (float)r * LOG2_THETA); }

__device__ __forceinline__ u32x4 pack8(const f32x4& a, const f32x4& b) {
    u32x4 w; w.x = cvt_pk_bf16(a[0], a[1]); w.y = cvt_pk_bf16(a[2], a[3]); w.z = cvt_pk_bf16(b[0], b[1]); w.w = cvt_pk_bf16(b[2], b[3]); return w;
}
__device__ __forceinline__ bf16_t f2bf1(float v) { return (bf16_t)(cvt_pk_bf16(v, v) & 0xffffu); }

__device__ __forceinline__ void store_v(bf16_t* v, int bh, int d0, int r, const f32x4& a, const f32x4& b) {
    *(u32x4*)(v + ((size_t)bh * 2048 + (r & 2047)) * 128 + d0) = pack8(a, b);
}

struct EpiProj {
    static constexpr bool PERM = true, AFTER_DRAIN = false;
    bf16_t* qlat; bf16_t* kvlat; float* ssql; bf16_t* proj; bf16_t* vtd;
    __device__ __forceinline__ void operator()(const f32x4 (&acc)[2][2][4][2], const Unit& u, int wr, int wc, int fr, int fq) const {
        const int row0 = u.pm * 256 + wr * 64 + fr;
        if (u.pn < 4) {
            bf16_t* dst = (u.pn < 2) ? qlat : kvlat; const int t2 = u.pn & 1, lat = u.pn >> 1, col0 = t2 * 256 + wc * 32 + 8 * fq;
#pragma unroll
            for (int ai = 0; ai < 2; ++ai)
#pragma unroll
                for (int m = 0; m < 4; ++m) { const int r = row0 + ai * 128 + m * 16; bf16_t* rowp = dst + (size_t)r * 512 + col0; float sq = 0.f;
#pragma unroll
                    for (int bj = 0; bj < 2; ++bj) { const f32x4 v0 = acc[ai][bj][m][0], v1 = acc[ai][bj][m][1]; *(u32x4*)(rowp + bj * 128) = pack8(v0, v1);
                        sq += (v0[0] * v0[0] + v0[1] * v0[1]) + (v0[2] * v0[2] + v0[3] * v0[3]) + (v1[0] * v1[0] + v1[1] * v1[1]) + (v1[2] * v1[2] + v1[3] * v1[3]); }
                    sq += __shfl_xor(sq, 16); sq += __shfl_xor(sq, 32);
                    if (fq == 0) ssql[(size_t)r * 16 + lat * 8 + t2 * 4 + wc] = sq; }
        } else if (u.pn < 12) {
            const int col0 = (u.pn - 4) * 256 + wc * 32 + 8 * fq;
#pragma unroll
            for (int ai = 0; ai < 2; ++ai)
#pragma unroll
                for (int m = 0; m < 4; ++m) { bf16_t* rowp = proj + (size_t)(row0 + ai * 128 + m * 16) * PROJ_LD + col0;
#pragma unroll
                    for (int bj = 0; bj < 2; ++bj) *(u32x4*)(rowp + bj * 128) = pack8(acc[ai][bj][m][0], acc[ai][bj][m][1]); }
        } else {
#pragma unroll
            for (int ai = 0; ai < 2; ++ai)
#pragma unroll
                for (int m = 0; m < 4; ++m) { const int r = row0 + ai * 128 + m * 16; const int b = r >> 11;
#pragma unroll
                    for (int bj = 0; bj < 2; ++bj) store_v(vtd, b * 8 + 2 * (u.pn - 12) + bj, wc * 32 + 8 * fq, r, acc[ai][bj][m][0], acc[ai][bj][m][1]); }
        }
    }
};
__device__ __forceinline__ float latent_rs(const float* ssql_row8) {
    const f32x4 a = *(const f32x4*)ssql_row8, b = *(const f32x4*)(ssql_row8 + 4);
    return 1.0f / sqrtf((((a[0] + a[1]) + (a[2] + a[3])) + ((b[0] + b[1]) + (b[2] + b[3]))) * (1.0f / 512.0f) + EPS);
}
struct EpiPlain {
    static constexpr bool PERM = true, AFTER_DRAIN = false;
    bf16_t* O; int ldc;
    __device__ __forceinline__ void operator()(const f32x4 (&acc)[2][2][4][2], const Unit& u, int wr, int wc, int fr, int fq) const {
        const int row0 = u.pm * 256 + wr * 64 + fr, col0 = u.pn * 256 + wc * 32 + 8 * fq;
#pragma unroll
        for (int ai = 0; ai < 2; ++ai)
#pragma unroll
            for (int m = 0; m < 4; ++m) { bf16_t* rowp = O + (size_t)(row0 + ai * 128 + m * 16) * ldc + col0;
#pragma unroll
                for (int bj = 0; bj < 2; ++bj) *(u32x4*)(rowp + bj * 128) = pack8(acc[ai][bj][m][0], acc[ai][bj][m][1]); }
    }
};
struct EpiKv {
    static constexpr bool PERM = true, AFTER_DRAIN = false;
    bf16_t* knope; bf16_t* vtm; const float* ssql;
    __device__ __forceinline__ void operator()(const f32x4 (&acc)[2][2][4][2], const Unit& u, int wr, int wc, int fr, int fq) const {
        const int row0 = u.pm * 256 + wr * 64 + fr;
        f32x4 sv[8][2];
#pragma unroll
        for (int k = 0; k < 8; ++k) { const f32x4* sp = (const f32x4*)(ssql + (size_t)(row0 + (k >> 2) * 128 + (k & 3) * 16) * 16 + 8); sv[k][0] = sp[0]; sv[k][1] = sp[1]; }
#pragma unroll
        for (int ai = 0; ai < 2; ++ai)
#pragma unroll
            for (int m = 0; m < 4; ++m) { const int r = row0 + ai * 128 + m * 16; const f32x4 a = sv[ai * 4 + m][0], b = sv[ai * 4 + m][1];
                const float rs = 1.0f / sqrtf((((a[0] + a[1]) + (a[2] + a[3])) + ((b[0] + b[1]) + (b[2] + b[3]))) * (1.0f / 512.0f) + EPS);
                *(u32x4*)(knope + (size_t)r * 1024 + u.pn * 128 + wc * 32 + 8 * fq) = pack8(acc[ai][0][m][0], acc[ai][0][m][1]);
                store_v(vtm, (r >> 11) * 8 + u.pn, wc * 32 + 8 * fq, r, acc[ai][1][m][0] * rs, acc[ai][1][m][1] * rs); }
    }
};
struct EpiWo {
    static constexpr bool PERM = false, AFTER_DRAIN = false;
    const float* x; float* out; bf16_t* x1b; float* ssq;
    __device__ __forceinline__ void operator()(const f32x4 (&acc)[2][2][4][2], const Unit& u, int wr, int wc, int fr, int fq) const {
        const int row0 = u.pm * 256 + wr * 64 + fr, col0 = u.pn * 256 + wc * 32 + 4 * fq;
#pragma unroll
        for (int ai = 0; ai < 2; ++ai) {
            f32x4 xv[4][2][2];
#pragma unroll
            for (int m = 0; m < 4; ++m)
#pragma unroll
                for (int bj = 0; bj < 2; ++bj)
#pragma unroll
                    for (int n = 0; n < 2; ++n) xv[m][bj][n] = *(const f32x4*)(x + (size_t)(row0 + ai * 128 + m * 16) * DM + col0 + bj * 128 + n * 16);
#pragma unroll
            for (int m = 0; m < 4; ++m) { const int r = row0 + ai * 128 + m * 16; const size_t off = (size_t)r * DM + col0; float s = 0.f;
#pragma unroll
                for (int bj = 0; bj < 2; ++bj)
#pragma unroll
                    for (int n = 0; n < 2; ++n) { const size_t o2 = off + bj * 128 + n * 16; const f32x4 v = xv[m][bj][n] + acc[ai][bj][m][n];
                        s += (v[0] * v[0] + v[1] * v[1]) + (v[2] * v[2] + v[3] * v[3]);
                        u32x2 w; w.x = cvt_pk_bf16(v[0], v[1]); w.y = cvt_pk_bf16(v[2], v[3]); *(u32x2*)(x1b + o2) = w; }
                s += __shfl_xor(s, 16); s += __shfl_xor(s, 32);
                if (fq == 0) ssq[(size_t)r * 32 + u.pn * 4 + wc] = s; }
        }
    }
};
struct EpiGateUp {
    static constexpr bool PERM = true, AFTER_DRAIN = false;
    const float* ssq; bf16_t* hmid;
    __device__ __forceinline__ void operator()(const f32x4 (&acc)[2][2][4][2], const Unit& u, int wr, int wc, int fr, int fq) const {
        const int row0 = u.pm * 256 + wr * 64 + fr, col0 = u.pn * 128 + wc * 32 + 8 * fq;
        f32x4 sv[8][2];
#pragma unroll
        for (int k = 0; k < 8; ++k) { const f32x4* sp = (const f32x4*)(ssq + (size_t)(row0 + (k >> 2) * 128 + (k & 3) * 16) * 32) + 2 * fq; sv[k][0] = sp[0]; sv[k][1] = sp[1]; }
        float r2[8];
#pragma unroll
        for (int k = 0; k < 8; ++k) { float s = ((sv[k][0][0] + sv[k][0][1]) + (sv[k][0][2] + sv[k][0][3])) + ((sv[k][1][0] + sv[k][1][1]) + (sv[k][1][2] + sv[k][1][3]));
            s += __shfl_xor(s, 16); s += __shfl_xor(s, 32); r2[k] = 1.0f / sqrtf(s * (1.0f / DM) + EPS); }
#pragma unroll
        for (int ai = 0; ai < 2; ++ai)
#pragma unroll
            for (int m = 0; m < 4; ++m) { const int r = row0 + ai * 128 + m * 16; const float rr = r2[ai * 4 + m];
                f32x4 hv[2];
#pragma unroll
                for (int n = 0; n < 2; ++n)
#pragma unroll
                    for (int e = 0; e < 4; ++e) { const float g = acc[ai][0][m][n][e] * rr, up = acc[ai][1][m][n][e] * rr;
                        const float sg = g * __builtin_amdgcn_rcpf(1.0f + __builtin_amdgcn_exp2f(-g * LOG2E)); hv[n][e] = sg * up; }
                *(u32x4*)(hmid + (size_t)r * DFF + col0) = pack8(hv[0], hv[1]); }
    }
};
struct EpiDown {
    static constexpr bool PERM = false, AFTER_DRAIN = false;
    const bf16_t* x1b; float* out;
    __device__ __forceinline__ void operator()(const f32x4 (&acc)[2][2][4][2], const Unit& u, int wr, int wc, int fr, int fq) const {
        const int row0 = u.pm * 256 + wr * 64 + fr, col0 = u.pn * 256 + wc * 32 + 4 * fq;
#pragma unroll
        for (int ai = 0; ai < 2; ++ai) {
            u32x2 xv[4][2][2];
#pragma unroll
            for (int m = 0; m < 4; ++m)
#pragma unroll
                for (int bj = 0; bj < 2; ++bj)
#pragma unroll
                    for (int n = 0; n < 2; ++n) xv[m][bj][n] = *(const u32x2*)(x1b + (size_t)(row0 + ai * 128 + m * 16) * DM + col0 + bj * 128 + n * 16);
#pragma unroll
            for (int m = 0; m < 4; ++m)
#pragma unroll
                for (int bj = 0; bj < 2; ++bj)
#pragma unroll
                    for (int n = 0; n < 2; ++n) { const u32x2 w = xv[m][bj][n]; const f32x4 r = {bflo(w.x), bfhi(w.x), bflo(w.y), bfhi(w.y)};
                        *(f32x4*)(out + (size_t)(row0 + ai * 128 + m * 16) * DM + col0 + bj * 128 + n * 16) = r + acc[ai][bj][m][n]; }
        }
    }
};

struct StackedOrder {
    int G, c;
    __device__ __forceinline__ bool next(int i, Unit& u) const {
        const long L = (long)i * G + c; if (L >= 448) return false;
        pg8::StaticOrder t; t.G = 1; t.c = 0;
        if (L < 256) { t.nM = 32; t.nN = 8; t.nwg = 256; t.next((int)L, u); u.pm += 32; u.pn += 6; }
        else { t.nM = 32; t.nN = 6; t.nwg = 192; t.next((int)L - 256, u); }
        return true;
    }
    __device__ __forceinline__ void a_ready(const Unit&) const {}
    __device__ __forceinline__ void done(const Unit&) const {}
};
struct EpiQKv {
    static constexpr bool PERM = true, AFTER_DRAIN = false;
    EpiPlain q; EpiKv kv;
    __device__ __forceinline__ void operator()(const f32x4 (&acc)[2][2][4][2], const Unit& u, int wr, int wc, int fr, int fq) const {
        if (u.pn < 6) q(acc, u, wr, wc, fr, fq);
        else { Unit v; v.pm = u.pm - 32; v.pn = u.pn - 6; kv(acc, v, wr, wc, fr, fq); }
    }
};

struct TItem { const float* src; const float* gain; bf16_t* dst; int ldw, K; bool zero; };
__device__ __forceinline__ TItem p0_item(const Params& p, unsigned char* ws, int it) {
    constexpr int I_IN = 32 * 65, I_Q = 8 * 24, I_KV = 8 * 32, I_O = 32 * 32, I_GU = 32 * 176;
    TItem t; t.gain = nullptr; t.zero = false; int r = it;
    if (r < I_IN) { const int kb = r / 65, nb = r % 65; const int nd = nb * 64; const int ns = nd < 1024 ? nd : (nd < 4096 ? nd + 64 : 1024);
        t.src = p.in[2] + (size_t)(kb * 64) * 4160 + ns; t.ldw = 4160; t.dst = (bf16_t*)(ws + WS_WIN) + (size_t)nd * 2048 + kb * 64; t.K = 2048; return t; } r -= I_IN;
    if (r < I_Q) { const int kb = r / 24, nb = r % 24; t.src = p.in[4] + (size_t)(kb * 64) * 1536 + nb * 64; t.ldw = 1536; t.gain = p.in[3] + kb * 64; t.dst = (bf16_t*)(ws + WS_WQ) + (size_t)(nb * 64) * 512 + kb * 64; t.K = 512; return t; } r -= I_Q;
    if (r < I_KV) { const int kb = r / 32, nb = r % 32; t.src = p.in[6] + (size_t)(kb * 64) * 2048 + nb * 64; t.ldw = 2048; t.gain = p.in[5] + kb * 64; t.dst = (bf16_t*)(ws + WS_WKV) + (size_t)(nb * 64) * 512 + kb * 64; t.K = 512; return t; } r -= I_KV;
    if (r < I_O) { const int kb = r / 32, nb = r % 32; t.src = p.in[17] + (size_t)(kb * 64) * 2048 + nb * 64; t.ldw = 2048; t.dst = (bf16_t*)(ws + WS_WO) + (size_t)(nb * 64) * 2048 + kb * 64; t.K = 2048; return t; } r -= I_O;
    if (r < I_GU) { const int kb = r / 176, nb = r % 176; const int nd = nb * 64; const int tt = nd >> 8, bj = (nd >> 7) & 1, j = nd & 127;
        t.src = (bj ? p.in[20] : p.in[19]) + (size_t)(kb * 64) * DFF + tt * 128 + j; t.ldw = DFF; t.gain = p.in[18] + kb * 64;
        t.dst = (bf16_t*)(ws + WS_WGU) + (size_t)nd * 2048 + kb * 64; t.K = 2048; return t; } r -= I_GU;
    { const int kb = r / 32, nb = r % 32; t.src = p.in[21] + (size_t)(kb * 64) * 2048 + nb * 64; t.ldw = 2048; t.dst = (bf16_t*)(ws + WS_WD) + (size_t)(nb * 64) * DFF + kb * 64; t.K = DFF; return t; }
}
constexpr int P0_NITEMS = 32 * 65 + 8 * 24 + 8 * 32 + 32 * 32 + 32 * 176 + 88 * 32, P0_ITEMS_WD = 88 * 32, P0_ITEMS_EARLY = 32 * 65 + 8 * 24 + 8 * 32, P0_ITEMS_MID = 32 * 32 + 32 * 176;
static_assert(P0_ITEMS_MID == 416 * 16 && P0_ITEMS_EARLY + P0_ITEMS_MID + P0_ITEMS_WD == P0_NITEMS, "conversion item split");
__device__ __forceinline__ void p0_convert(const Params& p, LAS unsigned char* lds, int it0, int NITEMS, int gw, int NGW, int wave, int lane) {
    unsigned char* ws = p.ws;
    LAS float* scr = (LAS float*)(lds + wave * 16640);
    const int ksub = lane >> 4, n4 = (lane & 15) * 4;
    f32x4 v[16];
#define P0_LOAD(T) do { const float* sp_ = (T).src + (size_t)ksub * (T).ldw + n4; \
        _Pragma("unroll") for (int i = 0; i < 16; ++i) v[i] = *(const f32x4*)(sp_ + (size_t)(4 * i) * (T).ldw); } while (0)
    int it = it0 + gw; TItem cur;
    if (it < NITEMS) { cur = p0_item(p, ws, it); P0_LOAD(cur); }
    while (it < NITEMS) {
        if (cur.gain) {
#pragma unroll
            for (int i = 0; i < 16; ++i) v[i] = v[i] * cur.gain[4 * i + ksub];
        }
#pragma unroll
        for (int i = 0; i < 16; ++i) { LAS float* d = scr + (4 * i + ksub) * 65 + n4; d[0] = v[i][0]; d[1] = v[i][1]; d[2] = v[i][2]; d[3] = v[i][3]; }
        const int itn = it + NGW; TItem nxt = cur;
        if (itn < NITEMS) { nxt = p0_item(p, ws, itn); P0_LOAD(nxt); }
        asm volatile("s_waitcnt lgkmcnt(0)" ::: "memory");
        const int c = lane & 7;
#pragma unroll
        for (int j = 0; j < 8; ++j) { const int n = (lane >> 3) + 8 * j; const LAS float* s = scr + (8 * c) * 65 + n;
            u32x4 o; o.x = cvt_pk_bf16(s[0 * 65], s[1 * 65]); o.y = cvt_pk_bf16(s[2 * 65], s[3 * 65]); o.z = cvt_pk_bf16(s[4 * 65], s[5 * 65]); o.w = cvt_pk_bf16(s[6 * 65], s[7 * 65]);
            *(u32x4*)(cur.dst + (size_t)n * cur.K + 8 * c) = o; }
        asm volatile("s_waitcnt lgkmcnt(0)" ::: "memory");
        it = itn; cur = nxt;
    }
#undef P0_LOAD
}
__device__ __forceinline__ void phase0(const Params& p, LAS unsigned char* lds, int gw, int NGW, int wave, int lane) {
    unsigned char* ws = p.ws;
    p0_convert(p, lds, 0, P0_ITEMS_EARLY, gw, NGW, wave, lane);
    const float* x = p.in[0]; const float* g = p.in[1]; bf16_t* hb = (bf16_t*)(ws + WS_HB);
    f32x4 v[8], vn[8];
    if (gw < M) {
#pragma unroll
        for (int j = 0; j < 8; ++j) vn[j] = ((const f32x4*)(x + (size_t)gw * DM) + lane)[64 * j];
    }
    for (int m = gw; m < M; m += NGW) {
        float s = 0.f;
#pragma unroll
        for (int j = 0; j < 8; ++j) { v[j] = vn[j]; s += (v[j][0] * v[j][0] + v[j][1] * v[j][1]) + (v[j][2] * v[j][2] + v[j][3] * v[j][3]); }
        if (m + NGW < M) {
#pragma unroll
            for (int j = 0; j < 8; ++j) vn[j] = ((const f32x4*)(x + (size_t)(m + NGW) * DM) + lane)[64 * j];
        }
        const float rs = 1.0f / sqrtf(wave_sum(s) * (1.0f / DM) + EPS);
        u32x2* o = (u32x2*)(hb + (size_t)m * DM) + lane;
#pragma unroll
        for (int j = 0; j < 8; ++j) { const f32x4 gv = ((const f32x4*)g)[lane + 64 * j]; u32x2 w;
            w.x = cvt_pk_bf16(v[j][0] * rs * gv[0], v[j][1] * rs * gv[1]); w.y = cvt_pk_bf16(v[j][2] * rs * gv[2], v[j][3] * rs * gv[3]); o[64 * j] = w; }
    }
}

__device__ __forceinline__ void unpack8(const u32x4& w, float (&f)[8]) {
    f[0] = bflo(w.x); f[1] = bfhi(w.x); f[2] = bflo(w.y); f[3] = bfhi(w.y); f[4] = bflo(w.z); f[5] = bfhi(w.z); f[6] = bflo(w.w); f[7] = bfhi(w.w);
}
__device__ __forceinline__ u32x4 pack8f(const float (&f)[8]) {
    u32x4 w; w.x = cvt_pk_bf16(f[0], f[1]); w.y = cvt_pk_bf16(f[2], f[3]); w.z = cvt_pk_bf16(f[4], f[5]); w.w = cvt_pk_bf16(f[6], f[7]); return w;
}
__device__ __forceinline__ void latent_norm(const bf16_t* src, const float* g, bf16_t* dst, int lane) {
    float f[8]; unpack8(*(const u32x4*)(src + lane * 8), f); float s = 0.f;
#pragma unroll
    for (int j = 0; j < 8; ++j) s += f[j] * f[j];
    const float rs = 1.0f / sqrtf(wave_sum(s) * (1.0f / 512.0f) + EPS);
#pragma unroll
    for (int j = 0; j < 8; ++j) f[j] = f[j] * rs * g[lane * 8 + j];
    *(u32x4*)(dst + lane * 8) = pack8f(f);
}
__device__ __forceinline__ void diff_row(const u32x4& raw0, const u32x4& raw1, const float (&g)[16], const float (&sn)[8], const float (&cs)[8], bf16_t* o, int sub) {
    float f[16]; { float t[8]; unpack8(raw0, t);
#pragma unroll
        for (int j = 0; j < 8; ++j) f[j] = t[j];
        unpack8(raw1, t);
#pragma unroll
        for (int j = 0; j < 8; ++j) f[8 + j] = t[j]; }
    float ss = 0.f;
#pragma unroll
    for (int j = 0; j < 16; ++j) ss += f[j] * f[j];
    ss += __shfl_xor(ss, 1); ss += __shfl_xor(ss, 2);
    const float rs = 1.0f / sqrtf(ss * (1.0f / 64.0f) + EPS);
#pragma unroll
    for (int j = 0; j < 16; ++j) f[j] = f[j] * rs * g[j];
    if (sub == 0) {
#pragma unroll
        for (int i = 0; i < 8; ++i) { const float a = f[i], bb = f[8 + i]; f[i] = a * cs[i] - bb * sn[i]; f[8 + i] = bb * cs[i] + a * sn[i]; }
    }
    { float t[8];
#pragma unroll
      for (int j = 0; j < 8; ++j) t[j] = f[j];
      *(u32x4*)o = pack8f(t);
#pragma unroll
      for (int j = 0; j < 8; ++j) t[j] = f[8 + j];
      *(u32x4*)(o + 8) = pack8f(t); }
}
__device__ __forceinline__ void kpe_gemm(unsigned char* ws, LAS unsigned char* lds, int blk0, int bstep, int bend, int tid, int wave, int lane) {
    const bf16_t* hb = (const bf16_t*)(ws + WS_HB); const bf16_t* wk = (const bf16_t*)(ws + WS_WIN) + (size_t)4096 * 2048; bf16_t* kpe = (bf16_t*)(ws + WS_KPE);
    const int r32 = lane & 31, h = lane >> 5;
    LAS float* red = (LAS float*)lds;
    for (int blk = blk0; blk < bend; blk += bstep) {
        const int m0 = blk * 32;
        const bf16_t* ap = hb + (size_t)(m0 + r32) * 2048 + wave * 256 + 8 * h;
        const bf16_t* bp = wk + (size_t)r32 * 2048 + wave * 256 + 8 * h;
        f32x16 c0, c1;
#pragma unroll
        for (int i = 0; i < 16; ++i) { c0[i] = 0.f; c1[i] = 0.f; }
#pragma unroll
        for (int ks = 0; ks < 16; ++ks) {
            const bf16x8 a = *(const bf16x8*)(ap + 16 * ks), b0 = *(const bf16x8*)(bp + 16 * ks), b1 = *(const bf16x8*)(bp + (size_t)32 * 2048 + 16 * ks);
            c0 = __builtin_amdgcn_mfma_f32_32x32x16_bf16(a, b0, c0, 0, 0, 0); c1 = __builtin_amdgcn_mfma_f32_32x32x16_bf16(a, b1, c1, 0, 0, 0);
        }
        __syncthreads();
#pragma unroll
        for (int i = 0; i < 16; ++i) { const int tok = (i & 3) + 8 * (i >> 2) + 4 * h; red[(wave * 32 + tok) * 64 + r32] = c0[i]; red[(wave * 32 + tok) * 64 + 32 + r32] = c1[i]; }
        __syncthreads();
        { const int tok = tid >> 4, n4 = (tid & 15) * 4; f32x4 sacc = {0.f, 0.f, 0.f, 0.f};
#pragma unroll
          for (int w8 = 0; w8 < 8; ++w8) sacc = sacc + *(const LAS f32x4*)(red + (w8 * 32 + tok) * 64 + n4);
          u32x2 w; w.x = cvt_pk_bf16(sacc[0], sacc[1]); w.y = cvt_pk_bf16(sacc[2], sacc[3]); *(u32x2*)(kpe + (size_t)(m0 + tok) * 64 + n4) = w; }
    }
}
__device__ __forceinline__ void p3_pre(const Params& p, LAS unsigned char* lds, int bx, int G, int tid, int wave, int lane) {
    unsigned char* ws = p.ws;
    const bf16_t* proj = (const bf16_t*)(ws + WS_PROJ); bf16_t* qd = (bf16_t*)(ws + WS_QD); bf16_t* kd = (bf16_t*)(ws + WS_KD);
    constexpr int NQU = (M / 256) * (1536 / 256);
    int row0, rstep, rend, blk0, bstep, bend;
    if (G == 256) {
        if (bx >= NQU) { row0 = (bx - NQU) * NWAVES + wave; rstep = (256 - NQU) * NWAVES; rend = 4096; blk0 = bx - NQU; bstep = 256 - NQU; bend = 128; }
        else { row0 = 4096 + bx * NWAVES + wave; rstep = NQU * NWAVES; rend = M; blk0 = 128 + bx; bstep = 256; bend = 256; }
    } else { row0 = bx * NWAVES + wave; rstep = G * NWAVES; rend = M; blk0 = bx; bstep = G; bend = 256; }
    kpe_gemm(ws, lds, blk0, bstep, bend, tid, wave, lane);
    const int sub = lane & 3, hc = lane >> 2;
    float gq[16], gk[16], frq[8];
#pragma unroll
    for (int j = 0; j < 16; ++j) { gq[j] = p.in[10][sub * 16 + j] * (0.125f * LOG2E); gk[j] = p.in[11][sub * 16 + j]; }
#pragma unroll
    for (int i = 0; i < 8; ++i) frq[i] = rope_freq(i, 16);
    for (int m = row0; m < rend; m += rstep) {
        const bf16_t* pr = proj + (size_t)m * PROJ_LD + lane * 16; const int b = m >> 11, sp = m & 2047;
        const u32x4 q0 = *(const u32x4*)(pr), q1 = *(const u32x4*)(pr + 8), k0 = *(const u32x4*)(pr + 1024), k1 = *(const u32x4*)(pr + 1032);
        float sn[8], cs[8];
#pragma unroll
        for (int i = 0; i < 8; ++i) sincos_ang((float)sp * frq[i], sn[i], cs[i]);
        const size_t off = ((size_t)((b * 16 + hc) * SEQ + sp)) * 64 + sub * 16;
        diff_row(q0, q1, gq, sn, cs, qd + off, sub);
        diff_row(k0, k1, gk, sn, cs, kd + off, sub);
    }
}

__device__ __forceinline__ void mla_row(const u32x4& n0, const u32x4& n1, const u32x4& r0, float rn, float rr, const float (&gn)[16], const float (&gr)[8], const float (&sns)[8], const float (&cs)[8], bf16_t* o, int sub) {
    float fn[16], fr[8];
    { float t[8]; unpack8(n0, t);
#pragma unroll
      for (int j = 0; j < 8; ++j) fn[j] = t[j] * rn;
      unpack8(n1, t);
#pragma unroll
      for (int j = 0; j < 8; ++j) fn[8 + j] = t[j] * rn;
      unpack8(r0, t);
#pragma unroll
      for (int j = 0; j < 8; ++j) fr[j] = t[j] * rr; }
    float ss = 0.f;
#pragma unroll
    for (int j = 0; j < 16; ++j) ss += fn[j] * fn[j];
#pragma unroll
    for (int j = 0; j < 8; ++j) ss += fr[j] * fr[j];
    ss += __shfl_xor(ss, 1); ss += __shfl_xor(ss, 2); ss += __shfl_xor(ss, 4);
    const float rs = 1.0f / sqrtf(ss * (1.0f / 192.0f) + EPS);
#pragma unroll
    for (int j = 0; j < 16; ++j) fn[j] = fn[j] * rs * gn[j];
    float ro[8];
#pragma unroll
    for (int j = 0; j < 8; ++j) { const float v = fr[j] * rs * gr[j]; const float pv = __shfl_xor(v, 4); ro[j] = v * cs[j] + pv * sns[j]; }
    { float t[8];
#pragma unroll
      for (int j = 0; j < 8; ++j) t[j] = fn[j];
      *(u32x4*)(o + sub * 16) = pack8f(t);
#pragma unroll
      for (int j = 0; j < 8; ++j) t[j] = fn[8 + j];
      *(u32x4*)(o + sub * 16 + 8) = pack8f(t); }
    *(u32x4*)(o + 128 + sub * 8) = pack8f(ro);
}
__device__ __forceinline__ void phase4(const Params& p, int gw, int NGW, int lane) {
    unsigned char* ws = p.ws;
    const bf16_t* qf = (const bf16_t*)(ws + WS_QF); const bf16_t* knope = (const bf16_t*)(ws + WS_KNOPE); const bf16_t* kpe = (const bf16_t*)(ws + WS_KPE);
    bf16_t* qm = (bf16_t*)(ws + WS_QM); bf16_t* km = (bf16_t*)(ws + WS_KM);
    const int h = lane >> 3, sub = lane & 7;
    const float qscale = LOG2E / sqrtf(192.0f), sgn = sub < 4 ? -1.0f : 1.0f;
    float gqn[16], gkn[16], gqr[8], gkr[8], frq[8];
#pragma unroll
    for (int j = 0; j < 16; ++j) { gqn[j] = p.in[7][sub * 16 + j] * qscale; gkn[j] = p.in[8][sub * 16 + j]; }
#pragma unroll
    for (int j = 0; j < 8; ++j) { gqr[j] = p.in[7][128 + sub * 8 + j] * qscale; gkr[j] = p.in[8][128 + sub * 8 + j]; frq[j] = rope_freq((sub * 8 + j) & 31, 64); }
    for (int m = gw; m < M; m += NGW) {
        const int b = m >> 11, sp = m & 2047;
        const bf16_t* q0 = qf + (size_t)m * 1536 + h * 192; const bf16_t* k0 = knope + (size_t)m * 1024 + h * 128 + sub * 16;
        const u32x4 qa = *(const u32x4*)(q0 + sub * 16), qb = *(const u32x4*)(q0 + sub * 16 + 8), qc = *(const u32x4*)(q0 + 128 + sub * 8);
        const u32x4 ka = *(const u32x4*)(k0), kb = *(const u32x4*)(k0 + 8), kc = *(const u32x4*)(kpe + (size_t)m * 64 + sub * 8);
        const float* sq = (const float*)(ws + WS_SSQL) + (size_t)m * 16; const float rq = latent_rs(sq), rkv = latent_rs(sq + 8);
        float sns[8], cs[8];
#pragma unroll
        for (int j = 0; j < 8; ++j) { float sv; sincos_ang((float)sp * frq[j], sv, cs[j]); sns[j] = sv * sgn; }
        const size_t off = ((size_t)((b * 8 + h) * SEQ + sp)) * 192;
        mla_row(qa, qb, qc, rq, rq, gqn, gqr, sns, cs, qm + off, sub);
        mla_row(ka, kb, kc, rkv, 1.0f, gkn, gkr, sns, cs, km + off, sub);
    }
}

#define MFMA32(a, b, c) __builtin_amdgcn_mfma_f32_32x32x16_bf16((a), (b), (c), 0, 0, 0)
typedef short s16x4 __attribute__((ext_vector_type(4)));
__device__ __forceinline__ float max3f(float a, float b, float c) { float r; asm("v_max3_f32 %0, %1, %2, %3" : "=v"(r) : "v"(a), "v"(b), "v"(c)); return r; }
__device__ __forceinline__ s16x4 vtr(const LAS unsigned char* p) { return __builtin_bit_cast(s16x4, __builtin_amdgcn_ds_read_tr16_b64_v4i16((LAS s16x4*)p)); }
template <int DQK>
__device__ __forceinline__ void attn_pass(f32x16 (&o)[4], const bf16_t* Qh, const bf16_t* Kh, const bf16_t* Vth, int q0, LAS unsigned char* lds, int tid, int w, int lane) {
    constexpr int KSTR = DQK * 2 + 16, VSTR = 320, NKC = (64 * DQK * 2 / 16) / NTHR, CPR = DQK / 8, KB = 64 * KSTR, VB = 64 * VSTR;
    static_assert(NKC * NTHR * 16 == 64 * DQK * 2, "K tile chunks");
    constexpr bool PIPE = false; constexpr int KA = PIPE ? 1 : 0;
    constexpr int QKB = (DQK == 64) ? 4 : 2, PVB = (DQK == 64) ? 2 : 1;
    constexpr float THR = 8.0f;
    LAS unsigned char* Ks = lds; LAS unsigned char* Vs = lds + 2 * KB;
    const int r32 = lane & 31, h = lane >> 5;
    bf16x8 qf[DQK / 16];
    { const bf16_t* qrow = Qh + (size_t)(q0 + 32 * w + r32) * DQK + 8 * h;
#pragma unroll
      for (int d0 = 0; d0 < DQK / 16; ++d0) qf[d0] = *(const bf16x8*)(qrow + 16 * d0); }
    float m_run = -INFINITY, l_lane = 0.f;
#pragma unroll
    for (int db = 0; db < 4; ++db)
#pragma unroll
        for (int i = 0; i < 16; ++i) o[db][i] = 0.f;
    const int NT = (q0 + 256) >> 6, tmax = (q0 >> 6) + (w >> 1);
    const int qg = q0 + 32 * w + r32;
    u32x4 kreg[NKC], vreg[2];
#define ATT_LDK(R, t) do { _Pragma("unroll") for (int j = 0; j < NKC; ++j) R[j] = ((const u32x4*)(Kh + (size_t)(t) * 64 * DQK))[tid + NTHR * j]; } while (0)
#define ATT_LDV(t) do { _Pragma("unroll") for (int j = 0; j < 2; ++j) vreg[j] = ((const u32x4*)(Vth + (size_t)(t) * 64 * 128))[tid + NTHR * j]; } while (0)
#define ATT_STK(R, buf) do { _Pragma("unroll") for (int j = 0; j < NKC; ++j) { const int c = tid + NTHR * j; *(LAS u32x4*)(Ks + (buf) * KB + (c / CPR) * KSTR + (c % CPR) * 16) = R[j]; } } while (0)
#define ATT_STV(buf) do { _Pragma("unroll") for (int j = 0; j < 2; ++j) { const int c = tid + NTHR * j; *(LAS u32x4*)(Vs + (buf) * VB + (c >> 4) * VSTR + (c & 15) * 16) = vreg[j]; } } while (0)
#define ATT_QK(P0, P1, buf) do { \
        _Pragma("unroll") for (int i = 0; i < 16; ++i) { P0[i] = 0.f; P1[i] = 0.f; } \
        const LAS unsigned char* ka = Ks + (buf) * KB + r32 * KSTR + h * 16; \
        _Pragma("unroll") for (int g0 = 0; g0 < DQK / 16; g0 += QKB) {         \
            bf16x8 fa[QKB], fb[QKB]; \
            _Pragma("unroll") for (int d = 0; d < QKB; ++d) { fa[d] = *(const LAS bf16x8*)(ka + (g0 + d) * 32); fb[d] = *(const LAS bf16x8*)(ka + 32 * KSTR + (g0 + d) * 32); } \
            _Pragma("unroll") for (int d = 0; d < QKB; ++d) { P0 = MFMA32(fa[d], qf[g0 + d], P0); P1 = MFMA32(fb[d], qf[g0 + d], P1); } \
            __builtin_amdgcn_sched_group_barrier(0x100, 2 * QKB, 0); __builtin_amdgcn_sched_group_barrier(0x008, 2 * QKB, 0); } \
        asm volatile("s_nop 15\n\ts_nop 7" : "+v"(P0), "+v"(P1)); } while (0)
#define ATT_SMPV(P0, P1, t, buf) do { \
        if ((t) == tmax) { const int kb = 64 * (t) + 4 * h; \
            _Pragma("unroll") for (int i = 0; i < 16; ++i) { const int kv = kb + (i & 3) + 8 * (i >> 2); if (kv > qg) P0[i] = -INFINITY; if (kv + 32 > qg) P1[i] = -INFINITY; } } \
        float mxa = max3f(P0[0], P0[1], P1[0]), mxb = max3f(P0[2], P0[3], P1[1]); mxa = max3f(mxa, P1[2], P1[3]); \
        _Pragma("unroll") for (int i = 4; i < 16; i += 4) { mxa = max3f(mxa, P0[i], P0[i + 1]); mxb = max3f(mxb, P0[i + 2], P0[i + 3]); mxa = max3f(mxa, P1[i], P1[i + 1]); mxb = max3f(mxb, P1[i + 2], P1[i + 3]); } \
        float mx = max3f(mxa, mxb, mxb); \
        mx = max3f(mx, __shfl_xor(mx, 32), mx); \
        const bool need = mx > m_run + THR; \
        if (__builtin_amdgcn_ballot_w64(need) != 0ull) { \
            const float mnew = need ? mx : m_run, alpha = __builtin_amdgcn_exp2f(m_run - mnew); m_run = mnew; l_lane *= alpha; \
            _Pragma("unroll") for (int db = 0; db < 4; ++db) _Pragma("unroll") for (int i = 0; i < 16; ++i) o[db][i] *= alpha; } \
        float rs = 0.f; \
        _Pragma("unroll") for (int i = 0; i < 16; ++i) { P0[i] = __builtin_amdgcn_exp2f(P0[i] - m_run); P1[i] = __builtin_amdgcn_exp2f(P1[i] - m_run); rs += P0[i] + P1[i]; } \
        l_lane += rs; \
        bf16x8 pb[4]; \
        { u32x4 t0, t1, t2, t3; \
          t0.x = cvt_pk_bf16(P0[0], P0[1]); t0.y = cvt_pk_bf16(P0[2], P0[3]); t0.z = cvt_pk_bf16(P0[4], P0[5]); t0.w = cvt_pk_bf16(P0[6], P0[7]); \
          t1.x = cvt_pk_bf16(P0[8], P0[9]); t1.y = cvt_pk_bf16(P0[10], P0[11]); t1.z = cvt_pk_bf16(P0[12], P0[13]); t1.w = cvt_pk_bf16(P0[14], P0[15]); \
          t2.x = cvt_pk_bf16(P1[0], P1[1]); t2.y = cvt_pk_bf16(P1[2], P1[3]); t2.z = cvt_pk_bf16(P1[4], P1[5]); t2.w = cvt_pk_bf16(P1[6], P1[7]); \
          t3.x = cvt_pk_bf16(P1[8], P1[9]); t3.y = cvt_pk_bf16(P1[10], P1[11]); t3.z = cvt_pk_bf16(P1[12], P1[13]); t3.w = cvt_pk_bf16(P1[14], P1[15]); \
          pb[0] = __builtin_bit_cast(bf16x8, t0); pb[1] = __builtin_bit_cast(bf16x8, t1); pb[2] = __builtin_bit_cast(bf16x8, t2); pb[3] = __builtin_bit_cast(bf16x8, t3); } \
        const LAS unsigned char* va = Vs + (buf) * VB + (4 * h + ((lane & 15) >> 2)) * VSTR + ((lane >> 4) & 1) * 32 + (lane & 3) * 8; \
        _Pragma("unroll") for (int dp = 0; dp < 4; dp += PVB) { \
            s16x4 lo[PVB][4], hi[PVB][4]; \
            _Pragma("unroll") for (int d2 = 0; d2 < PVB; ++d2) _Pragma("unroll") for (int ks = 0; ks < 4; ++ks) { lo[d2][ks] = vtr(va + (dp + d2) * 64 + (ks * 16) * VSTR); hi[d2][ks] = vtr(va + (dp + d2) * 64 + (ks * 16 + 8) * VSTR); } \
            _Pragma("unroll") for (int ks = 0; ks < 4; ++ks) _Pragma("unroll") for (int d2 = 0; d2 < PVB; ++d2) { \
                const bf16x8 a = (bf16x8){lo[d2][ks][0], lo[d2][ks][1], lo[d2][ks][2], lo[d2][ks][3], hi[d2][ks][0], hi[d2][ks][1], hi[d2][ks][2], hi[d2][ks][3]}; o[dp + d2] = MFMA32(a, pb[ks], o[dp + d2]); } \
            __builtin_amdgcn_sched_group_barrier(0x100, 8 * PVB, 0); __builtin_amdgcn_sched_group_barrier(0x008, 4 * PVB, 0); } } while (0)
#define ATT_ITER(C0, C1, N0, N1, tt, B, NB) do { \
        __syncthreads(); \
        if constexpr (PIPE) { if ((tt) + 2 < NT) ATT_STK(kreg, B); } else { if ((tt) + 1 < NT) ATT_STK(kreg, NB); } \
        if ((tt) + 1 < NT) ATT_STV(NB); \
        if ((tt) + 2 + KA < NT) ATT_LDK(kreg, (tt) + 2 + KA); \
        if ((tt) + 2 < NT) ATT_LDV((tt) + 2); \
        if constexpr (PIPE) { if ((tt) + 1 <= tmax) ATT_QK(N0, N1, NB); if ((tt) <= tmax) ATT_SMPV(C0, C1, tt, B); } \
        else { if ((tt) <= tmax) { ATT_QK(C0, C1, B); ATT_SMPV(C0, C1, tt, B); } } } while (0)
    f32x16 pA0, pA1, pB0, pB1;
    if constexpr (PIPE) {
        u32x4 kreg2[NKC];
        ATT_LDK(kreg, 0); ATT_LDV(0); ATT_LDK(kreg2, 1);
        __syncthreads();
        ATT_STK(kreg, 0); ATT_STV(0); ATT_STK(kreg2, 1);
        ATT_LDK(kreg, 2); ATT_LDV(1);
        __syncthreads();
        ATT_QK(pA0, pA1, 0);
        for (int t = 0; t < NT; t += 2) {
            ATT_ITER(pA0, pA1, pB0, pB1, t, 0, 1);
            ATT_ITER(pB0, pB1, pA0, pA1, t + 1, 1, 0);
        }
    } else {
        u32x4 kreg2[NKC], vreg2[2];
        ATT_LDK(kreg, 0); ATT_LDV(0);
        ATT_LDK(kreg2, 1);
#pragma unroll
        for (int j = 0; j < 2; ++j) vreg2[j] = ((const u32x4*)(Vth + (size_t)64 * 128))[tid + NTHR * j];
        __syncthreads();
        ATT_STK(kreg, 0); ATT_STV(0);
#pragma unroll
        for (int j = 0; j < NKC; ++j) kreg[j] = kreg2[j];
#pragma unroll
        for (int j = 0; j < 2; ++j) vreg[j] = vreg2[j];
        for (int t = 0; t < NT; t += 2) {
            ATT_ITER(pA0, pA1, pA0, pA1, t, 0, 1);
            ATT_ITER(pA0, pA1, pA0, pA1, t + 1, 1, 0);
        }
    }
#undef ATT_LDK
#undef ATT_LDV
#undef ATT_STK
#undef ATT_STV
#undef ATT_QK
#undef ATT_SMPV
#undef ATT_ITER
    float l = l_lane + __shfl_xor(l_lane, 32);
    const float inv = 1.0f / l;
#pragma unroll
    for (int db = 0; db < 4; ++db)
#pragma unroll
        for (int i = 0; i < 16; ++i) o[db][i] *= inv;
}
__device__ __forceinline__ void attn_out_store(const f32x16 (&o)[4], const float* gain, float scale, bf16_t* dst_row, int h) {
    float ss = 0.f;
#pragma unroll
    for (int db = 0; db < 4; ++db)
#pragma unroll
        for (int i = 0; i < 16; ++i) ss += o[db][i] * o[db][i];
    ss += __shfl_xor(ss, 32);
    const float rn = scale / sqrtf(ss * (1.0f / 128.0f) + EPS);
#pragma unroll
    for (int db = 0; db < 4; ++db)
#pragma unroll
        for (int g4 = 0; g4 < 4; ++g4) { const int d = 32 * db + 8 * g4 + 4 * h; const f32x4 gv = *(const f32x4*)(gain + d);
            u32x2 w; w.x = cvt_pk_bf16(o[db][4 * g4] * rn * gv[0], o[db][4 * g4 + 1] * rn * gv[1]); w.y = cvt_pk_bf16(o[db][4 * g4 + 2] * rn * gv[2], o[db][4 * g4 + 3] * rn * gv[3]);
            *(u32x2*)(dst_row + d) = w; }
}
__device__ __forceinline__ void phase5(const Params& p, LAS unsigned char* lds, unsigned* ctr, int tid, int wave, int lane) {
    unsigned char* ws = p.ws;
    const bf16_t* qm = (const bf16_t*)(ws + WS_QM); const bf16_t* km = (const bf16_t*)(ws + WS_KM); const bf16_t* vtm = (const bf16_t*)(ws + WS_VTM);
    const bf16_t* qd = (const bf16_t*)(ws + WS_QD); const bf16_t* kd = (const bf16_t*)(ws + WS_KD); const bf16_t* vtd = (const bf16_t*)(ws + WS_VTD);
    bf16_t* ao = (bf16_t*)(ws + WS_AO);
    LAS unsigned* shw = (LAS unsigned*)(lds + 163824);
    float lam;
    { const float a = p.in[12][lane] * p.in[13][lane], b2 = p.in[14][lane] * p.in[15][lane];
      lam = __expf(wave_sum(a)) - __expf(wave_sum(b2)) + LAMBDA_INIT; }
    const int r32 = lane & 31, h = lane >> 5;
    for (;;) {
        __syncthreads();
        if (tid == 0) shw[0] = atomicAdd(ctr, 1u);
        __syncthreads();
        const unsigned uq = shw[0];
        if (uq >= 928u) break;
        const unsigned grp = uq / 29u, ing = uq % 29u;
        if (ing >= 16u) {
            const int cj = (int)(grp * 13u + ing - 16u);
            p0_convert(p, lds, P0_ITEMS_EARLY + 16 * cj, P0_ITEMS_EARLY + 16 * cj + 16, wave, NWAVES, wave, lane);
            continue;
        }
        const unsigned u = grp * 16u + ing;
        const int cls = (int)(u >> 5), bh = (int)(u & 31u);
        const int isdiff = (0x552B >> cls) & 1, qb = (int)((0x0011223345465767ull >> (4 * cls)) & 15ull);
        const int q0 = qb * 256, b = bh >> 3, hd = bh & 7;
        if (!isdiff) {
            f32x16 o[4];
            attn_pass<192>(o, qm + (size_t)bh * SEQ * 192, km + (size_t)bh * SEQ * 192, vtm + (size_t)bh * 128 * SEQ, q0, lds, tid, wave, lane);
            attn_out_store(o, p.in[9], 1.0f, ao + (size_t)(b * SEQ + q0 + 32 * wave + r32) * DM + hd * 128, h);
        } else {
            f32x16 o[4];
            LAS unsigned* st = (LAS unsigned*)(lds + 59392) + wave * 2048 + lane;
            attn_pass<64>(o, qd + (size_t)(bh * 2 + 1) * SEQ * 64, kd + (size_t)(bh * 2 + 1) * SEQ * 64, vtd + (size_t)bh * 128 * SEQ, q0, lds, tid, wave, lane);
#pragma unroll
            for (int db = 0; db < 4; ++db)
#pragma unroll
                for (int i = 0; i < 16; i += 2) st[(db * 8 + (i >> 1)) * 64] = cvt_pk_bf16(o[db][i], o[db][i + 1]);
            attn_pass<64>(o, qd + (size_t)(bh * 2) * SEQ * 64, kd + (size_t)(bh * 2) * SEQ * 64, vtd + (size_t)bh * 128 * SEQ, q0, lds, tid, wave, lane);
#pragma unroll
            for (int db = 0; db < 4; ++db)
#pragma unroll
                for (int i = 0; i < 16; i += 2) { const unsigned wv = st[(db * 8 + (i >> 1)) * 64]; o[db][i] -= lam * bflo(wv); o[db][i + 1] -= lam * bfhi(wv); }
            attn_out_store(o, p.in[16], 1.0f - LAMBDA_INIT, ao + (size_t)(b * SEQ + q0 + 32 * wave + r32) * DM + hd * 128 + 1024, h);
        }
    }
}

#define XB_TMO      128
#define XB_XCNT(j)  (256  + 64 * (j))
#define XB_XSUB(j)  (1280 + 64 * (j))
#define XB_XGEN(j)  (2304 + 64 * (j))
#define XB_TOP      3328
#define XB_TOPGEN   3392
#define XCD_BAR_WORDS 3456
#define XB_SPIN_CAP (1u << 18)

__device__ __forceinline__ unsigned xb_ld(unsigned* p)              { return __hip_atomic_load(p, __ATOMIC_RELAXED, __HIP_MEMORY_SCOPE_AGENT); }
__device__ __forceinline__ unsigned xb_add(unsigned* p, unsigned v) { return __hip_atomic_fetch_add(p, v, __ATOMIC_RELAXED, __HIP_MEMORY_SCOPE_AGENT); }
__device__ __forceinline__ unsigned xb_xcc_id() { return (unsigned)__builtin_amdgcn_s_getreg((3 << 11) | 20) & 0xFu; }
#define XB_SPIN(cond, bar) do { unsigned _sp = 0; while (cond) { __builtin_amdgcn_s_sleep(1); \
    if ((++_sp & 255u) == 0u) { if (xb_ld(&(bar)[XB_TMO])) break; if (_sp > XB_SPIN_CAP) { atomicAdd(&(bar)[XB_TMO], 1u); break; } } } } while (0)

struct XcdBarrier {
    unsigned* bar; unsigned x;
    volatile LAS unsigned* st;
};

__device__ __forceinline__ XcdBarrier xcd_barrier_post(unsigned* bar, volatile LAS unsigned* st) {
    XcdBarrier b; b.bar = bar; b.x = xb_xcc_id(); b.st = st;
    if (threadIdx.x == 0) (void)xb_add(&bar[XB_XCNT(b.x)], 1u);
    return b;
}
__device__ __forceinline__ void xcd_barrier_complete(unsigned* bar, unsigned x, unsigned& nloc, unsigned& nx) {
    const unsigned G = gridDim.x * gridDim.y * gridDim.z;
    unsigned sum, cnt, mine, sp = 0u;
    for (;;) {
        sum = 0u; cnt = 0u; mine = 0u;
#pragma unroll
        for (unsigned j = 0; j < 16; ++j) { const unsigned c = xb_ld(&bar[XB_XCNT(j)]); sum += c; cnt += (c > 0u) ? 1u : 0u; mine = (j == x) ? c : mine; }
        if (sum == G) break;
        __builtin_amdgcn_s_sleep(1);
        if ((++sp & 255u) == 0u) { if (xb_ld(&bar[XB_TMO])) break; if (sp > XB_SPIN_CAP) { atomicAdd(&bar[XB_TMO], 1u); break; } }
    }
    nloc = mine > 0u ? mine : 1u; nx = cnt > 0u ? cnt : 1u;
}

__device__ __forceinline__ void xcd_barrier(const XcdBarrier& b) {
    asm volatile("s_waitcnt vmcnt(0)" ::: "memory");
    __syncthreads();
    if (threadIdx.x == 0) {
        unsigned* bar = b.bar;
        __builtin_amdgcn_s_waitcnt(0);
        unsigned nloc = b.st[0], nx = b.st[1];
        if (nloc == 0u) { xcd_barrier_complete(bar, b.x, nloc, nx); b.st[0] = nloc; b.st[1] = nx; }
        const unsigned old = xb_add(&bar[XB_XSUB(b.x)], 1u);
        const unsigned gen = old / nloc;
        if (old + 1u == (gen + 1u) * nloc) {
            __builtin_amdgcn_fence(__ATOMIC_RELEASE, "agent");
            asm volatile("s_waitcnt vmcnt(0)" ::: "memory");
            const unsigned og = xb_add(&bar[XB_TOP], 1u);
            const unsigned tg = og / nx;
            if (og + 1u == (tg + 1u) * nx) xb_add(&bar[XB_TOPGEN], 1u);
            else XB_SPIN(xb_ld(&bar[XB_TOPGEN]) == tg, bar);
            __builtin_amdgcn_fence(__ATOMIC_ACQUIRE, "agent");
            xb_add(&bar[XB_XGEN(b.x)], 1u);
            asm volatile("s_waitcnt vmcnt(0)" ::: "memory");
        } else {
            XB_SPIN(xb_ld(&bar[XB_XGEN(b.x)]) == gen, bar);
            __builtin_amdgcn_fence(__ATOMIC_ACQUIRE, "agent");
            asm volatile("s_waitcnt vmcnt(0)" ::: "memory");
        }
    }
    __syncthreads();
}

__global__ void __launch_bounds__(NTHR, 2) fwd_kernel(Params p) {
    extern __shared__ __attribute__((aligned(16))) unsigned char lds_raw[];
    LAS unsigned char* lds = (LAS unsigned char*)lds_raw;
    const int tid = threadIdx.x, lane = tid & 63, wave = __builtin_amdgcn_readfirstlane(tid >> 6);
    const int G = gridDim.x, bx = blockIdx.x;
    const int gw = bx * NWAVES + wave, NGW = G * NWAVES;
    unsigned char* ws = p.ws;
    unsigned* ctl = MK_ONE_LAUNCH ? g_ctl : (unsigned*)(ws + WS_CTL);
    const int lo = p.ph_lo, hi = p.ph_hi;
    volatile LAS unsigned* bst = (volatile LAS unsigned*)(lds + 163808);
    if (tid == 0) { bst[0] = 0u; bst[1] = 0u; }
    __syncthreads();
    XcdBarrier bar; bar.bar = ctl + 1024; bar.x = 0; bar.st = bst;
    if (hi > lo) bar = xcd_barrier_post(ctl + 1024, bst);
    if (hi > 1000) cg::this_grid().sync();
#define IN(k) (lo <= (k) && (k) < hi)
#define SEAM(k) do { if (IN(k) && IN((k) + 1)) { xcd_barrier(bar); } } while (0)
    if (IN(0)) { if (bx == 0 && tid == 0) { ctl[0] = 0u; ctl[64] = 0u; }
#if PROBE_REP == 0
        phase0(p, lds, gw, NGW, wave, lane); xcd_barrier(bar);
#endif
        phase0(p, lds, gw, NGW, wave, lane); }
    SEAM(0);
    if (IN(1)) {
        pg8::Gemm g{(const bf16_t*)(ws + WS_HB), (const bf16_t*)(ws + WS_WIN), M, NPROJ, 2048}; pg8::StaticOrder S; S.init(M, NPROJ, G, bx);
        EpiProj E{(bf16_t*)(ws + WS_QLAT), (bf16_t*)(ws + WS_KVLAT), (float*)(ws + WS_SSQL), (bf16_t*)(ws + WS_PROJ), (bf16_t*)(ws + WS_VTD)};
        pg8::gemm_phase<EpiProj, pg8::StaticOrder, true, true>(lds, g, S, E);
#if PROBE_REP == 1
        xcd_barrier(bar); pg8::gemm_phase<EpiProj, pg8::StaticOrder, true, true>(lds, g, S, E);
#endif
    }
    SEAM(1);
    if (IN(3)) {
        p3_pre(p, lds, bx, G, tid, wave, lane);
        __syncthreads();
        { pg8::Gemm g{(const bf16_t*)(ws + WS_QLAT), (const bf16_t*)(ws + WS_WQ), 2 * M, 3584, 512}; StackedOrder S{G, bx};
          EpiQKv E{EpiPlain{(bf16_t*)(ws + WS_QF), 1536}, EpiKv{(bf16_t*)(ws + WS_KNOPE), (bf16_t*)(ws + WS_VTM), (const float*)(ws + WS_SSQL)}};
          pg8::gemm_phase<EpiQKv, StackedOrder, true, true>(lds, g, S, E); }
    }
#if PROBE_REP == 3
    xcd_barrier(bar);
    if (IN(3)) {
        p3_pre(p, lds, bx, G, tid, wave, lane);
        __syncthreads();
        { pg8::Gemm g{(const bf16_t*)(ws + WS_QLAT), (const bf16_t*)(ws + WS_WQ), M, 1536, 512}; pg8::StaticOrder S; S.init(M, 1536, G, bx);
          EpiPlain E{(bf16_t*)(ws + WS_QF), 1536};
          pg8::gemm_phase<EpiPlain, pg8::StaticOrder, true, true>(lds, g, S, E); }
        __syncthreads();
        { pg8::Gemm g{(const bf16_t*)(ws + WS_KVLAT), (const bf16_t*)(ws + WS_WKV), M, 2048, 512}; pg8::StaticOrder S; S.init(M, 2048, G, bx);
          EpiKv E{(bf16_t*)(ws + WS_KNOPE), (bf16_t*)(ws + WS_VTM), (const float*)(ws + WS_SSQL)};
          pg8::gemm_phase<EpiKv, pg8::StaticOrder, true, true>(lds, g, S, E); }
    }
#endif
#if PROBE_REP == 33
    xcd_barrier(bar);
    if (IN(3)) {
        __syncthreads();
        { pg8::Gemm g{(const bf16_t*)(ws + WS_QLAT), (const bf16_t*)(ws + WS_WQ), M, 1536, 512}; pg8::StaticOrder S; S.init(M, 1536, G, bx);
          EpiPlain E{(bf16_t*)(ws + WS_QF), 1536};
          pg8::gemm_phase<EpiPlain, pg8::StaticOrder, true, true>(lds, g, S, E); }
        __syncthreads();
        { pg8::Gemm g{(const bf16_t*)(ws + WS_KVLAT), (const bf16_t*)(ws + WS_WKV), M, 2048, 512}; pg8::StaticOrder S; S.init(M, 2048, G, bx);
          EpiKv E{(bf16_t*)(ws + WS_KNOPE), (bf16_t*)(ws + WS_VTM), (const float*)(ws + WS_SSQL)};
          pg8::gemm_phase<EpiKv, pg8::StaticOrder, true, true>(lds, g, S, E); }
    }
#endif
    SEAM(3);
    if (IN(4)) phase4(p, gw, NGW, lane);
#if PROBE_REP == 4
    xcd_barrier(bar); phase4(p, gw, NGW, lane);
#endif
#if PROBE_REP == 99
    for (int rep = 0; rep < 10; ++rep) xcd_barrier(bar);
#endif
    SEAM(4);
    if (IN(5)) phase5(p, lds, ctl, tid, wave, lane);
#if PROBE_REP == 5
    xcd_barrier(bar); phase5(p, lds, ctl + 64, tid, wave, lane);
#endif
    SEAM(5);
    if (IN(6)) {
        pg8::Gemm g{(const bf16_t*)(ws + WS_AO), (const bf16_t*)(ws + WS_WO), M, DM, 2048}; pg8::StaticOrder S; S.init(M, DM, G, bx);
        EpiWo E{p.in[0], p.out, (bf16_t*)(ws + WS_X1B), (float*)(ws + WS_SSQ)};
        pg8::gemm_phase<EpiWo, pg8::StaticOrder, true, true>(lds, g, S, E);
#if PROBE_REP == 6
        xcd_barrier(bar); pg8::gemm_phase<EpiWo, pg8::StaticOrder, true, true>(lds, g, S, E);
#endif
    }
    SEAM(6);
    if (IN(7)) {
        pg8::Gemm g{(const bf16_t*)(ws + WS_X1B), (const bf16_t*)(ws + WS_WGU), M, 2 * DFF, 2048}; pg8::StaticOrder S; S.init(M, 2 * DFF, G, bx);
        EpiGateUp E{(const float*)(ws + WS_SSQ), (bf16_t*)(ws + WS_HMID)};
        pg8::gemm_phase<EpiGateUp, pg8::StaticOrder, true, true>(lds, g, S, E);
        { const int nwg = (M / 256) * (2 * DFF / 256), rem = nwg % G;
          if (rem == 0) p0_convert(p, lds, P0_NITEMS - P0_ITEMS_WD, P0_NITEMS, gw, NGW, wave, lane);
          else if (bx >= rem) p0_convert(p, lds, P0_NITEMS - P0_ITEMS_WD, P0_NITEMS, (bx - rem) * NWAVES + wave, (G - rem) * NWAVES, wave, lane); }
#if PROBE_REP == 7
        xcd_barrier(bar); pg8::gemm_phase<EpiGateUp, pg8::StaticOrder, true, true>(lds, g, S, E);
#endif
    }
    SEAM(7);
    if (IN(8)) {
        pg8::Gemm g{(const bf16_t*)(ws + WS_HMID), (const bf16_t*)(ws + WS_WD), M, DM, DFF}; pg8::StaticOrder S; S.init(M, DM, G, bx);
        EpiDown E{(const bf16_t*)(ws + WS_X1B), p.out};
#if PROBE_REP == 8
        { EpiPlain E2{(bf16_t*)(ws + WS_QM), 2048}; pg8::gemm_phase<EpiPlain, pg8::StaticOrder, true, true>(lds, g, S, E2); xcd_barrier(bar); }
#endif
        pg8::gemm_phase<EpiDown, pg8::StaticOrder, true, true>(lds, g, S, E);
    }
#if MK_ONE_LAUNCH
    if (hi > lo) {
        LAS unsigned* shx = (LAS unsigned*)(lds + 163828);
        __syncthreads();
        if (tid == 0) { __threadfence(); shx[0] = (atomicAdd(&ctl[128], 1u) == (unsigned)(G - 1)) ? 1u : 0u; }
        __syncthreads();
        if (shx[0]) { for (int i = tid; i < 8192; i += NTHR) __hip_atomic_store(&ctl[i], 0u, __ATOMIC_RELAXED, __HIP_MEMORY_SCOPE_AGENT); }
    }
#endif
#undef IN
#undef SEAM
}
}

extern "C" void kernel_launch(void* const* d_in, const int* in_sizes, int n_in, void* d_out, int out_size, void* d_ws, size_t ws_size, hipStream_t stream) {
    static int grid = 0;
    if (grid == 0) {
        if (n_in != 22 || out_size != mk::M * mk::DM || ws_size < mk::WS_END) { fprintf(stderr, "kernel_launch: unexpected shapes (n_in %d out %d ws %zu)\n", n_in, out_size, ws_size); grid = -1; return; }
        int dev = 0, cus = 0, per_cu = 0;
        if (hipGetDevice(&dev) != hipSuccess || hipDeviceGetAttribute(&cus, hipDeviceAttributeMultiprocessorCount, dev) != hipSuccess) { grid = -1; return; }
        if (hipFuncSetAttribute((const void*)mk::fwd_kernel, hipFuncAttributeMaxDynamicSharedMemorySize, mk::LDS_BYTES) != hipSuccess) { fprintf(stderr, "kernel_launch: hipFuncSetAttribute failed\n"); grid = -1; return; }
        if (hipOccupancyMaxActiveBlocksPerMultiprocessor(&per_cu, (const void*)mk::fwd_kernel, mk::NTHR, mk::LDS_BYTES) != hipSuccess || per_cu < 1) { fprintf(stderr, "kernel_launch: occupancy query says %d\n", per_cu); per_cu = 1; }
        (void)hipGetLastError();
        grid = cus * per_cu;
    }
    if (grid < 0) return;
#if !MK_ONE_LAUNCH
    if (hipMemsetAsync((char*)d_ws + mk::WS_CTL, 0, 32768, stream) != hipSuccess) { fprintf(stderr, "kernel_launch: hipMemsetAsync failed\n"); return; }
#endif
    mk::Params p{};
    for (int i = 0; i < 22; ++i) p.in[i] = (const float*)d_in[i];
    p.out = (float*)d_out; p.ws = (unsigned char*)d_ws;
#if MK_ONE_LAUNCH
    p.ph_lo = 0; p.ph_hi = 9;
#if PROBE_REP == 77
    { mk::Params p0 = p; p0.ph_lo = 50; p0.ph_hi = 50; void* a0[] = {&p0};
      (void)hipLaunchCooperativeKernel((const void*)mk::fwd_kernel, dim3(grid), dim3(mk::NTHR), a0, mk::LDS_BYTES, stream); }
#endif
    void* args[] = {&p};
    hipError_t e = hipLaunchCooperativeKernel((const void*)mk::fwd_kernel, dim3(grid), dim3(mk::NTHR), args, mk::LDS_BYTES, stream);
    if (e != hipSuccess) fprintf(stderr, "cooperative launch failed: %s (grid %d)\n", hipGetErrorString(e), grid);
#else
    for (int k = 0; k < 9; ++k) { p.ph_lo = k; p.ph_hi = k + 1; hipLaunchKernelGGL(mk::fwd_kernel, dim3(grid), dim3(mk::NTHR), mk::LDS_BYTES, stream, p); }
#endif
}
```

```cpp
#include <hip/hip_runtime.h>
#include <hip/hip_cooperative_groups.h>
#include <cstdio>
#include <cstdint>
namespace cg = cooperative_groups;
namespace pg8 {
#define PG8_LAS __attribute__((address_space(3)))
typedef unsigned short bf16_t;
typedef short bf16x8 __attribute__((ext_vector_type(8)));
typedef float f32x4 __attribute__((ext_vector_type(4)));
typedef unsigned u32x4 __attribute__((ext_vector_type(4)));
constexpr int BM = 256, BK = 64, HALF = 128, HTB = HALF * BK * 2  , STAGE_BYTES = 8 * HTB, NXCD = 8, WGM = 8;

__host__ __device__ __forceinline__ int lds_byte(int r, int c) { const int st = (r >> 4) * 2 + (c >> 5), rr = r & 15, cc = c & 31, ob = rr * 64 + cc * 2; return st * 1024 + (ob ^ (((ob >> 9) & 1) << 5)); }
__host__ __device__ __forceinline__ void stage_rc(int b, int& R, int& C) { const int st = b / 1024, sb = b % 1024, swz = sb ^ (((sb >> 9) & 1) << 5); R = (st >> 1) * 16 + swz / 64; C = (st & 1) * 32 + (swz % 64) / 2; }
__host__ __device__ __forceinline__ int perm32(int rho) { const int n = rho >> 4, i = rho & 15; return 8 * (i >> 2) + 4 * n + (i & 3); }

struct Unit { int pm, pn; };
struct Gemm { const bf16_t* A; const bf16_t* Bt; int M, N, K; };

struct StaticOrder {
    int nM, nN, nwg, G, c;
    __host__ __device__ void init(int M, int N, int G_, int c_) { nM = M / BM; nN = N / BM; nwg = nM * nN; G = G_; c = c_; }
    __host__ __device__ bool next(int i, Unit& u) const {
        const long L = (long)i * G + c; if (L >= nwg) return false;
        int wgid = (int)L; { const int q = nwg / NXCD, r = nwg % NXCD, xcd = wgid % NXCD, off = wgid / NXCD; wgid = (xcd < r ? xcd * (q + 1) : r * (q + 1) + (xcd - r) * q) + off; }
        const int nig = WGM * nN, gid = wgid / nig, fm = gid * WGM, gsz = (nM - fm) < WGM ? (nM - fm) : WGM;
        u.pm = fm + ((wgid % nig) % gsz); u.pn = (wgid % nig) / gsz; return true;
    }
    __device__ __forceinline__ void a_ready(const Unit&) const {}
    __device__ __forceinline__ void done(const Unit&) const {}
};

__device__ __forceinline__ unsigned cvt_pk_bf16(float lo, float hi) { unsigned r; asm volatile("v_cvt_pk_bf16_f32 %0, %1, %2" : "=v"(r) : "v"(lo), "v"(hi)); return r; }
typedef float f32x2 __attribute__((ext_vector_type(2)));
template <class Epi, class Sched, bool ALIGN_EPI = false, bool SP2 = false>
__device__ __forceinline__ void gemm_phase(PG8_LAS unsigned char* lds, const Gemm g, const Sched& S, const Epi& E) {
    const int tid = threadIdx.x, wid = __builtin_amdgcn_readfirstlane(tid >> 6), lane = tid & 63, wr = wid >> 2, wc = wid & 3, fr = lane & 15, fq = lane >> 4;
    const int K = g.K, nt = K / BK;
    unsigned voffA[2], voffB[2];
#pragma unroll
    for (int i = 0; i < 2; ++i) { int R, C; stage_rc(tid * 16 + i * 8192, R, C); const int Rb = Epi::PERM ? ((R & ~31) + perm32(R & 31)) : R;
        voffA[i] = (unsigned)(R * K + C) * 2u; voffB[i] = (unsigned)(Rb * K + C) * 2u; }
    const size_t kstep = (size_t)(BK * 2);
    const size_t hstep = (size_t)HALF * K * 2;
    const size_t tstep = 2 * hstep;
    const unsigned ldsw = (unsigned)wid * 1024u;
    const int aoff = lds_byte(wr * 64 + fr, fq * 8), boff = lds_byte(wc * 32 + fr, fq * 8);
#define PG8_SA(b, h) (((b) * 2 + (h)) * HTB)
#define PG8_SB(b, h) ((4 + (b) * 2 + (h)) * HTB)
#define PG8_STAGE(bufoff, gbase, voff) do { _Pragma("unroll") for (int _i = 0; _i < 2; ++_i) \
        __builtin_amdgcn_global_load_lds((const unsigned*)((const char*)(gbase) + (voff)[_i]), (PG8_LAS unsigned*)(lds + (bufoff) + ldsw + _i * 8192), 16, 0, 0); } while (0)
#define PG8_LDA(dst, b, h) do { _Pragma("unroll") for (int m = 0; m < 4; ++m) _Pragma("unroll") for (int k = 0; k < 2; ++k) dst[m][k] = *(const PG8_LAS bf16x8*)(lds + PG8_SA(b, h) + aoff + m * 2048 + k * 1024); } while (0)
#define PG8_LDB(dst, b, h) do { _Pragma("unroll") for (int n = 0; n < 2; ++n) _Pragma("unroll") for (int k = 0; k < 2; ++k) dst[n][k] = *(const PG8_LAS bf16x8*)(lds + PG8_SB(b, h) + boff + n * 2048 + k * 1024); } while (0)
#define PG8_MMA(ai, bj, At, Bt) do { __builtin_amdgcn_s_setprio(1); _Pragma("unroll") for (int m = 0; m < 4; ++m) _Pragma("unroll") for (int n = 0; n < 2; ++n) _Pragma("unroll") for (int k = 0; k < 2; ++k) \
        acc[ai][bj][m][n] = __builtin_amdgcn_mfma_f32_16x16x32_bf16(Bt[n][k], At[m][k], acc[ai][bj][m][n], 0, 0, 0); __builtin_amdgcn_s_setprio(0); } while (0)
#define PG8_WAIT_V(n) asm volatile("s_waitcnt vmcnt(" #n ")" ::: "memory")
#define PG8_WAIT_L(n) asm volatile("s_waitcnt lgkmcnt(" #n ")" ::: "memory")
#define PG8_BAR __builtin_amdgcn_s_barrier()
#define PG8_SCHED __builtin_amdgcn_sched_barrier(0)
    Unit cur, nxt; int ui = 0;
    if (!S.next(0, cur)) return;
    f32x4 acc[2][2][4][2];
#pragma unroll
    for (int a = 0; a < 2; ++a)
#pragma unroll
        for (int b = 0; b < 2; ++b)
#pragma unroll
            for (int m = 0; m < 4; ++m)
#pragma unroll
                for (int n = 0; n < 2; ++n) acc[a][b][m][n] = (f32x4){0.f, 0.f, 0.f, 0.f};
    bf16x8 At[4][2], B0[2][2], B1[2][2];
    const char* cA = (const char*)g.A + (size_t)cur.pm * tstep; const char* cB = (const char*)g.Bt + (size_t)cur.pn * tstep;
    S.a_ready(cur);
    if constexpr (SP2) {
        PG8_STAGE(PG8_SB(0, 0), cB, voffB); PG8_STAGE(PG8_SB(0, 1), cB + hstep, voffB); PG8_STAGE(PG8_SA(0, 0), cA, voffA); PG8_STAGE(PG8_SA(0, 1), cA + hstep, voffA);
        if (wr == 1) PG8_BAR;
        PG8_WAIT_V(2); PG8_BAR;
        PG8_STAGE(PG8_SB(1, 0), cB + kstep, voffB); PG8_STAGE(PG8_SA(1, 0), cA + kstep, voffA); PG8_STAGE(PG8_SB(1, 1), cB + hstep + kstep, voffB);
        PG8_WAIT_V(6); PG8_BAR;
    } else {
        PG8_STAGE(PG8_SB(0, 0), cB, voffB); PG8_STAGE(PG8_SA(0, 0), cA, voffA); PG8_STAGE(PG8_SB(0, 1), cB + hstep, voffB); PG8_STAGE(PG8_SA(0, 1), cA + hstep, voffA);
        if (wr == 1) PG8_BAR;
        PG8_WAIT_V(4); PG8_BAR;
        PG8_STAGE(PG8_SB(1, 0), cB + kstep, voffB); PG8_STAGE(PG8_SA(1, 0), cA + kstep, voffA); PG8_STAGE(PG8_SB(1, 1), cB + hstep + kstep, voffB);
        PG8_WAIT_V(6); PG8_BAR;
    }
    for (;;) {
        const bool has_next = S.next(ui + 1, nxt);
        const char* nA = has_next ? (const char*)g.A + (size_t)nxt.pm * tstep : cA; const char* nB = has_next ? (const char*)g.Bt + (size_t)nxt.pn * tstep : cB;
        for (int t = 0; t < nt; t += 2) {
            const bool last = (t == nt - 2);
            const char* a1 = cA + (size_t)(t + 1) * kstep;
            const char* a2 = last ? nA : cA + (size_t)(t + 2) * kstep; const char* b2 = last ? nB : cB + (size_t)(t + 2) * kstep;
            const char* a3 = a2 + kstep; const char* b3 = b2 + kstep;
            if (last && has_next) S.a_ready(nxt);
            if constexpr (SP2) {
            PG8_LDB(B0, 0, 0); PG8_LDB(B1, 0, 1); PG8_SCHED; PG8_LDA(At, 0, 0); PG8_STAGE(PG8_SA(1, 1), a1 + hstep, voffA);
            PG8_WAIT_V(8); PG8_WAIT_L(0); PG8_BAR; PG8_MMA(0, 0, At, B0); PG8_MMA(0, 1, At, B1); PG8_BAR; PG8_SCHED;
            PG8_LDA(At, 0, 1); PG8_STAGE(PG8_SB(0, 0), b2, voffB); PG8_STAGE(PG8_SB(0, 1), b2 + hstep, voffB); PG8_STAGE(PG8_SA(0, 0), a2, voffA);
            PG8_WAIT_V(8); PG8_WAIT_L(0); PG8_BAR; PG8_MMA(1, 0, At, B0); PG8_MMA(1, 1, At, B1); PG8_BAR; PG8_SCHED;
            PG8_LDB(B0, 1, 0); PG8_LDB(B1, 1, 1); PG8_SCHED; PG8_LDA(At, 1, 0); PG8_STAGE(PG8_SA(0, 1), a2 + hstep, voffA);
            PG8_WAIT_V(8); PG8_WAIT_L(0); PG8_BAR; PG8_MMA(0, 0, At, B0); PG8_MMA(0, 1, At, B1); PG8_BAR; PG8_SCHED;
            PG8_LDA(At, 1, 1); PG8_STAGE(PG8_SB(1, 0), b3, voffB); PG8_STAGE(PG8_SB(1, 1), b3 + hstep, voffB); PG8_STAGE(PG8_SA(1, 0), a3, voffA);
            PG8_WAIT_V(8); PG8_WAIT_L(0); PG8_BAR; PG8_MMA(1, 0, At, B0); PG8_MMA(1, 1, At, B1); PG8_BAR; PG8_SCHED;
            } else {
            PG8_LDB(B0, 0, 0); PG8_SCHED; PG8_LDA(At, 0, 0); PG8_STAGE(PG8_SA(1, 1), a1 + hstep, voffA);
            PG8_WAIT_L(8); PG8_BAR; PG8_WAIT_L(0); PG8_MMA(0, 0, At, B0); PG8_BAR; PG8_SCHED;
            PG8_LDB(B1, 0, 1); PG8_STAGE(PG8_SB(0, 0), b2, voffB);
            PG8_BAR; PG8_WAIT_L(0); PG8_MMA(0, 1, At, B1); PG8_BAR;
            PG8_LDA(At, 0, 1); PG8_STAGE(PG8_SA(0, 0), a2, voffA);
            PG8_BAR; PG8_WAIT_L(0); PG8_MMA(1, 0, At, B0); PG8_BAR; PG8_SCHED;
            PG8_STAGE(PG8_SB(0, 1), b2 + hstep, voffB);
            PG8_WAIT_V(6); PG8_BAR; PG8_MMA(1, 1, At, B1); PG8_BAR;
            PG8_LDB(B0, 1, 0); PG8_SCHED; PG8_LDA(At, 1, 0); PG8_STAGE(PG8_SA(0, 1), a2 + hstep, voffA);
            PG8_WAIT_L(8); PG8_BAR; PG8_WAIT_L(0); PG8_MMA(0, 0, At, B0); PG8_BAR; PG8_SCHED;
            PG8_LDB(B1, 1, 1); PG8_STAGE(PG8_SB(1, 0), b3, voffB);
            PG8_BAR; PG8_WAIT_L(0); PG8_MMA(0, 1, At, B1); PG8_BAR;
            PG8_LDA(At, 1, 1); PG8_STAGE(PG8_SA(1, 0), a3, voffA);
            PG8_BAR; PG8_WAIT_L(0); PG8_MMA(1, 0, At, B0); PG8_BAR; PG8_SCHED;
            PG8_STAGE(PG8_SB(1, 1), b3 + hstep, voffB);
            PG8_WAIT_V(6); PG8_BAR; PG8_MMA(1, 1, At, B1); PG8_BAR;
            }
        }
        if constexpr (ALIGN_EPI) { if (wr == 0) PG8_BAR; }
        if constexpr (!Epi::AFTER_DRAIN) { E(acc, cur, wr, wc, fr, fq); S.done(cur); }
        if (!has_next) break;
#pragma unroll
        for (int a = 0; a < 2; ++a)
#pragma unroll
            for (int b = 0; b < 2; ++b)
#pragma unroll
                for (int m = 0; m < 4; ++m)
#pragma unroll
                    for (int n = 0; n < 2; ++n) acc[a][b][m][n] = (f32x4){0.f, 0.f, 0.f, 0.f};
        cur = nxt; cA = nA; cB = nB; ++ui;
        if constexpr (ALIGN_EPI) { if (wr == 1) PG8_BAR; }
    }
    PG8_WAIT_V(0);
    if constexpr (!ALIGN_EPI) { if (wr == 0) PG8_BAR; }
    PG8_BAR;
    if constexpr (Epi::AFTER_DRAIN) { E.fused(acc, cur, wr, wc, fr, fq, lds, wid, lane); S.done(cur); }
#undef PG8_SA
#undef PG8_SB
#undef PG8_STAGE
#undef PG8_LDA
#undef PG8_LDB
#undef PG8_MMA
#undef PG8_WAIT_V
#undef PG8_WAIT_L
#undef PG8_BAR
#undef PG8_SCHED
}
}

#ifndef MK_ONE_LAUNCH
#define MK_ONE_LAUNCH 1
#endif

namespace mk {
#define LAS __attribute__((address_space(3)))
typedef unsigned short bf16_t;
typedef short bf16x8 __attribute__((ext_vector_type(8)));
typedef float f32x4 __attribute__((ext_vector_type(4)));
typedef float f32x16 __attribute__((ext_vector_type(16)));
typedef unsigned u32x4 __attribute__((ext_vector_type(4)));
typedef unsigned u32x2 __attribute__((ext_vector_type(2)));
using pg8::Unit;
using pg8::cvt_pk_bf16;

constexpr int NWAVES = 8, NTHR = 512;
constexpr int M = 8192, DM = 2048, SEQ = 2048;
constexpr int NPROJ = 4096, PROJ_LD = 2048, DFF = 5632;
constexpr float EPS = 1e-6f;
constexpr float LOG2E = 1.4426950408889634f;
constexpr float LOG2_THETA = 18.931568569324174f;
constexpr float LAMBDA_INIT = 0.2f;

constexpr size_t MiB = 1u << 20;
constexpr size_t WS_CTL = 0;
constexpr size_t WS_WIN = 1 * MiB, WS_WQ = 18 * MiB, WS_WKV = 18 * MiB + 1536 * 1024, WS_WO = 22 * MiB, WS_WGU = 30 * MiB, WS_WD = 74 * MiB;
constexpr size_t WS_VTM = 1 * MiB;
constexpr size_t WS_VTD = 74 * MiB;
constexpr size_t WS_HB = 96 * MiB, WS_PROJ = 128 * MiB, WS_QLAT = 160 * MiB, WS_KVLAT = 168 * MiB, WS_SSQL = 176 * MiB, WS_KPE = 177 * MiB;
constexpr size_t WS_QF = 178 * MiB, WS_KNOPE = 202 * MiB, WS_QD = 218 * MiB, WS_KD = 234 * MiB;
constexpr size_t WS_QM = 96 * MiB, WS_KM = 120 * MiB, WS_AO = 144 * MiB, WS_X1B = 96 * MiB, WS_SSQ = 128 * MiB, WS_HMID = 130 * MiB;
constexpr size_t WS_END = 256 * MiB;
constexpr int LDS_BYTES = 163840;

__device__ unsigned g_ctl[8192];
struct Params { const float* in[22]; float* out; unsigned char* ws; int ph_lo, ph_hi; };

__device__ __forceinline__ float bf2f(unsigned short b) { return __uint_as_float((unsigned)b << 16); }
__device__ __forceinline__ float bflo(unsigned w) { return __uint_as_float(w << 16); }
__device__ __forceinline__ float bfhi(unsigned w) { return __uint_as_float(w & 0xffff0000u); }
__device__ __forceinline__ float wave_sum(float v) {
#pragma unroll
    for (int o = 1; o < 64; o <<= 1) v += __shfl_xor(v, o);
    return v;
}
__device__ __forceinline__ int perm16(int s) { return (s & 3) | ((s & 4) << 1) | ((s & 8) >> 1); }
__device__ __forceinline__ void sincos_ang(float ang, float& s, float& c) {
    double rev = (double)ang * 0.15915494309189535;
    rev -= __builtin_rint(rev);
    const float fr = (float)rev;
    s = __builtin_amdgcn_sinf(fr); c = __builtin_amdgcn_cosf(fr);
}
__device__ __forceinline__ float rope_freq(int i, int r) { return exp2f(-(float)(2 * i) / (float)r * LOG2_THETA); }

__device__ __forceinline__ u32x4 pack8(const f32x4& a, const f32x4& b) {
    u32x4 w; w.x = cvt_pk_bf16(a[0], a[1]); w.y = cvt_pk_bf16(a[2], a[3]); w.z = cvt_pk_bf16(b[0], b[1]); w.w = cvt_pk_bf16(b[2], b[3]); return w;
}
__device__ __forceinline__ bf16_t f2bf1(float v) { return (bf16_t)(cvt_pk_bf16(v, v) & 0xffffu); }

__device__ __forceinline__ void store_v(bf16_t* v, int bh, int d0, int r, const f32x4& a, const f32x4& b) {
    *(u32x4*)(v + ((size_t)bh * 2048 + (r & 2047)) * 128 + d0) = pack8(a, b);
}

struct EpiProj {
    static constexpr bool PERM = true, AFTER_DRAIN = false;
    bf16_t* qlat; bf16_t* kvlat; float* ssql; bf16_t* proj; bf16_t* vtd;
    __device__ __forceinline__ void operator()(const f32x4 (&acc)[2][2][4][2], const Unit& u, int wr, int wc, int fr, int fq) const {
        const int row0 = u.pm * 256 + wr * 64 + fr;
        if (u.pn < 4) {
            bf16_t* dst = (u.pn < 2) ? qlat : kvlat; const int t2 = u.pn & 1, lat = u.pn >> 1, col0 = t2 * 256 + wc * 32 + 8 * fq;
#pragma unroll
            for (int ai = 0; ai < 2; ++ai)
#pragma unroll
                for (int m = 0; m < 4; ++m) { const int r = row0 + ai * 128 + m * 16; bf16_t* rowp = dst + (size_t)r * 512 + col0; float sq = 0.f;
#pragma unroll
                    for (int bj = 0; bj < 2; ++bj) { const f32x4 v0 = acc[ai][bj][m][0], v1 = acc[ai][bj][m][1]; *(u32x4*)(rowp + bj * 128) = pack8(v0, v1);
                        sq += (v0[0] * v0[0] + v0[1] * v0[1]) + (v0[2] * v0[2] + v0[3] * v0[3]) + (v1[0] * v1[0] + v1[1] * v1[1]) + (v1[2] * v1[2] + v1[3] * v1[3]); }
                    sq += __shfl_xor(sq, 16); sq += __shfl_xor(sq, 32);
                    if (fq == 0) ssql[(size_t)r * 16 + lat * 8 + t2 * 4 + wc] = sq; }
        } else if (u.pn < 12) {
            const int col0 = (u.pn - 4) * 256 + wc * 32 + 8 * fq;
#pragma unroll
            for (int ai = 0; ai < 2; ++ai)
#pragma unroll
                for (int m = 0; m < 4; ++m) { bf16_t* rowp = proj + (size_t)(row0 + ai * 128 + m * 16) * PROJ_LD + col0;
#pragma unroll
                    for (int bj = 0; bj < 2; ++bj) *(u32x4*)(rowp + bj * 128) = pack8(acc[ai][bj][m][0], acc[ai][bj][m][1]); }
        } else {
#pragma unroll
            for (int ai = 0; ai < 2; ++ai)
#pragma unroll
                for (int m = 0; m < 4; ++m) { const int r = row0 + ai * 128 + m * 16; const int b = r >> 11;
#pragma unroll
                    for (int bj = 0; bj < 2; ++bj) store_v(vtd, b * 8 + 2 * (u.pn - 12) + bj, wc * 32 + 8 * fq, r, acc[ai][bj][m][0], acc[ai][bj][m][1]); }
        }
    }
};
__device__ __forceinline__ float latent_rs(const float* ssql_row8) {
    const f32x4 a = *(const f32x4*)ssql_row8, b = *(const f32x4*)(ssql_row8 + 4);
    return 1.0f / sqrtf((((a[0] + a[1]) + (a[2] + a[3])) + ((b[0] + b[1]) + (b[2] + b[3]))) * (1.0f / 512.0f) + EPS);
}
struct EpiPlain {
    static constexpr bool PERM = true, AFTER_DRAIN = false;
    bf16_t* O; int ldc;
    __device__ __forceinline__ void operator()(const f32x4 (&acc)[2][2][4][2], const Unit& u, int wr, int wc, int fr, int fq) const {
        const int row0 = u.pm * 256 + wr * 64 + fr, col0 = u.pn * 256 + wc * 32 + 8 * fq;
#pragma unroll
        for (int ai = 0; ai < 2; ++ai)
#pragma unroll
            for (int m = 0; m < 4; ++m) { bf16_t* rowp = O + (size_t)(row0 + ai * 128 + m * 16) * ldc + col0;
#pragma unroll
                for (int bj = 0; bj < 2; ++bj) *(u32x4*)(rowp + bj * 128) = pack8(acc[ai][bj][m][0], acc[ai][bj][m][1]); }
    }
};
struct EpiKv {
    static constexpr bool PERM = true, AFTER_DRAIN = false;
    bf16_t* knope; bf16_t* vtm; const float* ssql;
    __device__ __forceinline__ void operator()(const f32x4 (&acc)[2][2][4][2], const Unit& u, int wr, int wc, int fr, int fq) const {
        const int row0 = u.pm * 256 + wr * 64 + fr;
        f32x4 sv[8][2];
#pragma unroll
        for (int k = 0; k < 8; ++k) { const f32x4* sp = (const f32x4*)(ssql + (size_t)(row0 + (k >> 2) * 128 + (k & 3) * 16) * 16 + 8); sv[k][0] = sp[0]; sv[k][1] = sp[1]; }
#pragma unroll
        for (int ai = 0; ai < 2; ++ai)
#pragma unroll
            for (int m = 0; m < 4; ++m) { const int r = row0 + ai * 128 + m * 16; const f32x4 a = sv[ai * 4 + m][0], b = sv[ai * 4 + m][1];
                const float rs = 1.0f / sqrtf((((a[0] + a[1]) + (a[2] + a[3])) + ((b[0] + b[1]) + (b[2] + b[3]))) * (1.0f / 512.0f) + EPS);
                *(u32x4*)(knope + (size_t)r * 1024 + u.pn * 128 + wc * 32 + 8 * fq) = pack8(acc[ai][0][m][0], acc[ai][0][m][1]);
                store_v(vtm, (r >> 11) * 8 + u.pn, wc * 32 + 8 * fq, r, acc[ai][1][m][0] * rs, acc[ai][1][m][1] * rs); }
    }
};
struct EpiWo {
    static constexpr bool PERM = false, AFTER_DRAIN = false;
    const float* x; float* out; bf16_t* x1b; float* ssq;
    __device__ __forceinline__ void operator()(const f32x4 (&acc)[2][2][4][2], const Unit& u, int wr, int wc, int fr, int fq) const {
        const int row0 = u.pm * 256 + wr * 64 + fr, col0 = u.pn * 256 + wc * 32 + 4 * fq;
#pragma unroll
        for (int ai = 0; ai < 2; ++ai) {
            f32x4 xv[4][2][2];
#pragma unroll
            for (int m = 0; m < 4; ++m)
#pragma unroll
                for (int bj = 0; bj < 2; ++bj)
#pragma unroll
                    for (int n = 0; n < 2; ++n) xv[m][bj][n] = *(const f32x4*)(x + (size_t)(row0 + ai * 128 + m * 16) * DM + col0 + bj * 128 + n * 16);
#pragma unroll
            for (int m = 0; m < 4; ++m) { const int r = row0 + ai * 128 + m * 16; const size_t off = (size_t)r * DM + col0; float s = 0.f;
#pragma unroll
                for (int bj = 0; bj < 2; ++bj)
#pragma unroll
                    for (int n = 0; n < 2; ++n) { const size_t o2 = off + bj * 128 + n * 16; const f32x4 v = xv[m][bj][n] + acc[ai][bj][m][n];
                        s += (v[0] * v[0] + v[1] * v[1]) + (v[2] * v[2] + v[3] * v[3]);
                        u32x2 w; w.x = cvt_pk_bf16(v[0], v[1]); w.y = cvt_pk_bf16(v[2], v[3]); *(u32x2*)(x1b + o2) = w; }
                s += __shfl_xor(s, 16); s += __shfl_xor(s, 32);
                if (fq == 0) ssq[(size_t)r * 32 + u.pn * 4 + wc] = s; }
        }
    }
};
struct EpiGateUp {
    static constexpr bool PERM = true, AFTER_DRAIN = false;
    const float* ssq; bf16_t* hmid;
    __device__ __forceinline__ void operator()(const f32x4 (&acc)[2][2][4][2], const Unit& u, int wr, int wc, int fr, int fq) const {
        const int row0 = u.pm * 256 + wr * 64 + fr, col0 = u.pn * 128 + wc * 32 + 8 * fq;
        f32x4 sv[8][2];
#pragma unroll
        for (int k = 0; k < 8; ++k) { const f32x4* sp = (const f32x4*)(ssq + (size_t)(row0 + (k >> 2) * 128 + (k & 3) * 16) * 32) + 2 * fq; sv[k][0] = sp[0]; sv[k][1] = sp[1]; }
        float r2[8];
#pragma unroll
        for (int k = 0; k < 8; ++k) { float s = ((sv[k][0][0] + sv[k][0][1]) + (sv[k][0][2] + sv[k][0][3])) + ((sv[k][1][0] + sv[k][1][1]) + (sv[k][1][2] + sv[k][1][3]));
            s += __shfl_xor(s, 16); s += __shfl_xor(s, 32); r2[k] = 1.0f / sqrtf(s * (1.0f / DM) + EPS); }
#pragma unroll
        for (int ai = 0; ai < 2; ++ai)
#pragma unroll
            for (int m = 0; m < 4; ++m) { const int r = row0 + ai * 128 + m * 16; const float rr = r2[ai * 4 + m];
                f32x4 hv[2];
#pragma unroll
                for (int n = 0; n < 2; ++n)
#pragma unroll
                    for (int e = 0; e < 4; ++e) { const float g = acc[ai][0][m][n][e] * rr, up = acc[ai][1][m][n][e] * rr;
                        const float sg = g * __builtin_amdgcn_rcpf(1.0f + __builtin_amdgcn_exp2f(-g * LOG2E)); hv[n][e] = sg * up; }
                *(u32x4*)(hmid + (size_t)r * DFF + col0) = pack8(hv[0], hv[1]); }
    }
};
struct EpiDown {
    static constexpr bool PERM = false, AFTER_DRAIN = false;
    const bf16_t* x1b; float* out;
    __device__ __forceinline__ void operator()(const f32x4 (&acc)[2][2][4][2], const Unit& u, int wr, int wc, int fr, int fq) const {
        const int row0 = u.pm * 256 + wr * 64 + fr, col0 = u.pn * 256 + wc * 32 + 4 * fq;
#pragma unroll
        for (int ai = 0; ai < 2; ++ai) {
            u32x2 xv[4][2][2];
#pragma unroll
            for (int m = 0; m < 4; ++m)
#pragma unroll
                for (int bj = 0; bj < 2; ++bj)
#pragma unroll
                    for (int n = 0; n < 2; ++n) xv[m][bj][n] = *(const u32x2*)(x1b + (size_t)(row0 + ai * 128 + m * 16) * DM + col0 + bj * 128 + n * 16);
#pragma unroll
            for (int m = 0; m < 4; ++m)
#pragma unroll
                for (int bj = 0; bj < 2; ++bj)
#pragma unroll
                    for (int n = 0; n < 2; ++n) { const u32x2 w = xv[m][bj][n]; const f32x4 r = {bflo(w.x), bfhi(w.x), bflo(w.y), bfhi(w.y)};
                        *(f32x4*)(out + (size_t)(row0 + ai * 128 + m * 16) * DM + col0 + bj * 128 + n * 16) = r + acc[ai][bj][m][n]; }
        }
    }
};

struct StackedOrder {
    int G, c;
    __device__ __forceinline__ bool next(int i, Unit& u) const {
        const long L = (long)i * G + c; if (L >= 448) return false;
        pg8::StaticOrder t; t.G = 1; t.c = 0;
        if (L < 256) { t.nM = 32; t.nN = 8; t.nwg = 256; t.next((int)L, u); u.pm += 32; u.pn += 6; }
        else { t.nM = 32; t.nN = 6; t.nwg = 192; t.next((int)L - 256, u); }
        return true;
    }
    __device__ __forceinline__ void a_ready(const Unit&) const {}
    __device__ __forceinline__ void done(const Unit&) const {}
};
struct EpiQKv {
    static constexpr bool PERM = true, AFTER_DRAIN = false;
    EpiPlain q; EpiKv kv;
    __device__ __forceinline__ void operator()(const f32x4 (&acc)[2][2][4][2], const Unit& u, int wr, int wc, int fr, int fq) const {
        if (u.pn < 6) q(acc, u, wr, wc, fr, fq);
        else { Unit v; v.pm = u.pm - 32; v.pn = u.pn - 6; kv(acc, v, wr, wc, fr, fq); }
    }
};

struct TItem { const float* src; const float* gain; bf16_t* dst; int ldw, K; bool zero; };
__device__ __forceinline__ TItem p0_item(const Params& p, unsigned char* ws, int it) {
    constexpr int I_IN = 32 * 65, I_Q = 8 * 24, I_KV = 8 * 32, I_O = 32 * 32, I_GU = 32 * 176;
    TItem t; t.gain = nullptr; t.zero = false; int r = it;
    if (r < I_IN) { const int kb = r / 65, nb = r % 65; const int nd = nb * 64; const int ns = nd < 1024 ? nd : (nd < 4096 ? nd + 64 : 1024);
        t.src = p.in[2] + (size_t)(kb * 64) * 4160 + ns; t.ldw = 4160; t.dst = (bf16_t*)(ws + WS_WIN) + (size_t)nd * 2048 + kb * 64; t.K = 2048; return t; } r -= I_IN;
    if (r < I_Q) { const int kb = r / 24, nb = r % 24; t.src = p.in[4] + (size_t)(kb * 64) * 1536 + nb * 64; t.ldw = 1536; t.gain = p.in[3] + kb * 64; t.dst = (bf16_t*)(ws + WS_WQ) + (size_t)(nb * 64) * 512 + kb * 64; t.K = 512; return t; } r -= I_Q;
    if (r < I_KV) { const int kb = r / 32, nb = r % 32; t.src = p.in[6] + (size_t)(kb * 64) * 2048 + nb * 64; t.ldw = 2048; t.gain = p.in[5] + kb * 64; t.dst = (bf16_t*)(ws + WS_WKV) + (size_t)(nb * 64) * 512 + kb * 64; t.K = 512; return t; } r -= I_KV;
    if (r < I_O) { const int kb = r / 32, nb = r % 32; t.src = p.in[17] + (size_t)(kb * 64) * 2048 + nb * 64; t.ldw = 2048; t.dst = (bf16_t*)(ws + WS_WO) + (size_t)(nb * 64) * 2048 + kb * 64; t.K = 2048; return t; } r -= I_O;
    if (r < I_GU) { const int kb = r / 176, nb = r % 176; const int nd = nb * 64; const int tt = nd >> 8, bj = (nd >> 7) & 1, j = nd & 127;
        t.src = (bj ? p.in[20] : p.in[19]) + (size_t)(kb * 64) * DFF + tt * 128 + j; t.ldw = DFF; t.gain = p.in[18] + kb * 64;
        t.dst = (bf16_t*)(ws + WS_WGU) + (size_t)nd * 2048 + kb * 64; t.K = 2048; return t; } r -= I_GU;
    { const int kb = r / 32, nb = r % 32; t.src = p.in[21] + (size_t)(kb * 64) * 2048 + nb * 64; t.ldw = 2048; t.dst = (bf16_t*)(ws + WS_WD) + (size_t)(nb * 64) * DFF + kb * 64; t.K = DFF; return t; }
}
constexpr int P0_NITEMS = 32 * 65 + 8 * 24 + 8 * 32 + 32 * 32 + 32 * 176 + 88 * 32, P0_ITEMS_WD = 88 * 32, P0_ITEMS_EARLY = 32 * 65 + 8 * 24 + 8 * 32, P0_ITEMS_MID = 32 * 32 + 32 * 176;
static_assert(P0_ITEMS_MID == 416 * 16 && P0_ITEMS_EARLY + P0_ITEMS_MID + P0_ITEMS_WD == P0_NITEMS, "conversion item split");
__device__ __forceinline__ void p0_convert(const Params& p, LAS unsigned char* lds, int it0, int NITEMS, int gw, int NGW, int wave, int lane) {
    unsigned char* ws = p.ws;
    LAS float* scr = (LAS float*)(lds + wave * 16640);
    const int ksub = lane >> 4, n4 = (lane & 15) * 4;
    f32x4 v[16];
#define P0_LOAD(T) do { const float* sp_ = (T).src + (size_t)ksub * (T).ldw + n4; \
        _Pragma("unroll") for (int i = 0; i < 16; ++i) v[i] = *(const f32x4*)(sp_ + (size_t)(4 * i) * (T).ldw); } while (0)
    int it = it0 + gw; TItem cur;
    if (it < NITEMS) { cur = p0_item(p, ws, it); P0_LOAD(cur); }
    while (it < NITEMS) {
        if (cur.gain) {
#pragma unroll
            for (int i = 0; i < 16; ++i) v[i] = v[i] * cur.gain[4 * i + ksub];
        }
#pragma unroll
        for (int i = 0; i < 16; ++i) { LAS float* d = scr + (4 * i + ksub) * 65 + n4; d[0] = v[i][0]; d[1] = v[i][1]; d[2] = v[i][2]; d[3] = v[i][3]; }
        const int itn = it + NGW; TItem nxt = cur;
        if (itn < NITEMS) { nxt = p0_item(p, ws, itn); P0_LOAD(nxt); }
        asm volatile("s_waitcnt lgkmcnt(0)" ::: "memory");
        const int c = lane & 7;
#pragma unroll
        for (int j = 0; j < 8; ++j) { const int n = (lane >> 3) + 8 * j; const LAS float* s = scr + (8 * c) * 65 + n;
            u32x4 o; o.x = cvt_pk_bf16(s[0 * 65], s[1 * 65]); o.y = cvt_pk_bf16(s[2 * 65], s[3 * 65]); o.z = cvt_pk_bf16(s[4 * 65], s[5 * 65]); o.w = cvt_pk_bf16(s[6 * 65], s[7 * 65]);
            *(u32x4*)(cur.dst + (size_t)n * cur.K + 8 * c) = o; }
        asm volatile("s_waitcnt lgkmcnt(0)" ::: "memory");
        it = itn; cur = nxt;
    }
#undef P0_LOAD
}
__device__ __forceinline__ void phase0(const Params& p, LAS unsigned char* lds, int gw, int NGW, int wave, int lane) {
    unsigned char* ws = p.ws;
    p0_convert(p, lds, 0, P0_ITEMS_EARLY, gw, NGW, wave, lane);
    const float* x = p.in[0]; const float* g = p.in[1]; bf16_t* hb = (bf16_t*)(ws + WS_HB);
    f32x4 v[8], vn[8];
    if (gw < M) {
#pragma unroll
        for (int j = 0; j < 8; ++j) vn[j] = ((const f32x4*)(x + (size_t)gw * DM) + lane)[64 * j];
    }
    for (int m = gw; m < M; m += NGW) {
        float s = 0.f;
#pragma unroll
        for (int j = 0; j < 8; ++j) { v[j] = vn[j]; s += (v[j][0] * v[j][0] + v[j][1] * v[j][1]) + (v[j][2] * v[j][2] + v[j][3] * v[j][3]); }
        if (m + NGW < M) {
#pragma unroll
            for (int j = 0; j < 8; ++j) vn[j] = ((const f32x4*)(x + (size_t)(m + NGW) * DM) + lane)[64 * j];
        }
        const float rs = 1.0f / sqrtf(wave_sum(s) * (1.0f / DM) + EPS);
        u32x2* o = (u32x2*)(hb + (size_t)m * DM) + lane;
#pragma unroll
        for (int j = 0; j < 8; ++j) { const f32x4 gv = ((const f32x4*)g)[lane + 64 * j]; u32x2 w;
            w.x = cvt_pk_bf16(v[j][0] * rs * gv[0], v[j][1] * rs * gv[1]); w.y = cvt_pk_bf16(v[j][2] * rs * gv[2], v[j][3] * rs * gv[3]); o[64 * j] = w; }
    }
}

__device__ __forceinline__ void unpack8(const u32x4& w, float (&f)[8]) {
    f[0] = bflo(w.x); f[1] = bfhi(w.x); f[2] = bflo(w.y); f[3] = bfhi(w.y); f[4] = bflo(w.z); f[5] = bfhi(w.z); f[6] = bflo(w.w); f[7] = bfhi(w.w);
}
__device__ __forceinline__ u32x4 pack8f(const float (&f)[8]) {
    u32x4 w; w.x = cvt_pk_bf16(f[0], f[1]); w.y = cvt_pk_bf16(f[2], f[3]); w.z = cvt_pk_bf16(f[4], f[5]); w.w = cvt_pk_bf16(f[6], f[7]); return w;
}
__device__ __forceinline__ void latent_norm(const bf16_t* src, const float* g, bf16_t* dst, int lane) {
    float f[8]; unpack8(*(const u32x4*)(src + lane * 8), f); float s = 0.f;
#pragma unroll
    for (int j = 0; j < 8; ++j) s += f[j] * f[j];
    const float rs = 1.0f / sqrtf(wave_sum(s) * (1.0f / 512.0f) + EPS);
#pragma unroll
    for (int j = 0; j < 8; ++j) f[j] = f[j] * rs * g[lane * 8 + j];
    *(u32x4*)(dst + lane * 8) = pack8f(f);
}
__device__ __forceinline__ void diff_row(const u32x4& raw0, const u32x4& raw1, const float (&g)[16], const float (&sn)[8], const float (&cs)[8], bf16_t* o, int sub) {
    float f[16]; { float t[8]; unpack8(raw0, t);
#pragma unroll
        for (int j = 0; j < 8; ++j) f[j] = t[j];
        unpack8(raw1, t);
#pragma unroll
        for (int j = 0; j < 8; ++j) f[8 + j] = t[j]; }
    float ss = 0.f;
#pragma unroll
    for (int j = 0; j < 16; ++j) ss += f[j] * f[j];
    ss += __shfl_xor(ss, 1); ss += __shfl_xor(ss, 2);
    const float rs = 1.0f / sqrtf(ss * (1.0f / 64.0f) + EPS);
#pragma unroll
    for (int j = 0; j < 16; ++j) f[j] = f[j] * rs * g[j];
    if (sub == 0) {
#pragma unroll
        for (int i = 0; i < 8; ++i) { const float a = f[i], bb = f[8 + i]; f[i] = a * cs[i] - bb * sn[i]; f[8 + i] = bb * cs[i] + a * sn[i]; }
    }
    { float t[8];
#pragma unroll
      for (int j = 0; j < 8; ++j) t[j] = f[j];
      *(u32x4*)o = pack8f(t);
#pragma unroll
      for (int j = 0; j < 8; ++j) t[j] = f[8 + j];
      *(u32x4*)(o + 8) = pack8f(t); }
}
__device__ __forceinline__ void kpe_gemm(unsigned char* ws, LAS unsigned char* lds, int blk0, int bstep, int bend, int tid, int wave, int lane) {
    const bf16_t* hb = (const bf16_t*)(ws + WS_HB); const bf16_t* wk = (const bf16_t*)(ws + WS_WIN) + (size_t)4096 * 2048; bf16_t* kpe = (bf16_t*)(ws + WS_KPE);
    const int r32 = lane & 31, h = lane >> 5;
    LAS float* red = (LAS float*)lds;
    for (int blk = blk0; blk < bend; blk += bstep) {
        const int m0 = blk * 32;
        const bf16_t* ap = hb + (size_t)(m0 + r32) * 2048 + wave * 256 + 8 * h;
        const bf16_t* bp = wk + (size_t)r32 * 2048 + wave * 256 + 8 * h;
        f32x16 c0, c1;
#pragma unroll
        for (int i = 0; i < 16; ++i) { c0[i] = 0.f; c1[i] = 0.f; }
#pragma unroll
        for (int ks = 0; ks < 16; ++ks) {
            const bf16x8 a = *(const bf16x8*)(ap + 16 * ks), b0 = *(const bf16x8*)(bp + 16 * ks), b1 = *(const bf16x8*)(bp + (size_t)32 * 2048 + 16 * ks);
            c0 = __builtin_amdgcn_mfma_f32_32x32x16_bf16(a, b0, c0, 0, 0, 0); c1 = __builtin_amdgcn_mfma_f32_32x32x16_bf16(a, b1, c1, 0, 0, 0);
        }
        __syncthreads();
#pragma unroll
        for (int i = 0; i < 16; ++i) { const int tok = (i & 3) + 8 * (i >> 2) + 4 * h; red[(wave * 32 + tok) * 64 + r32] = c0[i]; red[(wave * 32 + tok) * 64 + 32 + r32] = c1[i]; }
        __syncthreads();
        { const int tok = tid >> 4, n4 = (tid & 15) * 4; f32x4 sacc = {0.f, 0.f, 0.f, 0.f};
#pragma unroll
          for (int w8 = 0; w8 < 8; ++w8) sacc = sacc + *(const LAS f32x4*)(red + (w8 * 32 + tok) * 64 + n4);
          u32x2 w; w.x = cvt_pk_bf16(sacc[0], sacc[1]); w.y = cvt_pk_bf16(sacc[2], sacc[3]); *(u32x2*)(kpe + (size_t)(m0 + tok) * 64 + n4) = w; }
    }
}
__device__ __forceinline__ void p3_pre(const Params& p, LAS unsigned char* lds, int bx, int G, int tid, int wave, int lane) {
    unsigned char* ws = p.ws;
    const bf16_t* proj = (const bf16_t*)(ws + WS_PROJ); bf16_t* qd = (bf16_t*)(ws + WS_QD); bf16_t* kd = (bf16_t*)(ws + WS_KD);
    constexpr int NQU = (M / 256) * (1536 / 256);
    int row0, rstep, rend, blk0, bstep, bend;
    if (G == 256) {
        if (bx >= NQU) { row0 = (bx - NQU) * NWAVES + wave; rstep = (256 - NQU) * NWAVES; rend = 4096; blk0 = bx - NQU; bstep = 256 - NQU; bend = 128; }
        else { row0 = 4096 + bx * NWAVES + wave; rstep = NQU * NWAVES; rend = M; blk0 = 128 + bx; bstep = 256; bend = 256; }
    } else { row0 = bx * NWAVES + wave; rstep = G * NWAVES; rend = M; blk0 = bx; bstep = G; bend = 256; }
    kpe_gemm(ws, lds, blk0, bstep, bend, tid, wave, lane);
    const int sub = lane & 3, hc = lane >> 2;
    float gq[16], gk[16], frq[8];
#pragma unroll
    for (int j = 0; j < 16; ++j) { gq[j] = p.in[10][sub * 16 + j] * (0.125f * LOG2E); gk[j] = p.in[11][sub * 16 + j]; }
#pragma unroll
    for (int i = 0; i < 8; ++i) frq[i] = rope_freq(i, 16);
    for (int m = row0; m < rend; m += rstep) {
        const bf16_t* pr = proj + (size_t)m * PROJ_LD + lane * 16; const int b = m >> 11, sp = m & 2047;
        const u32x4 q0 = *(const u32x4*)(pr), q1 = *(const u32x4*)(pr + 8), k0 = *(const u32x4*)(pr + 1024), k1 = *(const u32x4*)(pr + 1032);
        float sn[8], cs[8];
#pragma unroll
        for (int i = 0; i < 8; ++i) sincos_ang((float)sp * frq[i], sn[i], cs[i]);
        const size_t off = ((size_t)((b * 16 + hc) * SEQ + sp)) * 64 + sub * 16;
        diff_row(q0, q1, gq, sn, cs, qd + off, sub);
        diff_row(k0, k1, gk, sn, cs, kd + off, sub);
    }
}

__device__ __forceinline__ void mla_row(const u32x4& n0, const u32x4& n1, const u32x4& r0, float rn, float rr, const float (&gn)[16], const float (&gr)[8], const float (&sns)[8], const float (&cs)[8], bf16_t* o, int sub) {
    float fn[16], fr[8];
    { float t[8]; unpack8(n0, t);
#pragma unroll
      for (int j = 0; j < 8; ++j) fn[j] = t[j] * rn;
      unpack8(n1, t);
#pragma unroll
      for (int j = 0; j < 8; ++j) fn[8 + j] = t[j] * rn;
      unpack8(r0, t);
#pragma unroll
      for (int j = 0; j < 8; ++j) fr[j] = t[j] * rr; }
    float ss = 0.f;
#pragma unroll
    for (int j = 0; j < 16; ++j) ss += fn[j] * fn[j];
#pragma unroll
    for (int j = 0; j < 8; ++j) ss += fr[j] * fr[j];
    ss += __shfl_xor(ss, 1); ss += __shfl_xor(ss, 2); ss += __shfl_xor(ss, 4);
    const float rs = 1.0f / sqrtf(ss * (1.0f / 192.0f) + EPS);
#pragma unroll
    for (int j = 0; j < 16; ++j) fn[j] = fn[j] * rs * gn[j];
    float ro[8];
#pragma unroll
    for (int j = 0; j < 8; ++j) { const float v = fr[j] * rs * gr[j]; const float pv = __shfl_xor(v, 4); ro[j] = v * cs[j] + pv * sns[j]; }
    { float t[8];
#pragma unroll
      for (int j = 0; j < 8; ++j) t[j] = fn[j];
      *(u32x4*)(o + sub * 16) = pack8f(t);
#pragma unroll
      for (int j = 0; j < 8; ++j) t[j] = fn[8 + j];
      *(u32x4*)(o + sub * 16 + 8) = pack8f(t); }
    *(u32x4*)(o + 128 + sub * 8) = pack8f(ro);
}
__device__ __forceinline__ void phase4(const Params& p, int gw, int NGW, int lane) {
    unsigned char* ws = p.ws;
    const bf16_t* qf = (const bf16_t*)(ws + WS_QF); const bf16_t* knope = (const bf16_t*)(ws + WS_KNOPE); const bf16_t* kpe = (const bf16_t*)(ws + WS_KPE);
    bf16_t* qm = (bf16_t*)(ws + WS_QM); bf16_t* km = (bf16_t*)(ws + WS_KM);
    const int h = lane >> 3, sub = lane & 7;
    const float qscale = LOG2E / sqrtf(192.0f), sgn = sub < 4 ? -1.0f : 1.0f;
    float gqn[16], gkn[16], gqr[8], gkr[8], frq[8];
#pragma unroll
    for (int j = 0; j < 16; ++j) { gqn[j] = p.in[7][sub * 16 + j] * qscale; gkn[j] = p.in[8][sub * 16 + j]; }
#pragma unroll
    for (int j = 0; j < 8; ++j) { gqr[j] = p.in[7][128 + sub * 8 + j] * qscale; gkr[j] = p.in[8][128 + sub * 8 + j]; frq[j] = rope_freq((sub * 8 + j) & 31, 64); }
    for (int m = gw; m < M; m += NGW) {
        const int b = m >> 11, sp = m & 2047;
        const bf16_t* q0 = qf + (size_t)m * 1536 + h * 192; const bf16_t* k0 = knope + (size_t)m * 1024 + h * 128 + sub * 16;
        const u32x4 qa = *(const u32x4*)(q0 + sub * 16), qb = *(const u32x4*)(q0 + sub * 16 + 8), qc = *(const u32x4*)(q0 + 128 + sub * 8);
        const u32x4 ka = *(const u32x4*)(k0), kb = *(const u32x4*)(k0 + 8), kc = *(const u32x4*)(kpe + (size_t)m * 64 + sub * 8);
        const float* sq = (const float*)(ws + WS_SSQL) + (size_t)m * 16; const float rq = latent_rs(sq), rkv = latent_rs(sq + 8);
        float sns[8], cs[8];
#pragma unroll
        for (int j = 0; j < 8; ++j) { float sv; sincos_ang((float)sp * frq[j], sv, cs[j]); sns[j] = sv * sgn; }
        const size_t off = ((size_t)((b * 8 + h) * SEQ + sp)) * 192;
        mla_row(qa, qb, qc, rq, rq, gqn, gqr, sns, cs, qm + off, sub);
        mla_row(ka, kb, kc, rkv, 1.0f, gkn, gkr, sns, cs, km + off, sub);
    }
}

#define MFMA32(a, b, c) __builtin_amdgcn_mfma_f32_32x32x16_bf16((a), (b), (c), 0, 0, 0)
typedef short s16x4 __attribute__((ext_vector_type(4)));
__device__ __forceinline__ float max3f(float a, float b, float c) { float r; asm("v_max3_f32 %0, %1, %2, %3" : "=v"(r) : "v"(a), "v"(b), "v"(c)); return r; }
__device__ __forceinline__ s16x4 vtr(const LAS unsigned char* p) { return __builtin_bit_cast(s16x4, __builtin_amdgcn_ds_read_tr16_b64_v4i16((LAS s16x4*)p)); }
template <int DQK>
__device__ __forceinline__ void attn_pass(f32x16 (&o)[4], const bf16_t* Qh, const bf16_t* Kh, const bf16_t* Vth, int q0, LAS unsigned char* lds, int tid, int w, int lane) {
    constexpr int KSTR = DQK * 2 + 16, VSTR = 320, NKC = (64 * DQK * 2 / 16) / NTHR, CPR = DQK / 8, KB = 64 * KSTR, VB = 64 * VSTR;
    static_assert(NKC * NTHR * 16 == 64 * DQK * 2, "K tile chunks");
    constexpr bool PIPE = false; constexpr int KA = PIPE ? 1 : 0;
    constexpr int QKB = (DQK == 64) ? 4 : 2, PVB = (DQK == 64) ? 2 : 1;
    constexpr float THR = 8.0f;
    LAS unsigned char* Ks = lds; LAS unsigned char* Vs = lds + 2 * KB;
    const int r32 = lane & 31, h = lane >> 5;
    bf16x8 qf[DQK / 16];
    { const bf16_t* qrow = Qh + (size_t)(q0 + 32 * w + r32) * DQK + 8 * h;
#pragma unroll
      for (int d0 = 0; d0 < DQK / 16; ++d0) qf[d0] = *(const bf16x8*)(qrow + 16 * d0); }
    float m_run = -INFINITY, l_lane = 0.f;
#pragma unroll
    for (int db = 0; db < 4; ++db)
#pragma unroll
        for (int i = 0; i < 16; ++i) o[db][i] = 0.f;
    const int NT = (q0 + 256) >> 6, tmax = (q0 >> 6) + (w >> 1);
    const int qg = q0 + 32 * w + r32;
    u32x4 kreg[NKC], vreg[2];
#define ATT_LDK(R, t) do { _Pragma("unroll") for (int j = 0; j < NKC; ++j) R[j] = ((const u32x4*)(Kh + (size_t)(t) * 64 * DQK))[tid + NTHR * j]; } while (0)
#define ATT_LDV(t) do { _Pragma("unroll") for (int j = 0; j < 2; ++j) vreg[j] = ((const u32x4*)(Vth + (size_t)(t) * 64 * 128))[tid + NTHR * j]; } while (0)
#define ATT_STK(R, buf) do { _Pragma("unroll") for (int j = 0; j < NKC; ++j) { const int c = tid + NTHR * j; *(LAS u32x4*)(Ks + (buf) * KB + (c / CPR) * KSTR + (c % CPR) * 16) = R[j]; } } while (0)
#define ATT_STV(buf) do { _Pragma("unroll") for (int j = 0; j < 2; ++j) { const int c = tid + NTHR * j; *(LAS u32x4*)(Vs + (buf) * VB + (c >> 4) * VSTR + (c & 15) * 16) = vreg[j]; } } while (0)
#define ATT_QK(P0, P1, buf) do { \
        _Pragma("unroll") for (int i = 0; i < 16; ++i) { P0[i] = 0.f; P1[i] = 0.f; } \
        const LAS unsigned char* ka = Ks + (buf) * KB + r32 * KSTR + h * 16; \
        _Pragma("unroll") for (int g0 = 0; g0 < DQK / 16; g0 += QKB) {         \
            bf16x8 fa[QKB], fb[QKB]; \
            _Pragma("unroll") for (int d = 0; d < QKB; ++d) { fa[d] = *(const LAS bf16x8*)(ka + (g0 + d) * 32); fb[d] = *(const LAS bf16x8*)(ka + 32 * KSTR + (g0 + d) * 32); } \
            _Pragma("unroll") for (int d = 0; d < QKB; ++d) { P0 = MFMA32(fa[d], qf[g0 + d], P0); P1 = MFMA32(fb[d], qf[g0 + d], P1); } \
            __builtin_amdgcn_sched_group_barrier(0x100, 2 * QKB, 0); __builtin_amdgcn_sched_group_barrier(0x008, 2 * QKB, 0); } \
        asm volatile("s_nop 15\n\ts_nop 7" : "+v"(P0), "+v"(P1)); } while (0)
#define ATT_SMPV(P0, P1, t, buf) do { \
        if ((t) == tmax) { const int kb = 64 * (t) + 4 * h; \
            _Pragma("unroll") for (int i = 0; i < 16; ++i) { const int kv = kb + (i & 3) + 8 * (i >> 2); if (kv > qg) P0[i] = -INFINITY; if (kv + 32 > qg) P1[i] = -INFINITY; } } \
        float mxa = max3f(P0[0], P0[1], P1[0]), mxb = max3f(P0[2], P0[3], P1[1]); mxa = max3f(mxa, P1[2], P1[3]); \
        _Pragma("unroll") for (int i = 4; i < 16; i += 4) { mxa = max3f(mxa, P0[i], P0[i + 1]); mxb = max3f(mxb, P0[i + 2], P0[i + 3]); mxa = max3f(mxa, P1[i], P1[i + 1]); mxb = max3f(mxb, P1[i + 2], P1[i + 3]); } \
        float mx = max3f(mxa, mxb, mxb); \
        mx = max3f(mx, __shfl_xor(mx, 32), mx); \
        const bool need = mx > m_run + THR; \
        if (__builtin_amdgcn_ballot_w64(need) != 0ull) { \
            const float mnew = need ? mx : m_run, alpha = __builtin_amdgcn_exp2f(m_run - mnew); m_run = mnew; l_lane *= alpha; \
            _Pragma("unroll") for (int db = 0; db < 4; ++db) _Pragma("unroll") for (int i = 0; i < 16; ++i) o[db][i] *= alpha; } \
        float rs = 0.f; \
        _Pragma("unroll") for (int i = 0; i < 16; ++i) { P0[i] = __builtin_amdgcn_exp2f(P0[i] - m_run); P1[i] = __builtin_amdgcn_exp2f(P1[i] - m_run); rs += P0[i] + P1[i]; } \
        l_lane += rs; \
        bf16x8 pb[4]; \
        { u32x4 t0, t1, t2, t3; \
          t0.x = cvt_pk_bf16(P0[0], P0[1]); t0.y = cvt_pk_bf16(P0[2], P0[3]); t0.z = cvt_pk_bf16(P0[4], P0[5]); t0.w = cvt_pk_bf16(P0[6], P0[7]); \
          t1.x = cvt_pk_bf16(P0[8], P0[9]); t1.y = cvt_pk_bf16(P0[10], P0[11]); t1.z = cvt_pk_bf16(P0[12], P0[13]); t1.w = cvt_pk_bf16(P0[14], P0[15]); \
          t2.x = cvt_pk_bf16(P1[0], P1[1]); t2.y = cvt_pk_bf16(P1[2], P1[3]); t2.z = cvt_pk_bf16(P1[4], P1[5]); t2.w = cvt_pk_bf16(P1[6], P1[7]); \
          t3.x = cvt_pk_bf16(P1[8], P1[9]); t3.y = cvt_pk_bf16(P1[10], P1[11]); t3.z = cvt_pk_bf16(P1[12], P1[13]); t3.w = cvt_pk_bf16(P1[14], P1[15]); \
          pb[0] = __builtin_bit_cast(bf16x8, t0); pb[1] = __builtin_bit_cast(bf16x8, t1); pb[2] = __builtin_bit_cast(bf16x8, t2); pb[3] = __builtin_bit_cast(bf16x8, t3); } \
        const LAS unsigned char* va = Vs + (buf) * VB + (4 * h + ((lane & 15) >> 2)) * VSTR + ((lane >> 4) & 1) * 32 + (lane & 3) * 8; \
        _Pragma("unroll") for (int dp = 0; dp < 4; dp += PVB) { \
            s16x4 lo[PVB][4], hi[PVB][4]; \
            _Pragma("unroll") for (int d2 = 0; d2 < PVB; ++d2) _Pragma("unroll") for (int ks = 0; ks < 4; ++ks) { lo[d2][ks] = vtr(va + (dp + d2) * 64 + (ks * 16) * VSTR); hi[d2][ks] = vtr(va + (dp + d2) * 64 + (ks * 16 + 8) * VSTR); } \
            _Pragma("unroll") for (int ks = 0; ks < 4; ++ks) _Pragma("unroll") for (int d2 = 0; d2 < PVB; ++d2) { \
                const bf16x8 a = (bf16x8){lo[d2][ks][0], lo[d2][ks][1], lo[d2][ks][2], lo[d2][ks][3], hi[d2][ks][0], hi[d2][ks][1], hi[d2][ks][2], hi[d2][ks][3]}; o[dp + d2] = MFMA32(a, pb[ks], o[dp + d2]); } \
            __builtin_amdgcn_sched_group_barrier(0x100, 8 * PVB, 0); __builtin_amdgcn_sched_group_barrier(0x008, 4 * PVB, 0); } } while (0)
#define ATT_ITER(C0, C1, N0, N1, tt, B, NB) do { \
        __syncthreads(); \
        if constexpr (PIPE) { if ((tt) + 2 < NT) ATT_STK(kreg, B); } else { if ((tt) + 1 < NT) ATT_STK(kreg, NB); } \
        if ((tt) + 1 < NT) ATT_STV(NB); \
        if ((tt) + 2 + KA < NT) ATT_LDK(kreg, (tt) + 2 + KA); \
        if ((tt) + 2 < NT) ATT_LDV((tt) + 2); \
        if constexpr (PIPE) { if ((tt) + 1 <= tmax) ATT_QK(N0, N1, NB); if ((tt) <= tmax) ATT_SMPV(C0, C1, tt, B); } \
        else { if ((tt) <= tmax) { ATT_QK(C0, C1, B); ATT_SMPV(C0, C1, tt, B); } } } while (0)
    f32x16 pA0, pA1, pB0, pB1;
    if constexpr (PIPE) {
        u32x4 kreg2[NKC];
        ATT_LDK(kreg, 0); ATT_LDV(0); ATT_LDK(kreg2, 1);
        __syncthreads();
        ATT_STK(kreg, 0); ATT_STV(0); ATT_STK(kreg2, 1);
        ATT_LDK(kreg, 2); ATT_LDV(1);
        __syncthreads();
        ATT_QK(pA0, pA1, 0);
        for (int t = 0; t < NT; t += 2) {
            ATT_ITER(pA0, pA1, pB0, pB1, t, 0, 1);
            ATT_ITER(pB0, pB1, pA0, pA1, t + 1, 1, 0);
        }
    } else {
        u32x4 kreg2[NKC], vreg2[2];
        ATT_LDK(kreg, 0); ATT_LDV(0);
        ATT_LDK(kreg2, 1);
#pragma unroll
        for (int j = 0; j < 2; ++j) vreg2[j] = ((const u32x4*)(Vth + (size_t)64 * 128))[tid + NTHR * j];
        __syncthreads();
        ATT_STK(kreg, 0); ATT_STV(0);
#pragma unroll
        for (int j = 0; j < NKC; ++j) kreg[j] = kreg2[j];
#pragma unroll
        for (int j = 0; j < 2; ++j) vreg[j] = vreg2[j];
        for (int t = 0; t < NT; t += 2) {
            ATT_ITER(pA0, pA1, pA0, pA1, t, 0, 1);
            ATT_ITER(pA0, pA1, pA0, pA1, t + 1, 1, 0);
        }
    }
#undef ATT_LDK
#undef ATT_LDV
#undef ATT_STK
#undef ATT_STV
#undef ATT_QK
#undef ATT_SMPV
#undef ATT_ITER
    float l = l_lane + __shfl_xor(l_lane, 32);
    const float inv = 1.0f / l;
#pragma unroll
    for (int db = 0; db < 4; ++db)
#pragma unroll
        for (int i = 0; i < 16; ++i) o[db][i] *= inv;
}
__device__ __forceinline__ void attn_out_store(const f32x16 (&o)[4], const float* gain, float scale, bf16_t* dst_row, int h) {
    float ss = 0.f;
#pragma unroll
    for (int db = 0; db < 4; ++db)
#pragma unroll
        for (int i = 0; i < 16; ++i) ss += o[db][i] * o[db][i];
    ss += __shfl_xor(ss, 32);
    const float rn = scale / sqrtf(ss * (1.0f / 128.0f) + EPS);
#pragma unroll
    for (int db = 0; db < 4; ++db)
#pragma unroll
        for (int g4 = 0; g4 < 4; ++g4) { const int d = 32 * db + 8 * g4 + 4 * h; const f32x4 gv = *(const f32x4*)(gain + d);
            u32x2 w; w.x = cvt_pk_bf16(o[db][4 * g4] * rn * gv[0], o[db][4 * g4 + 1] * rn * gv[1]); w.y = cvt_pk_bf16(o[db][4 * g4 + 2] * rn * gv[2], o[db][4 * g4 + 3] * rn * gv[3]);
            *(u32x2*)(dst_row + d) = w; }
}
__device__ __forceinline__ void phase5(const Params& p, LAS unsigned char* lds, unsigned* ctr, int tid, int wave, int lane) {
    unsigned char* ws = p.ws;
    const bf16_t* qm = (const bf16_t*)(ws + WS_QM); const bf16_t* km = (const bf16_t*)(ws + WS_KM); const bf16_t* vtm = (const bf16_t*)(ws + WS_VTM);
    const bf16_t* qd = (const bf16_t*)(ws + WS_QD); const bf16_t* kd = (const bf16_t*)(ws + WS_KD); const bf16_t* vtd = (const bf16_t*)(ws + WS_VTD);
    bf16_t* ao = (bf16_t*)(ws + WS_AO);
    LAS unsigned* shw = (LAS unsigned*)(lds + 163824);
    float lam;
    { const float a = p.in[12][lane] * p.in[13][lane], b2 = p.in[14][lane] * p.in[15][lane];
      lam = __expf(wave_sum(a)) - __expf(wave_sum(b2)) + LAMBDA_INIT; }
    const int r32 = lane & 31, h = lane >> 5;
    for (;;) {
        __syncthreads();
        if (tid == 0) shw[0] = atomicAdd(ctr, 1u);
        __syncthreads();
        const unsigned uq = shw[0];
        if (uq >= 928u) break;
        const unsigned grp = uq / 29u, ing = uq % 29u;
        if (ing >= 16u) {
            const int cj = (int)(grp * 13u + ing - 16u);
            p0_convert(p, lds, P0_ITEMS_EARLY + 16 * cj, P0_ITEMS_EARLY + 16 * cj + 16, wave, NWAVES, wave, lane);
            continue;
        }
        const unsigned u = grp * 16u + ing;
        const int cls = (int)(u >> 5), bh = (int)(u & 31u);
        const int isdiff = (0x552B >> cls) & 1, qb = (int)((0x0011223345465767ull >> (4 * cls)) & 15ull);
        const int q0 = qb * 256, b = bh >> 3, hd = bh & 7;
        if (!isdiff) {
            f32x16 o[4];
            attn_pass<192>(o, qm + (size_t)bh * SEQ * 192, km + (size_t)bh * SEQ * 192, vtm + (size_t)bh * 128 * SEQ, q0, lds, tid, wave, lane);
            attn_out_store(o, p.in[9], 1.0f, ao + (size_t)(b * SEQ + q0 + 32 * wave + r32) * DM + hd * 128, h);
        } else {
            f32x16 o[4];
            LAS unsigned* st = (LAS unsigned*)(lds + 59392) + wave * 2048 + lane;
            attn_pass<64>(o, qd + (size_t)(bh * 2 + 1) * SEQ * 64, kd + (size_t)(bh * 2 + 1) * SEQ * 64, vtd + (size_t)bh * 128 * SEQ, q0, lds, tid, wave, lane);
#pragma unroll
            for (int db = 0; db < 4; ++db)
#pragma unroll
                for (int i = 0; i < 16; i += 2) st[(db * 8 + (i >> 1)) * 64] = cvt_pk_bf16(o[db][i], o[db][i + 1]);
            attn_pass<64>(o, qd + (size_t)(bh * 2) * SEQ * 64, kd + (size_t)(bh * 2) * SEQ * 64, vtd + (size_t)bh * 128 * SEQ, q0, lds, tid, wave, lane);
#pragma unroll
            for (int db = 0; db < 4; ++db)
#pragma unroll
                for (int i = 0; i < 16; i += 2) { const unsigned wv = st[(db * 8 + (i >> 1)) * 64]; o[db][i] -= lam * bflo(wv); o[db][i + 1] -= lam * bfhi(wv); }
            attn_out_store(o, p.in[16], 1.0f - LAMBDA_INIT, ao + (size_t)(b * SEQ + q0 + 32 * wave + r32) * DM + hd * 128 + 1024, h);
        }
    }
}

#define XB_TMO      128
#define XB_XCNT(j)  (256  + 64 * (j))
#define XB_XSUB(j)  (1280 + 64 * (j))
#define XB_XGEN(j)  (2304 + 64 * (j))
#define XB_TOP      3328
#define XB_TOPGEN   3392
#define XCD_BAR_WORDS 3456
#define XB_SPIN_CAP (1u << 18)

__device__ __forceinline__ unsigned xb_ld(unsigned* p)              { return __hip_atomic_load(p, __ATOMIC_RELAXED, __HIP_MEMORY_SCOPE_AGENT); }
__device__ __forceinline__ unsigned xb_add(unsigned* p, unsigned v) { return __hip_atomic_fetch_add(p, v, __ATOMIC_RELAXED, __HIP_MEMORY_SCOPE_AGENT); }
__device__ __forceinline__ unsigned xb_xcc_id() { return (unsigned)__builtin_amdgcn_s_getreg((3 << 11) | 20) & 0xFu; }
#define XB_SPIN(cond, bar) do { unsigned _sp = 0; while (cond) { __builtin_amdgcn_s_sleep(1); \
    if ((++_sp & 255u) == 0u) { if (xb_ld(&(bar)[XB_TMO])) break; if (_sp > XB_SPIN_CAP) { atomicAdd(&(bar)[XB_TMO], 1u); break; } } } } while (0)

struct XcdBarrier {
    unsigned* bar; unsigned x;
    volatile LAS unsigned* st;
};

__device__ __forceinline__ XcdBarrier xcd_barrier_post(unsigned* bar, volatile LAS unsigned* st) {
    XcdBarrier b; b.bar = bar; b.x = xb_xcc_id(); b.st = st;
    if (threadIdx.x == 0) (void)xb_add(&bar[XB_XCNT(b.x)], 1u);
    return b;
}
__device__ __forceinline__ void xcd_barrier_complete(unsigned* bar, unsigned x, unsigned& nloc, unsigned& nx) {
    const unsigned G = gridDim.x * gridDim.y * gridDim.z;
    unsigned sum, cnt, mine, sp = 0u;
    for (;;) {
        sum = 0u; cnt = 0u; mine = 0u;
#pragma unroll
        for (unsigned j = 0; j < 16; ++j) { const unsigned c = xb_ld(&bar[XB_XCNT(j)]); sum += c; cnt += (c > 0u) ? 1u : 0u; mine = (j == x) ? c : mine; }
        if (sum == G) break;
        __builtin_amdgcn_s_sleep(1);
        if ((++sp & 255u) == 0u) { if (xb_ld(&bar[XB_TMO])) break; if (sp > XB_SPIN_CAP) { atomicAdd(&bar[XB_TMO], 1u); break; } }
    }
    nloc = mine > 0u ? mine : 1u; nx = cnt > 0u ? cnt : 1u;
}

__device__ __forceinline__ void xcd_barrier(const XcdBarrier& b) {
    asm volatile("s_waitcnt vmcnt(0)" ::: "memory");
    __syncthreads();
    if (threadIdx.x == 0) {
        unsigned* bar = b.bar;
        __builtin_amdgcn_s_waitcnt(0);
        unsigned nloc = b.st[0], nx = b.st[1];
        if (nloc == 0u) { xcd_barrier_complete(bar, b.x, nloc, nx); b.st[0] = nloc; b.st[1] = nx; }
        const unsigned old = xb_add(&bar[XB_XSUB(b.x)], 1u);
        const unsigned gen = old / nloc;
        if (old + 1u == (gen + 1u) * nloc) {
            __builtin_amdgcn_fence(__ATOMIC_RELEASE, "agent");
            asm volatile("s_waitcnt vmcnt(0)" ::: "memory");
            const unsigned og = xb_add(&bar[XB_TOP], 1u);
            const unsigned tg = og / nx;
            if (og + 1u == (tg + 1u) * nx) xb_add(&bar[XB_TOPGEN], 1u);
            else XB_SPIN(xb_ld(&bar[XB_TOPGEN]) == tg, bar);
            __builtin_amdgcn_fence(__ATOMIC_ACQUIRE, "agent");
            xb_add(&bar[XB_XGEN(b.x)], 1u);
            asm volatile("s_waitcnt vmcnt(0)" ::: "memory");
        } else {
            XB_SPIN(xb_ld(&bar[XB_XGEN(b.x)]) == gen, bar);
            __builtin_amdgcn_fence(__ATOMIC_ACQUIRE, "agent");
            asm volatile("s_waitcnt vmcnt(0)" ::: "memory");
        }
    }
    __syncthreads();
}

__global__ void __launch_bounds__(NTHR, 2) fwd_kernel(Params p) {
    extern __shared__ __attribute__((aligned(16))) unsigned char lds_raw[];
    LAS unsigned char* lds = (LAS unsigned char*)lds_raw;
    const int tid = threadIdx.x, lane = tid & 63, wave = __builtin_amdgcn_readfirstlane(tid >> 6);
    const int G = gridDim.x, bx = blockIdx.x;
    const int gw = bx * NWAVES + wave, NGW = G * NWAVES;
    unsigned char* ws = p.ws;
    unsigned* ctl = MK_ONE_LAUNCH ? g_ctl : (unsigned*)(ws + WS_CTL);
    const int lo = p.ph_lo, hi = p.ph_hi;
    volatile LAS unsigned* bst = (volatile LAS unsigned*)(lds + 163808);
    if (tid == 0) { bst[0] = 0u; bst[1] = 0u; }
    __syncthreads();
    XcdBarrier bar; bar.bar = ctl + 1024; bar.x = 0; bar.st = bst;
    if (hi > lo) bar = xcd_barrier_post(ctl + 1024, bst);
    if (hi > 1000) cg::this_grid().sync();
#define IN(k) (lo <= (k) && (k) < hi)
#define SEAM(k) do { if (IN(k) && IN((k) + 1)) { xcd_barrier(bar); } } while (0)
    if (IN(0)) { if (bx == 0 && tid == 0) { ctl[0] = 0u; ctl[64] = 0u; }
        phase0(p, lds, gw, NGW, wave, lane); }
    SEAM(0);
    if (IN(1)) {
        pg8::Gemm g{(const bf16_t*)(ws + WS_HB), (const bf16_t*)(ws + WS_WIN), M, NPROJ, 2048}; pg8::StaticOrder S; S.init(M, NPROJ, G, bx);
        EpiProj E{(bf16_t*)(ws + WS_QLAT), (bf16_t*)(ws + WS_KVLAT), (float*)(ws + WS_SSQL), (bf16_t*)(ws + WS_PROJ), (bf16_t*)(ws + WS_VTD)};
        pg8::gemm_phase<EpiProj, pg8::StaticOrder, true, true>(lds, g, S, E);
    }
    SEAM(1);
    if (IN(3)) {
        p3_pre(p, lds, bx, G, tid, wave, lane);
        __syncthreads();
        { pg8::Gemm g{(const bf16_t*)(ws + WS_QLAT), (const bf16_t*)(ws + WS_WQ), 2 * M, 3584, 512}; StackedOrder S{G, bx};
          EpiQKv E{EpiPlain{(bf16_t*)(ws + WS_QF), 1536}, EpiKv{(bf16_t*)(ws + WS_KNOPE), (bf16_t*)(ws + WS_VTM), (const float*)(ws + WS_SSQL)}};
          pg8::gemm_phase<EpiQKv, StackedOrder, true, true>(lds, g, S, E); }
    }
    SEAM(3);
    if (IN(4)) phase4(p, gw, NGW, lane);
    SEAM(4);
    if (IN(5)) phase5(p, lds, ctl, tid, wave, lane);
    SEAM(5);
    if (IN(6)) {
        pg8::Gemm g{(const bf16_t*)(ws + WS_AO), (const bf16_t*)(ws + WS_WO), M, DM, 2048}; pg8::StaticOrder S; S.init(M, DM, G, bx);
        EpiWo E{p.in[0], p.out, (bf16_t*)(ws + WS_X1B), (float*)(ws + WS_SSQ)};
        pg8::gemm_phase<EpiWo, pg8::StaticOrder, true, true>(lds, g, S, E);
    }
    SEAM(6);
    if (IN(7)) {
        pg8::Gemm g{(const bf16_t*)(ws + WS_X1B), (const bf16_t*)(ws + WS_WGU), M, 2 * DFF, 2048}; pg8::StaticOrder S; S.init(M, 2 * DFF, G, bx);
        EpiGateUp E{(const float*)(ws + WS_SSQ), (bf16_t*)(ws + WS_HMID)};
        pg8::gemm_phase<EpiGateUp, pg8::StaticOrder, true, true>(lds, g, S, E);
        { const int nwg = (M / 256) * (2 * DFF / 256), rem = nwg % G;
          if (rem == 0) p0_convert(p, lds, P0_NITEMS - P0_ITEMS_WD, P0_NITEMS, gw, NGW, wave, lane);
          else if (bx >= rem) p0_convert(p, lds, P0_NITEMS - P0_ITEMS_WD, P0_NITEMS, (bx - rem) * NWAVES + wave, (G - rem) * NWAVES, wave, lane); }
    }
    SEAM(7);
    if (IN(8)) {
        pg8::Gemm g{(const bf16_t*)(ws + WS_HMID), (const bf16_t*)(ws + WS_WD), M, DM, DFF}; pg8::StaticOrder S; S.init(M, DM, G, bx);
        EpiDown E{(const bf16_t*)(ws + WS_X1B), p.out};
        pg8::gemm_phase<EpiDown, pg8::StaticOrder, true, true>(lds, g, S, E);
    }
#if MK_ONE_LAUNCH
    if (hi > lo) {
        LAS unsigned* shx = (LAS unsigned*)(lds + 163828);
        __syncthreads();
        if (tid == 0) { __threadfence(); shx[0] = (atomicAdd(&ctl[128], 1u) == (unsigned)(G - 1)) ? 1u : 0u; }
        __syncthreads();
        if (shx[0]) { for (int i = tid; i < 8192; i += NTHR) __hip_atomic_store(&ctl[i], 0u, __ATOMIC_RELAXED, __HIP_MEMORY_SCOPE_AGENT); }
    }
#endif
#undef IN
#undef SEAM
}
}

extern "C" void kernel_launch(void* const* d_in, const int* in_sizes, int n_in, void* d_out, int out_size, void* d_ws, size_t ws_size, hipStream_t stream) {
    static int grid = 0;
    if (grid == 0) {
        if (n_in != 22 || out_size != mk::M * mk::DM || ws_size < mk::WS_END) { fprintf(stderr, "kernel_launch: unexpected shapes (n_in %d out %d ws %zu)\n", n_in, out_size, ws_size); grid = -1; return; }
        int dev = 0, cus = 0, per_cu = 0;
        if (hipGetDevice(&dev) != hipSuccess || hipDeviceGetAttribute(&cus, hipDeviceAttributeMultiprocessorCount, dev) != hipSuccess) { grid = -1; return; }
        if (hipFuncSetAttribute((const void*)mk::fwd_kernel, hipFuncAttributeMaxDynamicSharedMemorySize, mk::LDS_BYTES) != hipSuccess) { fprintf(stderr, "kernel_launch: hipFuncSetAttribute failed\n"); grid = -1; return; }
        if (hipOccupancyMaxActiveBlocksPerMultiprocessor(&per_cu, (const void*)mk::fwd_kernel, mk::NTHR, mk::LDS_BYTES) != hipSuccess || per_cu < 1) { fprintf(stderr, "kernel_launch: occupancy query says %d\n", per_cu); per_cu = 1; }
        (void)hipGetLastError();
        grid = cus * per_cu;
    }
    if (grid < 0) return;
#if !MK_ONE_LAUNCH
    if (hipMemsetAsync((char*)d_ws + mk::WS_CTL, 0, 32768, stream) != hipSuccess) { fprintf(stderr, "kernel_launch: hipMemsetAsync failed\n"); return; }
#endif
    mk::Params p{};
    for (int i = 0; i < 22; ++i) p.in[i] = (const float*)d_in[i];
    p.out = (float*)d_out; p.ws = (unsigned char*)d_ws;
#if MK_ONE_LAUNCH
    p.ph_lo = 0; p.ph_hi = 9;
    void* args[] = {&p};
    hipError_t e = hipLaunchCooperativeKernel((const void*)mk::fwd_kernel, dim3(grid), dim3(mk::NTHR), args, mk::LDS_BYTES, stream);
    if (e != hipSuccess) fprintf(stderr, "cooperative launch failed: %s (grid %d)\n", hipGetErrorString(e), grid);
#else
    for (int k = 0; k < 9; ++k) { p.ph_lo = k; p.ph_hi = k + 1; hipLaunchKernelGGL(mk::fwd_kernel, dim3(grid), dim3(mk::NTHR), mk::LDS_BYTES, stream, p); }
#endif
}
```

```cpp
#include <hip/hip_runtime.h>
#include <hip/hip_cooperative_groups.h>
#include <cstdio>
#include <cstdint>
namespace cg = cooperative_groups;
namespace pg8 {
#define PG8_LAS __attribute__((address_space(3)))
typedef unsigned short bf16_t;
typedef short bf16x8 __attribute__((ext_vector_type(8)));
typedef float f32x4 __attribute__((ext_vector_type(4)));
typedef unsigned u32x4 __attribute__((ext_vector_type(4)));
constexpr int BM = 256, BK = 64, HALF = 128, HTB = HALF * BK * 2  , STAGE_BYTES = 8 * HTB, NXCD = 8, WGM = 2;

__host__ __device__ __forceinline__ int lds_byte(int r, int c) { const int st = (r >> 4) * 2 + (c >> 5), rr = r & 15, cc = c & 31, ob = rr * 64 + cc * 2; return st * 1024 + (ob ^ (((ob >> 9) & 1) << 5)); }
__host__ __device__ __forceinline__ void stage_rc(int b, int& R, int& C) { const int st = b / 1024, sb = b % 1024, swz = sb ^ (((sb >> 9) & 1) << 5); R = (st >> 1) * 16 + swz / 64; C = (st & 1) * 32 + (swz % 64) / 2; }
__host__ __device__ __forceinline__ int perm32(int rho) { const int n = rho >> 4, i = rho & 15; return 8 * (i >> 2) + 4 * n + (i & 3); }

struct Unit { int pm, pn; };
struct Gemm { const bf16_t* A; const bf16_t* Bt; int M, N, K; };

struct StaticOrder {
    int nM, nN, nwg, G, c;
    __host__ __device__ void init(int M, int N, int G_, int c_) { nM = M / BM; nN = N / BM; nwg = nM * nN; G = G_; c = c_; }
    __host__ __device__ bool next(int i, Unit& u) const {
        const long L = (long)i * G + c; if (L >= nwg) return false;
        int wgid = (int)L; { const int q = nwg / NXCD, r = nwg % NXCD, xcd = wgid % NXCD, off = wgid / NXCD; wgid = (xcd < r ? xcd * (q + 1) : r * (q + 1) + (xcd - r) * q) + off; }
        const int nig = WGM * nN, gid = wgid / nig, fm = gid * WGM, gsz = (nM - fm) < WGM ? (nM - fm) : WGM;
        u.pm = fm + ((wgid % nig) % gsz); u.pn = (wgid % nig) / gsz; return true;
    }
    __device__ __forceinline__ void a_ready(const Unit&) const {}
    __device__ __forceinline__ void done(const Unit&) const {}
};

__device__ __forceinline__ unsigned cvt_pk_bf16(float lo, float hi) { unsigned r; asm volatile("v_cvt_pk_bf16_f32 %0, %1, %2" : "=v"(r) : "v"(lo), "v"(hi)); return r; }
typedef float f32x2 __attribute__((ext_vector_type(2)));
template <class Epi, class Sched, bool ALIGN_EPI = false, bool SP2 = false>
__device__ __forceinline__ void gemm_phase(PG8_LAS unsigned char* lds, const Gemm g, const Sched& S, const Epi& E) {
    const int tid = threadIdx.x, wid = __builtin_amdgcn_readfirstlane(tid >> 6), lane = tid & 63, wr = wid >> 2, wc = wid & 3, fr = lane & 15, fq = lane >> 4;
    const int K = g.K, nt = K / BK;
    unsigned voffA[2], voffB[2];
#pragma unroll
    for (int i = 0; i < 2; ++i) { int R, C; stage_rc(tid * 16 + i * 8192, R, C); const int Rb = Epi::PERM ? ((R & ~31) + perm32(R & 31)) : R;
        voffA[i] = (unsigned)(R * K + C) * 2u; voffB[i] = (unsigned)(Rb * K + C) * 2u; }
    const size_t kstep = (size_t)(BK * 2);
    const size_t hstep = (size_t)HALF * K * 2;
    const size_t tstep = 2 * hstep;
    const unsigned ldsw = (unsigned)wid * 1024u;
    const int aoff = lds_byte(wr * 64 + fr, fq * 8), boff = lds_byte(wc * 32 + fr, fq * 8);
#define PG8_SA(b, h) (((b) * 2 + (h)) * HTB)
#define PG8_SB(b, h) ((4 + (b) * 2 + (h)) * HTB)
#define PG8_STAGE(bufoff, gbase, voff) do { _Pragma("unroll") for (int _i = 0; _i < 2; ++_i) \
        __builtin_amdgcn_global_load_lds((const unsigned*)((const char*)(gbase) + (voff)[_i]), (PG8_LAS unsigned*)(lds + (bufoff) + ldsw + _i * 8192), 16, 0, 0); } while (0)
#define PG8_LDA(dst, b, h) do { _Pragma("unroll") for (int m = 0; m < 4; ++m) _Pragma("unroll") for (int k = 0; k < 2; ++k) dst[m][k] = *(const PG8_LAS bf16x8*)(lds + PG8_SA(b, h) + aoff + m * 2048 + k * 1024); } while (0)
#define PG8_LDB(dst, b, h) do { _Pragma("unroll") for (int n = 0; n < 2; ++n) _Pragma("unroll") for (int k = 0; k < 2; ++k) dst[n][k] = *(const PG8_LAS bf16x8*)(lds + PG8_SB(b, h) + boff + n * 2048 + k * 1024); } while (0)
#define PG8_MMA(ai, bj, At, Bt) do { __builtin_amdgcn_s_setprio(1); _Pragma("unroll") for (int m = 0; m < 4; ++m) _Pragma("unroll") for (int n = 0; n < 2; ++n) _Pragma("unroll") for (int k = 0; k < 2; ++k) \
        acc[ai][bj][m][n] = __builtin_amdgcn_mfma_f32_16x16x32_bf16(Bt[n][k], At[m][k], acc[ai][bj][m][n], 0, 0, 0); __builtin_amdgcn_s_setprio(0); } while (0)
#define PG8_WAIT_V(n) asm volatile("s_waitcnt vmcnt(" #n ")" ::: "memory")
#define PG8_WAIT_L(n) asm volatile("s_waitcnt lgkmcnt(" #n ")" ::: "memory")
#define PG8_BAR __builtin_amdgcn_s_barrier()
#define PG8_SCHED __builtin_amdgcn_sched_barrier(0)
    Unit cur, nxt; int ui = 0;
    if (!S.next(0, cur)) return;
    f32x4 acc[2][2][4][2];
#pragma unroll
    for (int a = 0; a < 2; ++a)
#pragma unroll
        for (int b = 0; b < 2; ++b)
#pragma unroll
            for (int m = 0; m < 4; ++m)
#pragma unroll
                for (int n = 0; n < 2; ++n) acc[a][b][m][n] = (f32x4){0.f, 0.f, 0.f, 0.f};
    bf16x8 At[4][2], B0[2][2], B1[2][2];
    const char* cA = (const char*)g.A + (size_t)cur.pm * tstep; const char* cB = (const char*)g.Bt + (size_t)cur.pn * tstep;
    S.a_ready(cur);
    if constexpr (SP2) {
        PG8_STAGE(PG8_SB(0, 0), cB, voffB); PG8_STAGE(PG8_SB(0, 1), cB + hstep, voffB); PG8_STAGE(PG8_SA(0, 0), cA, voffA); PG8_STAGE(PG8_SA(0, 1), cA + hstep, voffA);
        if (wr == 1) PG8_BAR;
        PG8_WAIT_V(2); PG8_BAR;
        PG8_STAGE(PG8_SB(1, 0), cB + kstep, voffB); PG8_STAGE(PG8_SA(1, 0), cA + kstep, voffA); PG8_STAGE(PG8_SB(1, 1), cB + hstep + kstep, voffB);
        PG8_WAIT_V(6); PG8_BAR;
    } else {
        PG8_STAGE(PG8_SB(0, 0), cB, voffB); PG8_STAGE(PG8_SA(0, 0), cA, voffA); PG8_STAGE(PG8_SB(0, 1), cB + hstep, voffB); PG8_STAGE(PG8_SA(0, 1), cA + hstep, voffA);
        if (wr == 1) PG8_BAR;
        PG8_WAIT_V(4); PG8_BAR;
        PG8_STAGE(PG8_SB(1, 0), cB + kstep, voffB); PG8_STAGE(PG8_SA(1, 0), cA + kstep, voffA); PG8_STAGE(PG8_SB(1, 1), cB + hstep + kstep, voffB);
        PG8_WAIT_V(6); PG8_BAR;
    }
    for (;;) {
        const bool has_next = S.next(ui + 1, nxt);
        const char* nA = has_next ? (const char*)g.A + (size_t)nxt.pm * tstep : cA; const char* nB = has_next ? (const char*)g.Bt + (size_t)nxt.pn * tstep : cB;
        for (int t = 0; t < nt; t += 2) {
            const bool last = (t == nt - 2);
            const char* a1 = cA + (size_t)(t + 1) * kstep;
            const char* a2 = last ? nA : cA + (size_t)(t + 2) * kstep; const char* b2 = last ? nB : cB + (size_t)(t + 2) * kstep;
            const char* a3 = a2 + kstep; const char* b3 = b2 + kstep;
            if (last && has_next) S.a_ready(nxt);
            if constexpr (SP2) {
            PG8_LDB(B0, 0, 0); PG8_LDB(B1, 0, 1); PG8_SCHED; PG8_LDA(At, 0, 0); PG8_STAGE(PG8_SA(1, 1), a1 + hstep, voffA);
            PG8_WAIT_V(8); PG8_WAIT_L(0); PG8_BAR; PG8_MMA(0, 0, At, B0); PG8_MMA(0, 1, At, B1); PG8_BAR; PG8_SCHED;
            PG8_LDA(At, 0, 1); PG8_STAGE(PG8_SB(0, 0), b2, voffB); PG8_STAGE(PG8_SB(0, 1), b2 + hstep, voffB); PG8_STAGE(PG8_SA(0, 0), a2, voffA);
            PG8_WAIT_V(8); PG8_WAIT_L(0); PG8_BAR; PG8_MMA(1, 0, At, B0); PG8_MMA(1, 1, At, B1); PG8_BAR; PG8_SCHED;
            PG8_LDB(B0, 1, 0); PG8_LDB(B1, 1, 1); PG8_SCHED; PG8_LDA(At, 1, 0); PG8_STAGE(PG8_SA(0, 1), a2 + hstep, voffA);
            PG8_WAIT_V(8); PG8_WAIT_L(0); PG8_BAR; PG8_MMA(0, 0, At, B0); PG8_MMA(0, 1, At, B1); PG8_BAR; PG8_SCHED;
            PG8_LDA(At, 1, 1); PG8_STAGE(PG8_SB(1, 0), b3, voffB); PG8_STAGE(PG8_SB(1, 1), b3 + hstep, voffB); PG8_STAGE(PG8_SA(1, 0), a3, voffA);
            PG8_WAIT_V(8); PG8_WAIT_L(0); PG8_BAR; PG8_MMA(1, 0, At, B0); PG8_MMA(1, 1, At, B1); PG8_BAR; PG8_SCHED;
            } else {
            PG8_LDB(B0, 0, 0); PG8_SCHED; PG8_LDA(At, 0, 0); PG8_STAGE(PG8_SA(1, 1), a1 + hstep, voffA);
            PG8_WAIT_L(8); PG8_BAR; PG8_WAIT_L(0); PG8_MMA(0, 0, At, B0); PG8_BAR; PG8_SCHED;
            PG8_LDB(B1, 0, 1); PG8_STAGE(PG8_SB(0, 0), b2, voffB);
            PG8_BAR; PG8_WAIT_L(0); PG8_MMA(0, 1, At, B1); PG8_BAR;
            PG8_LDA(At, 0, 1); PG8_STAGE(PG8_SA(0, 0), a2, voffA);
            PG8_BAR; PG8_WAIT_L(0); PG8_MMA(1, 0, At, B0); PG8_BAR; PG8_SCHED;
            PG8_STAGE(PG8_SB(0, 1), b2 + hstep, voffB);
            PG8_WAIT_V(6); PG8_BAR; PG8_MMA(1, 1, At, B1); PG8_BAR;
            PG8_LDB(B0, 1, 0); PG8_SCHED; PG8_LDA(At, 1, 0); PG8_STAGE(PG8_SA(0, 1), a2 + hstep, voffA);
            PG8_WAIT_L(8); PG8_BAR; PG8_WAIT_L(0); PG8_MMA(0, 0, At, B0); PG8_BAR; PG8_SCHED;
            PG8_LDB(B1, 1, 1); PG8_STAGE(PG8_SB(1, 0), b3, voffB);
            PG8_BAR; PG8_WAIT_L(0); PG8_MMA(0, 1, At, B1); PG8_BAR;
            PG8_LDA(At, 1, 1); PG8_STAGE(PG8_SA(1, 0), a3, voffA);
            PG8_BAR; PG8_WAIT_L(0); PG8_MMA(1, 0, At, B0); PG8_BAR; PG8_SCHED;
            PG8_STAGE(PG8_SB(1, 1), b3 + hstep, voffB);
            PG8_WAIT_V(6); PG8_BAR; PG8_MMA(1, 1, At, B1); PG8_BAR;
            }
        }
        if constexpr (ALIGN_EPI) { if (wr == 0) PG8_BAR; }
        if constexpr (!Epi::AFTER_DRAIN) { E(acc, cur, wr, wc, fr, fq); S.done(cur); }
        if (!has_next) break;
#pragma unroll
        for (int a = 0; a < 2; ++a)
#pragma unroll
            for (int b = 0; b < 2; ++b)
#pragma unroll
                for (int m = 0; m < 4; ++m)
#pragma unroll
                    for (int n = 0; n < 2; ++n) acc[a][b][m][n] = (f32x4){0.f, 0.f, 0.f, 0.f};
        cur = nxt; cA = nA; cB = nB; ++ui;
        if constexpr (ALIGN_EPI) { if (wr == 1) PG8_BAR; }
    }
    PG8_WAIT_V(0);
    if constexpr (!ALIGN_EPI) { if (wr == 0) PG8_BAR; }
    PG8_BAR;
    if constexpr (Epi::AFTER_DRAIN) { E.fused(acc, cur, wr, wc, fr, fq, lds, wid, lane); S.done(cur); }
#undef PG8_SA
#undef PG8_SB
#undef PG8_STAGE
#undef PG8_LDA
#undef PG8_LDB
#undef PG8_MMA
#undef PG8_WAIT_V
#undef PG8_WAIT_L
#undef PG8_BAR
#undef PG8_SCHED
}
}

#ifndef MK_ONE_LAUNCH
#define MK_ONE_LAUNCH 1
#endif

namespace mk {
#define LAS __attribute__((address_space(3)))
typedef unsigned short bf16_t;
typedef short bf16x8 __attribute__((ext_vector_type(8)));
typedef float f32x4 __attribute__((ext_vector_type(4)));
typedef float f32x16 __attribute__((ext_vector_type(16)));
typedef unsigned u32x4 __attribute__((ext_vector_type(4)));
typedef unsigned u32x2 __attribute__((ext_vector_type(2)));
using pg8::Unit;
using pg8::cvt_pk_bf16;

constexpr int NWAVES = 8, NTHR = 512;
constexpr int M = 8192, DM = 2048, SEQ = 2048;
constexpr int NPROJ = 4096, PROJ_LD = 2048, DFF = 5632;
constexpr float EPS = 1e-6f;
constexpr float LOG2E = 1.4426950408889634f;
constexpr float LOG2_THETA = 18.931568569324174f;
constexpr float LAMBDA_INIT = 0.2f;

constexpr size_t MiB = 1u << 20;
constexpr size_t WS_CTL = 0;
constexpr size_t WS_WIN = 1 * MiB, WS_WQ = 18 * MiB, WS_WKV = 18 * MiB + 1536 * 1024, WS_WO = 22 * MiB, WS_WGU = 30 * MiB, WS_WD = 74 * MiB;
constexpr size_t WS_VTM = 1 * MiB;
constexpr size_t WS_VTD = 74 * MiB;
constexpr size_t WS_HB = 96 * MiB, WS_PROJ = 128 * MiB, WS_QLAT = 160 * MiB, WS_KVLAT = 168 * MiB, WS_SSQL = 176 * MiB, WS_KPE = 177 * MiB;
constexpr size_t WS_QF = 178 * MiB, WS_KNOPE = 202 * MiB, WS_QD = 218 * MiB, WS_KD = 234 * MiB;
constexpr size_t WS_QM = 96 * MiB, WS_KM = 120 * MiB, WS_AO = 144 * MiB, WS_X1B = 96 * MiB, WS_SSQ = 128 * MiB, WS_HMID = 130 * MiB;
constexpr size_t WS_END = 256 * MiB;
constexpr int LDS_BYTES = 163840;

__device__ unsigned g_ctl[8192];
struct Params { const float* in[22]; float* out; unsigned char* ws; int ph_lo, ph_hi; };

__device__ __forceinline__ float bf2f(unsigned short b) { return __uint_as_float((unsigned)b << 16); }
__device__ __forceinline__ float bflo(unsigned w) { return __uint_as_float(w << 16); }
__device__ __forceinline__ float bfhi(unsigned w) { return __uint_as_float(w & 0xffff0000u); }
__device__ __forceinline__ float wave_sum(float v) {
#pragma unroll
    for (int o = 1; o < 64; o <<= 1) v += __shfl_xor(v, o);
    return v;
}
__device__ __forceinline__ int perm16(int s) { return (s & 3) | ((s & 4) << 1) | ((s & 8) >> 1); }
__device__ __forceinline__ void sincos_ang(float ang, float& s, float& c) {
    double rev = (double)ang * 0.15915494309189535;
    rev -= __builtin_rint(rev);
    const float fr = (float)rev;
    s = __builtin_amdgcn_sinf(fr); c = __builtin_amdgcn_cosf(fr);
}
__device__ __forceinline__ float rope_freq(int i, int r) { return exp2f(-(float)(2 * i) / (float)r * LOG2_THETA); }

__device__ __forceinline__ u32x4 pack8(const f32x4& a, const f32x4& b) {
    u32x4 w; w.x = cvt_pk_bf16(a[0], a[1]); w.y = cvt_pk_bf16(a[2], a[3]); w.z = cvt_pk_bf16(b[0], b[1]); w.w = cvt_pk_bf16(b[2], b[3]); return w;
}
__device__ __forceinline__ bf16_t f2bf1(float v) { return (bf16_t)(cvt_pk_bf16(v, v) & 0xffffu); }

__device__ __forceinline__ void store_v(bf16_t* v, int bh, int d0, int r, const f32x4& a, const f32x4& b) {
    *(u32x4*)(v + ((size_t)bh * 2048 + (r & 2047)) * 128 + d0) = pack8(a, b);
}

struct EpiProj {
    static constexpr bool PERM = true, AFTER_DRAIN = false;
    bf16_t* qlat; bf16_t* kvlat; float* ssql; bf16_t* proj; bf16_t* vtd;
    __device__ __forceinline__ void operator()(const f32x4 (&acc)[2][2][4][2], const Unit& u, int wr, int wc, int fr, int fq) const {
        const int row0 = u.pm * 256 + wr * 64 + fr;
        if (u.pn < 4) {
            bf16_t* dst = (u.pn < 2) ? qlat : kvlat; const int t2 = u.pn & 1, lat = u.pn >> 1, col0 = t2 * 256 + wc * 32 + 8 * fq;
#pragma unroll
            for (int ai = 0; ai < 2; ++ai)
#pragma unroll
                for (int m = 0; m < 4; ++m) { const int r = row0 + ai * 128 + m * 16; bf16_t* rowp = dst + (size_t)r * 512 + col0; float sq = 0.f;
#pragma unroll
                    for (int bj = 0; bj < 2; ++bj) { const f32x4 v0 = acc[ai][bj][m][0], v1 = acc[ai][bj][m][1]; *(u32x4*)(rowp + bj * 128) = pack8(v0, v1);
                        sq += (v0[0] * v0[0] + v0[1] * v0[1]) + (v0[2] * v0[2] + v0[3] * v0[3]) + (v1[0] * v1[0] + v1[1] * v1[1]) + (v1[2] * v1[2] + v1[3] * v1[3]); }
                    sq += __shfl_xor(sq, 16); sq += __shfl_xor(sq, 32);
                    if (fq == 0) ssql[(size_t)r * 16 + lat * 8 + t2 * 4 + wc] = sq; }
        } else if (u.pn < 12) {
            const int col0 = (u.pn - 4) * 256 + wc * 32 + 8 * fq;
#pragma unroll
            for (int ai = 0; ai < 2; ++ai)
#pragma unroll
                for (int m = 0; m < 4; ++m) { bf16_t* rowp = proj + (size_t)(row0 + ai * 128 + m * 16) * PROJ_LD + col0;
#pragma unroll
                    for (int bj = 0; bj < 2; ++bj) *(u32x4*)(rowp + bj * 128) = pack8(acc[ai][bj][m][0], acc[ai][bj][m][1]); }
        } else {
#pragma unroll
            for (int ai = 0; ai < 2; ++ai)
#pragma unroll
                for (int m = 0; m < 4; ++m) { const int r = row0 + ai * 128 + m * 16; const int b = r >> 11;
#pragma unroll
                    for (int bj = 0; bj < 2; ++bj) store_v(vtd, b * 8 + 2 * (u.pn - 12) + bj, wc * 32 + 8 * fq, r, acc[ai][bj][m][0], acc[ai][bj][m][1]); }
        }
    }
};
__device__ __forceinline__ float latent_rs(const float* ssql_row8) {
    const f32x4 a = *(const f32x4*)ssql_row8, b = *(const f32x4*)(ssql_row8 + 4);
    return 1.0f / sqrtf((((a[0] + a[1]) + (a[2] + a[3])) + ((b[0] + b[1]) + (b[2] + b[3]))) * (1.0f / 512.0f) + EPS);
}
struct EpiPlain {
    static constexpr bool PERM = true, AFTER_DRAIN = false;
    bf16_t* O; int ldc;
    __device__ __forceinline__ void operator()(const f32x4 (&acc)[2][2][4][2], const Unit& u, int wr, int wc, int fr, int fq) const {
        const int row0 = u.pm * 256 + wr * 64 + fr, col0 = u.pn * 256 + wc * 32 + 8 * fq;
#pragma unroll
        for (int ai = 0; ai < 2; ++ai)
#pragma unroll
            for (int m = 0; m < 4; ++m) { bf16_t* rowp = O + (size_t)(row0 + ai * 128 + m * 16) * ldc + col0;
#pragma unroll
                for (int bj = 0; bj < 2; ++bj) *(u32x4*)(rowp + bj * 128) = pack8(acc[ai][bj][m][0], acc[ai][bj][m][1]); }
    }
};
struct EpiKv {
    static constexpr bool PERM = true, AFTER_DRAIN = false;
    bf16_t* knope; bf16_t* vtm; const float* ssql;
    __device__ __forceinline__ void operator()(const f32x4 (&acc)[2][2][4][2], const Unit& u, int wr, int wc, int fr, int fq) const {
        const int row0 = u.pm * 256 + wr * 64 + fr;
        f32x4 sv[8][2];
#pragma unroll
        for (int k = 0; k < 8; ++k) { const f32x4* sp = (const f32x4*)(ssql + (size_t)(row0 + (k >> 2) * 128 + (k & 3) * 16) * 16 + 8); sv[k][0] = sp[0]; sv[k][1] = sp[1]; }
#pragma unroll
        for (int ai = 0; ai < 2; ++ai)
#pragma unroll
            for (int m = 0; m < 4; ++m) { const int r = row0 + ai * 128 + m * 16; const f32x4 a = sv[ai * 4 + m][0], b = sv[ai * 4 + m][1];
                const float rs = 1.0f / sqrtf((((a[0] + a[1]) + (a[2] + a[3])) + ((b[0] + b[1]) + (b[2] + b[3]))) * (1.0f / 512.0f) + EPS);
                *(u32x4*)(knope + (size_t)r * 1024 + u.pn * 128 + wc * 32 + 8 * fq) = pack8(acc[ai][0][m][0], acc[ai][0][m][1]);
                store_v(vtm, (r >> 11) * 8 + u.pn, wc * 32 + 8 * fq, r, acc[ai][1][m][0] * rs, acc[ai][1][m][1] * rs); }
    }
};
struct EpiWo {
    static constexpr bool PERM = false, AFTER_DRAIN = false;
    const float* x; float* out; bf16_t* x1b; float* ssq;
    __device__ __forceinline__ void operator()(const f32x4 (&acc)[2][2][4][2], const Unit& u, int wr, int wc, int fr, int fq) const {
        const int row0 = u.pm * 256 + wr * 64 + fr, col0 = u.pn * 256 + wc * 32 + 4 * fq;
#pragma unroll
        for (int ai = 0; ai < 2; ++ai) {
            f32x4 xv[4][2][2];
#pragma unroll
            for (int m = 0; m < 4; ++m)
#pragma unroll
                for (int bj = 0; bj < 2; ++bj)
#pragma unroll
                    for (int n = 0; n < 2; ++n) xv[m][bj][n] = *(const f32x4*)(x + (size_t)(row0 + ai * 128 + m * 16) * DM + col0 + bj * 128 + n * 16);
#pragma unroll
            for (int m = 0; m < 4; ++m) { const int r = row0 + ai * 128 + m * 16; const size_t off = (size_t)r * DM + col0; float s = 0.f;
#pragma unroll
                for (int bj = 0; bj < 2; ++bj)
#pragma unroll
                    for (int n = 0; n < 2; ++n) { const size_t o2 = off + bj * 128 + n * 16; const f32x4 v = xv[m][bj][n] + acc[ai][bj][m][n];
                        s += (v[0] * v[0] + v[1] * v[1]) + (v[2] * v[2] + v[3] * v[3]);
                        u32x2 w; w.x = cvt_pk_bf16(v[0], v[1]); w.y = cvt_pk_bf16(v[2], v[3]); *(u32x2*)(x1b + o2) = w; }
                s += __shfl_xor(s, 16); s += __shfl_xor(s, 32);
                if (fq == 0) ssq[(size_t)r * 32 + u.pn * 4 + wc] = s; }
        }
    }
};
struct EpiGateUp {
    static constexpr bool PERM = true, AFTER_DRAIN = false;
    const float* ssq; bf16_t* hmid;
    __device__ __forceinline__ void operator()(const f32x4 (&acc)[2][2][4][2], const Unit& u, int wr, int wc, int fr, int fq) const {
        const int row0 = u.pm * 256 + wr * 64 + fr, col0 = u.pn * 128 + wc * 32 + 8 * fq;
        f32x4 sv[8][2];
#pragma unroll
        for (int k = 0; k < 8; ++k) { const f32x4* sp = (const f32x4*)(ssq + (size_t)(row0 + (k >> 2) * 128 + (k & 3) * 16) * 32) + 2 * fq; sv[k][0] = sp[0]; sv[k][1] = sp[1]; }
        float r2[8];
#pragma unroll
        for (int k = 0; k < 8; ++k) { float s = ((sv[k][0][0] + sv[k][0][1]) + (sv[k][0][2] + sv[k][0][3])) + ((sv[k][1][0] + sv[k][1][1]) + (sv[k][1][2] + sv[k][1][3]));
            s += __shfl_xor(s, 16); s += __shfl_xor(s, 32); r2[k] = 1.0f / sqrtf(s * (1.0f / DM) + EPS); }
#pragma unroll
        for (int ai = 0; ai < 2; ++ai)
#pragma unroll
            for (int m = 0; m < 4; ++m) { const int r = row0 + ai * 128 + m * 16; const float rr = r2[ai * 4 + m];
                f32x4 hv[2];
#pragma unroll
                for (int n = 0; n < 2; ++n)
#pragma unroll
                    for (int e = 0; e < 4; ++e) { const float g = acc[ai][0][m][n][e] * rr, up = acc[ai][1][m][n][e] * rr;
                        const float sg = g * __builtin_amdgcn_rcpf(1.0f + __builtin_amdgcn_exp2f(-g * LOG2E)); hv[n][e] = sg * up; }
                *(u32x4*)(hmid + (size_t)r * DFF + col0) = pack8(hv[0], hv[1]); }
    }
};
struct EpiDown {
    static constexpr bool PERM = false, AFTER_DRAIN = false;
    const bf16_t* x1b; float* out;
    __device__ __forceinline__ void operator()(const f32x4 (&acc)[2][2][4][2], const Unit& u, int wr, int wc, int fr, int fq) const {
        const int row0 = u.pm * 256 + wr * 64 + fr, col0 = u.pn * 256 + wc * 32 + 4 * fq;
#pragma unroll
        for (int ai = 0; ai < 2; ++ai) {
            u32x2 xv[4][2][2];
#pragma unroll
            for (int m = 0; m < 4; ++m)
#pragma unroll
                for (int bj = 0; bj < 2; ++bj)
#pragma unroll
                    for (int n = 0; n < 2; ++n) xv[m][bj][n] = *(const u32x2*)(x1b + (size_t)(row0 + ai * 128 + m * 16) * DM + col0 + bj * 128 + n * 16);
#pragma unroll
            for (int m = 0; m < 4; ++m)
#pragma unroll
                for (int bj = 0; bj < 2; ++bj)
#pragma unroll
                    for (int n = 0; n < 2; ++n) { const u32x2 w = xv[m][bj][n]; const f32x4 r = {bflo(w.x), bfhi(w.x), bflo(w.y), bfhi(w.y)};
                        *(f32x4*)(out + (size_t)(row0 + ai * 128 + m * 16) * DM + col0 + bj * 128 + n * 16) = r + acc[ai][bj][m][n]; }
        }
    }
};

struct StackedOrder {
    int G, c;
    __device__ __forceinline__ bool next(int i, Unit& u) const {
        const long L = (long)i * G + c; if (L >= 448) return false;
        pg8::StaticOrder t; t.G = 1; t.c = 0;
        if (L < 256) { t.nM = 32; t.nN = 8; t.nwg = 256; t.next((int)L, u); u.pm += 32; u.pn += 6; }
        else { t.nM = 32; t.nN = 6; t.nwg = 192; t.next((int)L - 256, u); }
        return true;
    }
    __device__ __forceinline__ void a_ready(const Unit&) const {}
    __device__ __forceinline__ void done(const Unit&) const {}
};
struct EpiQKv {
    static constexpr bool PERM = true, AFTER_DRAIN = false;
    EpiPlain q; EpiKv kv;
    __device__ __forceinline__ void operator()(const f32x4 (&acc)[2][2][4][2], const Unit& u, int wr, int wc, int fr, int fq) const {
        if (u.pn < 6) q(acc, u, wr, wc, fr, fq);
        else { Unit v; v.pm = u.pm - 32; v.pn = u.pn - 6; kv(acc, v, wr, wc, fr, fq); }
    }
};

struct TItem { const float* src; const float* gain; bf16_t* dst; int ldw, K; bool zero; };
__device__ __forceinline__ TItem p0_item(const Params& p, unsigned char* ws, int it) {
    constexpr int I_IN = 32 * 65, I_Q = 8 * 24, I_KV = 8 * 32, I_O = 32 * 32, I_GU = 32 * 176;
    TItem t; t.gain = nullptr; t.zero = false; int r = it;
    if (r < I_IN) { const int kb = r / 65, nb = r % 65; const int nd = nb * 64; const int ns = nd < 1024 ? nd : (nd < 4096 ? nd + 64 : 1024);
        t.src = p.in[2] + (size_t)(kb * 64) * 4160 + ns; t.ldw = 4160; t.dst = (bf16_t*)(ws + WS_WIN) + (size_t)nd * 2048 + kb * 64; t.K = 2048; return t; } r -= I_IN;
    if (r < I_Q) { const int kb = r / 24, nb = r % 24; t.src = p.in[4] + (size_t)(kb * 64) * 1536 + nb * 64; t.ldw = 1536; t.gain = p.in[3] + kb * 64; t.dst = (bf16_t*)(ws + WS_WQ) + (size_t)(nb * 64) * 512 + kb * 64; t.K = 512; return t; } r -= I_Q;
    if (r < I_KV) { const int kb = r / 32, nb = r % 32; t.src = p.in[6] + (size_t)(kb * 64) * 2048 + nb * 64; t.ldw = 2048; t.gain = p.in[5] + kb * 64; t.dst = (bf16_t*)(ws + WS_WKV) + (size_t)(nb * 64) * 512 + kb * 64; t.K = 512; return t; } r -= I_KV;
    if (r < I_O) { const int kb = r / 32, nb = r % 32; t.src = p.in[17] + (size_t)(kb * 64) * 2048 + nb * 64; t.ldw = 2048; t.dst = (bf16_t*)(ws + WS_WO) + (size_t)(nb * 64) * 2048 + kb * 64; t.K = 2048; return t; } r -= I_O;
    if (r < I_GU) { const int kb = r / 176, nb = r % 176; const int nd = nb * 64; const int tt = nd >> 8, bj = (nd >> 7) & 1, j = nd & 127;
        t.src = (bj ? p.in[20] : p.in[19]) + (size_t)(kb * 64) * DFF + tt * 128 + j; t.ldw = DFF; t.gain = p.in[18] + kb * 64;
        t.dst = (bf16_t*)(ws + WS_WGU) + (size_t)nd * 2048 + kb * 64; t.K = 2048; return t; } r -= I_GU;
    { const int kb = r / 32, nb = r % 32; t.src = p.in[21] + (size_t)(kb * 64) * 2048 + nb * 64; t.ldw = 2048; t.dst = (bf16_t*)(ws + WS_WD) + (size_t)(nb * 64) * DFF + kb * 64; t.K = DFF; return t; }
}
constexpr int P0_NITEMS = 32 * 65 + 8 * 24 + 8 * 32 + 32 * 32 + 32 * 176 + 88 * 32, P0_ITEMS_WD = 88 * 32, P0_ITEMS_EARLY = 32 * 65 + 8 * 24 + 8 * 32, P0_ITEMS_MID = 32 * 32 + 32 * 176;
static_assert(P0_ITEMS_MID == 416 * 16 && P0_ITEMS_EARLY + P0_ITEMS_MID + P0_ITEMS_WD == P0_NITEMS, "conversion item split");
__device__ __forceinline__ void p0_convert(const Params& p, LAS unsigned char* lds, int it0, int NITEMS, int gw, int NGW, int wave, int lane) {
    unsigned char* ws = p.ws;
    LAS float* scr = (LAS float*)(lds + wave * 16640);
    const int ksub = lane >> 4, n4 = (lane & 15) * 4;
    f32x4 v[16];
#define P0_LOAD(T) do { const float* sp_ = (T).src + (size_t)ksub * (T).ldw + n4; \
        _Pragma("unroll") for (int i = 0; i < 16; ++i) v[i] = *(const f32x4*)(sp_ + (size_t)(4 * i) * (T).ldw); } while (0)
    int it = it0 + gw; TItem cur;
    if (it < NITEMS) { cur = p0_item(p, ws, it); P0_LOAD(cur); }
    while (it < NITEMS) {
        if (cur.gain) {
#pragma unroll
            for (int i = 0; i < 16; ++i) v[i] = v[i] * cur.gain[4 * i + ksub];
        }
#pragma unroll
        for (int i = 0; i < 16; ++i) { LAS float* d = scr + (4 * i + ksub) * 65 + n4; d[0] = v[i][0]; d[1] = v[i][1]; d[2] = v[i][2]; d[3] = v[i][3]; }
        const int itn = it + NGW; TItem nxt = cur;
        if (itn < NITEMS) { nxt = p0_item(p, ws, itn); P0_LOAD(nxt); }
        asm volatile("s_waitcnt lgkmcnt(0)" ::: "memory");
        const int c = lane & 7;
#pragma unroll
        for (int j = 0; j < 8; ++j) { const int n = (lane >> 3) + 8 * j; const LAS float* s = scr + (8 * c) * 65 + n;
            u32x4 o; o.x = cvt_pk_bf16(s[0 * 65], s[1 * 65]); o.y = cvt_pk_bf16(s[2 * 65], s[3 * 65]); o.z = cvt_pk_bf16(s[4 * 65], s[5 * 65]); o.w = cvt_pk_bf16(s[6 * 65], s[7 * 65]);
            *(u32x4*)(cur.dst + (size_t)n * cur.K + 8 * c) = o; }
        asm volatile("s_waitcnt lgkmcnt(0)" ::: "memory");
        it = itn; cur = nxt;
    }
#undef P0_LOAD
}
__device__ __forceinline__ void phase0(const Params& p, LAS unsigned char* lds, int gw, int NGW, int wave, int lane) {
    unsigned char* ws = p.ws;
    p0_convert(p, lds, 0, P0_ITEMS_EARLY, gw, NGW, wave, lane);
    const float* x = p.in[0]; const float* g = p.in[1]; bf16_t* hb = (bf16_t*)(ws + WS_HB);
    f32x4 v[8], vn[8];
    if (gw < M) {
#pragma unroll
        for (int j = 0; j < 8; ++j) vn[j] = ((const f32x4*)(x + (size_t)gw * DM) + lane)[64 * j];
    }
    for (int m = gw; m < M; m += NGW) {
        float s = 0.f;
#pragma unroll
        for (int j = 0; j < 8; ++j) { v[j] = vn[j]; s += (v[j][0] * v[j][0] + v[j][1] * v[j][1]) + (v[j][2] * v[j][2] + v[j][3] * v[j][3]); }
        if (m + NGW < M) {
#pragma unroll
            for (int j = 0; j < 8; ++j) vn[j] = ((const f32x4*)(x + (size_t)(m + NGW) * DM) + lane)[64 * j];
        }
        const float rs = 1.0f / sqrtf(wave_sum(s) * (1.0f / DM) + EPS);
        u32x2* o = (u32x2*)(hb + (size_t)m * DM) + lane;
#pragma unroll
        for (int j = 0; j < 8; ++j) { const f32x4 gv = ((const f32x4*)g)[lane + 64 * j]; u32x2 w;
            w.x = cvt_pk_bf16(v[j][0] * rs * gv[0], v[j][1] * rs * gv[1]); w.y = cvt_pk_bf16(v[j][2] * rs * gv[2], v[j][3] * rs * gv[3]); o[64 * j] = w; }
    }
}

__device__ __forceinline__ void unpack8(const u32x4& w, float (&f)[8]) {
    f[0] = bflo(w.x); f[1] = bfhi(w.x); f[2] = bflo(w.y); f[3] = bfhi(w.y); f[4] = bflo(w.z); f[5] = bfhi(w.z); f[6] = bflo(w.w); f[7] = bfhi(w.w);
}
__device__ __forceinline__ u32x4 pack8f(const float (&f)[8]) {
    u32x4 w; w.x = cvt_pk_bf16(f[0], f[1]); w.y = cvt_pk_bf16(f[2], f[3]); w.z = cvt_pk_bf16(f[4], f[5]); w.w = cvt_pk_bf16(f[6], f[7]); return w;
}
__device__ __forceinline__ void latent_norm(const bf16_t* src, const float* g, bf16_t* dst, int lane) {
    float f[8]; unpack8(*(const u32x4*)(src + lane * 8), f); float s = 0.f;
#pragma unroll
    for (int j = 0; j < 8; ++j) s += f[j] * f[j];
    const float rs = 1.0f / sqrtf(wave_sum(s) * (1.0f / 512.0f) + EPS);
#pragma unroll
    for (int j = 0; j < 8; ++j) f[j] = f[j] * rs * g[lane * 8 + j];
    *(u32x4*)(dst + lane * 8) = pack8f(f);
}
__device__ __forceinline__ void diff_row(const u32x4& raw0, const u32x4& raw1, const float (&g)[16], const float (&sn)[8], const float (&cs)[8], bf16_t* o, int sub) {
    float f[16]; { float t[8]; unpack8(raw0, t);
#pragma unroll
        for (int j = 0; j < 8; ++j) f[j] = t[j];
        unpack8(raw1, t);
#pragma unroll
        for (int j = 0; j < 8; ++j) f[8 + j] = t[j]; }
    float ss = 0.f;
#pragma unroll
    for (int j = 0; j < 16; ++j) ss += f[j] * f[j];
    ss += __shfl_xor(ss, 1); ss += __shfl_xor(ss, 2);
    const float rs = 1.0f / sqrtf(ss * (1.0f / 64.0f) + EPS);
#pragma unroll
    for (int j = 0; j < 16; ++j) f[j] = f[j] * rs * g[j];
    if (sub == 0) {
#pragma unroll
        for (int i = 0; i < 8; ++i) { const float a = f[i], bb = f[8 + i]; f[i] = a * cs[i] - bb * sn[i]; f[8 + i] = bb * cs[i] + a * sn[i]; }
    }
    { float t[8];
#pragma unroll
      for (int j = 0; j < 8; ++j) t[j] = f[j];
      *(u32x4*)o = pack8f(t);
#pragma unroll
      for (int j = 0; j < 8; ++j) t[j] = f[8 + j];
      *(u32x4*)(o + 8) = pack8f(t); }
}
__device__ __forceinline__ void kpe_gemm(unsigned char* ws, LAS unsigned char* lds, int blk0, int bstep, int bend, int tid, int wave, int lane) {
    const bf16_t* hb = (const bf16_t*)(ws + WS_HB); const bf16_t* wk = (const bf16_t*)(ws + WS_WIN) + (size_t)4096 * 2048; bf16_t* kpe = (bf16_t*)(ws + WS_KPE);
    const int r32 = lane & 31, h = lane >> 5;
    LAS float* red = (LAS float*)lds;
    for (int blk = blk0; blk < bend; blk += bstep) {
        const int m0 = blk * 32;
        const bf16_t* ap = hb + (size_t)(m0 + r32) * 2048 + wave * 256 + 8 * h;
        const bf16_t* bp = wk + (size_t)r32 * 2048 + wave * 256 + 8 * h;
        f32x16 c0, c1;
#pragma unroll
        for (int i = 0; i < 16; ++i) { c0[i] = 0.f; c1[i] = 0.f; }
#pragma unroll
        for (int ks = 0; ks < 16; ++ks) {
            const bf16x8 a = *(const bf16x8*)(ap + 16 * ks), b0 = *(const bf16x8*)(bp + 16 * ks), b1 = *(const bf16x8*)(bp + (size_t)32 * 2048 + 16 * ks);
            c0 = __builtin_amdgcn_mfma_f32_32x32x16_bf16(a, b0, c0, 0, 0, 0); c1 = __builtin_amdgcn_mfma_f32_32x32x16_bf16(a, b1, c1, 0, 0, 0);
        }
        __syncthreads();
#pragma unroll
        for (int i = 0; i < 16; ++i) { const int tok = (i & 3) + 8 * (i >> 2) + 4 * h; red[(wave * 32 + tok) * 64 + r32] = c0[i]; red[(wave * 32 + tok) * 64 + 32 + r32] = c1[i]; }
        __syncthreads();
        { const int tok = tid >> 4, n4 = (tid & 15) * 4; f32x4 sacc = {0.f, 0.f, 0.f, 0.f};
#pragma unroll
          for (int w8 = 0; w8 < 8; ++w8) sacc = sacc + *(const LAS f32x4*)(red + (w8 * 32 + tok) * 64 + n4);
          u32x2 w; w.x = cvt_pk_bf16(sacc[0], sacc[1]); w.y = cvt_pk_bf16(sacc[2], sacc[3]); *(u32x2*)(kpe + (size_t)(m0 + tok) * 64 + n4) = w; }
    }
}
__device__ __forceinline__ void p3_pre(const Params& p, LAS unsigned char* lds, int bx, int G, int tid, int wave, int lane) {
    unsigned char* ws = p.ws;
    const bf16_t* proj = (const bf16_t*)(ws + WS_PROJ); bf16_t* qd = (bf16_t*)(ws + WS_QD); bf16_t* kd = (bf16_t*)(ws + WS_KD);
    constexpr int NQU = (M / 256) * (1536 / 256);
    int row0, rstep, rend, blk0, bstep, bend;
    if (G == 256) {
        if (bx >= NQU) { row0 = (bx - NQU) * NWAVES + wave; rstep = (256 - NQU) * NWAVES; rend = 4096; blk0 = bx - NQU; bstep = 256 - NQU; bend = 128; }
        else { row0 = 4096 + bx * NWAVES + wave; rstep = NQU * NWAVES; rend = M; blk0 = 128 + bx; bstep = 256; bend = 256; }
    } else { row0 = bx * NWAVES + wave; rstep = G * NWAVES; rend = M; blk0 = bx; bstep = G; bend = 256; }
    kpe_gemm(ws, lds, blk0, bstep, bend, tid, wave, lane);
    const int sub = lane & 3, hc = lane >> 2;
    float gq[16], gk[16], frq[8];
#pragma unroll
    for (int j = 0; j < 16; ++j) { gq[j] = p.in[10][sub * 16 + j] * (0.125f * LOG2E); gk[j] = p.in[11][sub * 16 + j]; }
#pragma unroll
    for (int i = 0; i < 8; ++i) frq[i] = rope_freq(i, 16);
    for (int m = row0; m < rend; m += rstep) {
        const bf16_t* pr = proj + (size_t)m * PROJ_LD + lane * 16; const int b = m >> 11, sp = m & 2047;
        const u32x4 q0 = *(const u32x4*)(pr), q1 = *(const u32x4*)(pr + 8), k0 = *(const u32x4*)(pr + 1024), k1 = *(const u32x4*)(pr + 1032);
        float sn[8], cs[8];
#pragma unroll
        for (int i = 0; i < 8; ++i) sincos_ang((float)sp * frq[i], sn[i], cs[i]);
        const size_t off = ((size_t)((b * 16 + hc) * SEQ + sp)) * 64 + sub * 16;
        diff_row(q0, q1, gq, sn, cs, qd + off, sub);
        diff_row(k0, k1, gk, sn, cs, kd + off, sub);
    }
}

__device__ __forceinline__ void mla_row(const u32x4& n0, const u32x4& n1, const u32x4& r0, float rn, float rr, const float (&gn)[16], const float (&gr)[8], const float (&sns)[8], const float (&cs)[8], bf16_t* o, int sub) {
    float fn[16], fr[8];
    { float t[8]; unpack8(n0, t);
#pragma unroll
      for (int j = 0; j < 8; ++j) fn[j] = t[j] * rn;
      unpack8(n1, t);
#pragma unroll
      for (int j = 0; j < 8; ++j) fn[8 + j] = t[j] * rn;
      unpack8(r0, t);
#pragma unroll
      for (int j = 0; j < 8; ++j) fr[j] = t[j] * rr; }
    float ss = 0.f;
#pragma unroll
    for (int j = 0; j < 16; ++j) ss += fn[j] * fn[j];
#pragma unroll
    for (int j = 0; j < 8; ++j) ss += fr[j] * fr[j];
    ss += __shfl_xor(ss, 1); ss += __shfl_xor(ss, 2); ss += __shfl_xor(ss, 4);
    const float rs = 1.0f / sqrtf(ss * (1.0f / 192.0f) + EPS);
#pragma unroll
    for (int j = 0; j < 16; ++j) fn[j] = fn[j] * rs * gn[j];
    float ro[8];
#pragma unroll
    for (int j = 0; j < 8; ++j) { const float v = fr[j] * rs * gr[j]; const float pv = __shfl_xor(v, 4); ro[j] = v * cs[j] + pv * sns[j]; }
    { float t[8];
#pragma unroll
      for (int j = 0; j < 8; ++j) t[j] = fn[j];
      *(u32x4*)(o + sub * 16) = pack8f(t);
#pragma unroll
      for (int j = 0; j < 8; ++j) t[j] = fn[8 + j];
      *(u32x4*)(o + sub * 16 + 8) = pack8f(t); }
    *(u32x4*)(o + 128 + sub * 8) = pack8f(ro);
}
__device__ __forceinline__ void phase4(const Params& p, int gw, int NGW, int lane) {
    unsigned char* ws = p.ws;
    const bf16_t* qf = (const bf16_t*)(ws + WS_QF); const bf16_t* knope = (const bf16_t*)(ws + WS_KNOPE); const bf16_t* kpe = (const bf16_t*)(ws + WS_KPE);
    bf16_t* qm = (bf16_t*)(ws + WS_QM); bf16_t* km = (bf16_t*)(ws + WS_KM);
    const int h = lane >> 3, sub = lane & 7;
    const float qscale = LOG2E / sqrtf(192.0f), sgn = sub < 4 ? -1.0f : 1.0f;
    float gqn[16], gkn[16], gqr[8], gkr[8], frq[8];
#pragma unroll
    for (int j = 0; j < 16; ++j) { gqn[j] = p.in[7][sub * 16 + j] * qscale; gkn[j] = p.in[8][sub * 16 + j]; }
#pragma unroll
    for (int j = 0; j < 8; ++j) { gqr[j] = p.in[7][128 + sub * 8 + j] * qscale; gkr[j] = p.in[8][128 + sub * 8 + j]; frq[j] = rope_freq((sub * 8 + j) & 31, 64); }
    for (int m = gw; m < M; m += NGW) {
        const int b = m >> 11, sp = m & 2047;
        const bf16_t* q0 = qf + (size_t)m * 1536 + h * 192; const bf16_t* k0 = knope + (size_t)m * 1024 + h * 128 + sub * 16;
        const u32x4 qa = *(const u32x4*)(q0 + sub * 16), qb = *(const u32x4*)(q0 + sub * 16 + 8), qc = *(const u32x4*)(q0 + 128 + sub * 8);
        const u32x4 ka = *(const u32x4*)(k0), kb = *(const u32x4*)(k0 + 8), kc = *(const u32x4*)(kpe + (size_t)m * 64 + sub * 8);
        const float* sq = (const float*)(ws + WS_SSQL) + (size_t)m * 16; const float rq = latent_rs(sq), rkv = latent_rs(sq + 8);
        float sns[8], cs[8];
#pragma unroll
        for (int j = 0; j < 8; ++j) { float sv; sincos_ang((float)sp * frq[j], sv, cs[j]); sns[j] = sv * sgn; }
        const size_t off = ((size_t)((b * 8 + h) * SEQ + sp)) * 192;
        mla_row(qa, qb, qc, rq, rq, gqn, gqr, sns, cs, qm + off, sub);
        mla_row(ka, kb, kc, rkv, 1.0f, gkn, gkr, sns, cs, km + off, sub);
    }
}

#define MFMA32(a, b, c) __builtin_amdgcn_mfma_f32_32x32x16_bf16((a), (b), (c), 0, 0, 0)
typedef short s16x4 __attribute__((ext_vector_type(4)));
__device__ __forceinline__ float max3f(float a, float b, float c) { float r; asm("v_max3_f32 %0, %1, %2, %3" : "=v"(r) : "v"(a), "v"(b), "v"(c)); return r; }
__device__ __forceinline__ s16x4 vtr(const LAS unsigned char* p) { return __builtin_bit_cast(s16x4, __builtin_amdgcn_ds_read_tr16_b64_v4i16((LAS s16x4*)p)); }
template <int DQK>
__device__ __forceinline__ void attn_pass(f32x16 (&o)[4], const bf16_t* Qh, const bf16_t* Kh, const bf16_t* Vth, int q0, LAS unsigned char* lds, int tid, int w, int lane) {
    constexpr int KSTR = DQK * 2 + 16, VSTR = 320, NKC = (64 * DQK * 2 / 16) / NTHR, CPR = DQK / 8, KB = 64 * KSTR, VB = 64 * VSTR;
    static_assert(NKC * NTHR * 16 == 64 * DQK * 2, "K tile chunks");
    constexpr bool PIPE = false; constexpr int KA = PIPE ? 1 : 0;
    constexpr int QKB = (DQK == 64) ? 4 : 2, PVB = (DQK == 64) ? 2 : 1;
    constexpr float THR = 8.0f;
    LAS unsigned char* Ks = lds; LAS unsigned char* Vs = lds + 2 * KB;
    const int r32 = lane & 31, h = lane >> 5;
    bf16x8 qf[DQK / 16];
    { const bf16_t* qrow = Qh + (size_t)(q0 + 32 * w + r32) * DQK + 8 * h;
#pragma unroll
      for (int d0 = 0; d0 < DQK / 16; ++d0) qf[d0] = *(const bf16x8*)(qrow + 16 * d0); }
    float m_run = -INFINITY, l_lane = 0.f;
#pragma unroll
    for (int db = 0; db < 4; ++db)
#pragma unroll
        for (int i = 0; i < 16; ++i) o[db][i] = 0.f;
    const int NT = (q0 + 256) >> 6, tmax = (q0 >> 6) + (w >> 1);
    const int qg = q0 + 32 * w + r32;
    u32x4 kreg[NKC], vreg[2];
#define ATT_LDK(R, t) do { _Pragma("unroll") for (int j = 0; j < NKC; ++j) R[j] = ((const u32x4*)(Kh + (size_t)(t) * 64 * DQK))[tid + NTHR * j]; } while (0)
#define ATT_LDV(t) do { _Pragma("unroll") for (int j = 0; j < 2; ++j) vreg[j] = ((const u32x4*)(Vth + (size_t)(t) * 64 * 128))[tid + NTHR * j]; } while (0)
#define ATT_STK(R, buf) do { _Pragma("unroll") for (int j = 0; j < NKC; ++j) { const int c = tid + NTHR * j; *(LAS u32x4*)(Ks + (buf) * KB + (c / CPR) * KSTR + (c % CPR) * 16) = R[j]; } } while (0)
#define ATT_STV(buf) do { _Pragma("unroll") for (int j = 0; j < 2; ++j) { const int c = tid + NTHR * j; *(LAS u32x4*)(Vs + (buf) * VB + (c >> 4) * VSTR + (c & 15) * 16) = vreg[j]; } } while (0)
#define ATT_QK(P0, P1, buf) do { \
        _Pragma("unroll") for (int i = 0; i < 16; ++i) { P0[i] = 0.f; P1[i] = 0.f; } \
        const LAS unsigned char* ka = Ks + (buf) * KB + r32 * KSTR + h * 16; \
        _Pragma("unroll") for (int g0 = 0; g0 < DQK / 16; g0 += QKB) {         \
            bf16x8 fa[QKB], fb[QKB]; \
            _Pragma("unroll") for (int d = 0; d < QKB; ++d) { fa[d] = *(const LAS bf16x8*)(ka + (g0 + d) * 32); fb[d] = *(const LAS bf16x8*)(ka + 32 * KSTR + (g0 + d) * 32); } \
            _Pragma("unroll") for (int d = 0; d < QKB; ++d) { P0 = MFMA32(fa[d], qf[g0 + d], P0); P1 = MFMA32(fb[d], qf[g0 + d], P1); } \
            __builtin_amdgcn_sched_group_barrier(0x100, 2 * QKB, 0); __builtin_amdgcn_sched_group_barrier(0x008, 2 * QKB, 0); } \
        asm volatile("s_nop 15\n\ts_nop 7" : "+v"(P0), "+v"(P1)); } while (0)
#define ATT_SMPV(P0, P1, t, buf) do { \
        if ((t) == tmax) { const int kb = 64 * (t) + 4 * h; \
            _Pragma("unroll") for (int i = 0; i < 16; ++i) { const int kv = kb + (i & 3) + 8 * (i >> 2); if (kv > qg) P0[i] = -INFINITY; if (kv + 32 > qg) P1[i] = -INFINITY; } } \
        float mxa = max3f(P0[0], P0[1], P1[0]), mxb = max3f(P0[2], P0[3], P1[1]); mxa = max3f(mxa, P1[2], P1[3]); \
        _Pragma("unroll") for (int i = 4; i < 16; i += 4) { mxa = max3f(mxa, P0[i], P0[i + 1]); mxb = max3f(mxb, P0[i + 2], P0[i + 3]); mxa = max3f(mxa, P1[i], P1[i + 1]); mxb = max3f(mxb, P1[i + 2], P1[i + 3]); } \
        float mx = max3f(mxa, mxb, mxb); \
        mx = max3f(mx, __shfl_xor(mx, 32), mx); \
        const bool need = mx > m_run + THR; \
        if (__builtin_amdgcn_ballot_w64(need) != 0ull) { \
            const float mnew = need ? mx : m_run, alpha = __builtin_amdgcn_exp2f(m_run - mnew); m_run = mnew; l_lane *= alpha; \
            _Pragma("unroll") for (int db = 0; db < 4; ++db) _Pragma("unroll") for (int i = 0; i < 16; ++i) o[db][i] *= alpha; } \
        float rs = 0.f; \
        _Pragma("unroll") for (int i = 0; i < 16; ++i) { P0[i] = __builtin_amdgcn_exp2f(P0[i] - m_run); P1[i] = __builtin_amdgcn_exp2f(P1[i] - m_run); rs += P0[i] + P1[i]; } \
        l_lane += rs; \
        bf16x8 pb[4]; \
        { u32x4 t0, t1, t2, t3; \
          t0.x = cvt_pk_bf16(P0[0], P0[1]); t0.y = cvt_pk_bf16(P0[2], P0[3]); t0.z = cvt_pk_bf16(P0[4], P0[5]); t0.w = cvt_pk_bf16(P0[6], P0[7]); \
          t1.x = cvt_pk_bf16(P0[8], P0[9]); t1.y = cvt_pk_bf16(P0[10], P0[11]); t1.z = cvt_pk_bf16(P0[12], P0[13]); t1.w = cvt_pk_bf16(P0[14], P0[15]); \
          t2.x = cvt_pk_bf16(P1[0], P1[1]); t2.y = cvt_pk_bf16(P1[2], P1[3]); t2.z = cvt_pk_bf16(P1[4], P1[5]); t2.w = cvt_pk_bf16(P1[6], P1[7]); \
          t3.x = cvt_pk_bf16(P1[8], P1[9]); t3.y = cvt_pk_bf16(P1[10], P1[11]); t3.z = cvt_pk_bf16(P1[12], P1[13]); t3.w = cvt_pk_bf16(P1[14], P1[15]); \
          pb[0] = __builtin_bit_cast(bf16x8, t0); pb[1] = __builtin_bit_cast(bf16x8, t1); pb[2] = __builtin_bit_cast(bf16x8, t2); pb[3] = __builtin_bit_cast(bf16x8, t3); } \
        const LAS unsigned char* va = Vs + (buf) * VB + (4 * h + ((lane & 15) >> 2)) * VSTR + ((lane >> 4) & 1) * 32 + (lane & 3) * 8; \
        _Pragma("unroll") for (int dp = 0; dp < 4; dp += PVB) { \
            s16x4 lo[PVB][4], hi[PVB][4]; \
            _Pragma("unroll") for (int d2 = 0; d2 < PVB; ++d2) _Pragma("unroll") for (int ks = 0; ks < 4; ++ks) { lo[d2][ks] = vtr(va + (dp + d2) * 64 + (ks * 16) * VSTR); hi[d2][ks] = vtr(va + (dp + d2) * 64 + (ks * 16 + 8) * VSTR); } \
            _Pragma("unroll") for (int ks = 0; ks < 4; ++ks) _Pragma("unroll") for (int d2 = 0; d2 < PVB; ++d2) { \
                const bf16x8 a = (bf16x8){lo[d2][ks][0], lo[d2][ks][1], lo[d2][ks][2], lo[d2][ks][3], hi[d2][ks][0], hi[d2][ks][1], hi[d2][ks][2], hi[d2][ks][3]}; o[dp + d2] = MFMA32(a, pb[ks], o[dp + d2]); } \
            __builtin_amdgcn_sched_group_barrier(0x100, 8 * PVB, 0); __builtin_amdgcn_sched_group_barrier(0x008, 4 * PVB, 0); } } while (0)
#define ATT_ITER(C0, C1, N0, N1, tt, B, NB) do { \
        __syncthreads(); \
        if constexpr (PIPE) { if ((tt) + 2 < NT) ATT_STK(kreg, B); } else { if ((tt) + 1 < NT) ATT_STK(kreg, NB); } \
        if ((tt) + 1 < NT) ATT_STV(NB); \
        if ((tt) + 2 + KA < NT) ATT_LDK(kreg, (tt) + 2 + KA); \
        if ((tt) + 2 < NT) ATT_LDV((tt) + 2); \
        if constexpr (PIPE) { if ((tt) + 1 <= tmax) ATT_QK(N0, N1, NB); if ((tt) <= tmax) ATT_SMPV(C0, C1, tt, B); } \
        else { if ((tt) <= tmax) { ATT_QK(C0, C1, B); ATT_SMPV(C0, C1, tt, B); } } } while (0)
    f32x16 pA0, pA1, pB0, pB1;
    if constexpr (PIPE) {
        u32x4 kreg2[NKC];
        ATT_LDK(kreg, 0); ATT_LDV(0); ATT_LDK(kreg2, 1);
        __syncthreads();
        ATT_STK(kreg, 0); ATT_STV(0); ATT_STK(kreg2, 1);
        ATT_LDK(kreg, 2); ATT_LDV(1);
        __syncthreads();
        ATT_QK(pA0, pA1, 0);
        for (int t = 0; t < NT; t += 2) {
            ATT_ITER(pA0, pA1, pB0, pB1, t, 0, 1);
            ATT_ITER(pB0, pB1, pA0, pA1, t + 1, 1, 0);
        }
    } else {
        u32x4 kreg2[NKC], vreg2[2];
        ATT_LDK(kreg, 0); ATT_LDV(0);
        ATT_LDK(kreg2, 1);
#pragma unroll
        for (int j = 0; j < 2; ++j) vreg2[j] = ((const u32x4*)(Vth + (size_t)64 * 128))[tid + NTHR * j];
        __syncthreads();
        ATT_STK(kreg, 0); ATT_STV(0);
#pragma unroll
        for (int j = 0; j < NKC; ++j) kreg[j] = kreg2[j];
#pragma unroll
        for (int j = 0; j < 2; ++j) vreg[j] = vreg2[j];
        for (int t = 0; t < NT; t += 2) {
            ATT_ITER(pA0, pA1, pA0, pA1, t, 0, 1);
            ATT_ITER(pA0, pA1, pA0, pA1, t + 1, 1, 0);
        }
    }
#undef ATT_LDK
#undef ATT_LDV
#undef ATT_STK
#undef ATT_STV
#undef ATT_QK
#undef ATT_SMPV
#undef ATT_ITER
    float l = l_lane + __shfl_xor(l_lane, 32);
    const float inv = 1.0f / l;
#pragma unroll
    for (int db = 0; db < 4; ++db)
#pragma unroll
        for (int i = 0; i < 16; ++i) o[db][i] *= inv;
}
__device__ __forceinline__ void attn_out_store(const f32x16 (&o)[4], const float* gain, float scale, bf16_t* dst_row, int h) {
    float ss = 0.f;
#pragma unroll
    for (int db = 0; db < 4; ++db)
#pragma unroll
        for (int i = 0; i < 16; ++i) ss += o[db][i] * o[db][i];
    ss += __shfl_xor(ss, 32);
    const float rn = scale / sqrtf(ss * (1.0f / 128.0f) + EPS);
#pragma unroll
    for (int db = 0; db < 4; ++db)
#pragma unroll
        for (int g4 = 0; g4 < 4; ++g4) { const int d = 32 * db + 8 * g4 + 4 * h; const f32x4 gv = *(const f32x4*)(gain + d);
            u32x2 w; w.x = cvt_pk_bf16(o[db][4 * g4] * rn * gv[0], o[db][4 * g4 + 1] * rn * gv[1]); w.y = cvt_pk_bf16(o[db][4 * g4 + 2] * rn * gv[2], o[db][4 * g4 + 3] * rn * gv[3]);
            *(u32x2*)(dst_row + d) = w; }
}
__device__ __forceinline__ void phase5(const Params& p, LAS unsigned char* lds, unsigned* ctr, int tid, int wave, int lane) {
    unsigned char* ws = p.ws;
    const bf16_t* qm = (const bf16_t*)(ws + WS_QM); const bf16_t* km = (const bf16_t*)(ws + WS_KM); const bf16_t* vtm = (const bf16_t*)(ws + WS_VTM);
    const bf16_t* qd = (const bf16_t*)(ws + WS_QD); const bf16_t* kd = (const bf16_t*)(ws + WS_KD); const bf16_t* vtd = (const bf16_t*)(ws + WS_VTD);
    bf16_t* ao = (bf16_t*)(ws + WS_AO);
    LAS unsigned* shw = (LAS unsigned*)(lds + 163824);
    float lam;
    { const float a = p.in[12][lane] * p.in[13][lane], b2 = p.in[14][lane] * p.in[15][lane];
      lam = __expf(wave_sum(a)) - __expf(wave_sum(b2)) + LAMBDA_INIT; }
    const int r32 = lane & 31, h = lane >> 5;
    for (;;) {
        __syncthreads();
        if (tid == 0) shw[0] = atomicAdd(ctr, 1u);
        __syncthreads();
        const unsigned uq = shw[0];
        if (uq >= 928u) break;
        const unsigned grp = uq / 29u, ing = uq % 29u;
        if (ing >= 16u) {
            const int cj = (int)(grp * 13u + ing - 16u);
            p0_convert(p, lds, P0_ITEMS_EARLY + 16 * cj, P0_ITEMS_EARLY + 16 * cj + 16, wave, NWAVES, wave, lane);
            continue;
        }
        const unsigned u = grp * 16u + ing;
        const int cls = (int)(u >> 5), bh = (int)(u & 31u);
        const int isdiff = (0x552B >> cls) & 1, qb = (int)((0x0011223345465767ull >> (4 * cls)) & 15ull);
        const int q0 = qb * 256, b = bh >> 3, hd = bh & 7;
        if (!isdiff) {
            f32x16 o[4];
            attn_pass<192>(o, qm + (size_t)bh * SEQ * 192, km + (size_t)bh * SEQ * 192, vtm + (size_t)bh * 128 * SEQ, q0, lds, tid, wave, lane);
            attn_out_store(o, p.in[9], 1.0f, ao + (size_t)(b * SEQ + q0 + 32 * wave + r32) * DM + hd * 128, h);
        } else {
            f32x16 o[4];
            LAS unsigned* st = (LAS unsigned*)(lds + 59392) + wave * 2048 + lane;
            attn_pass<64>(o, qd + (size_t)(bh * 2 + 1) * SEQ * 64, kd + (size_t)(bh * 2 + 1) * SEQ * 64, vtd + (size_t)bh * 128 * SEQ, q0, lds, tid, wave, lane);
#pragma unroll
            for (int db = 0; db < 4; ++db)
#pragma unroll
                for (int i = 0; i < 16; i += 2) st[(db * 8 + (i >> 1)) * 64] = cvt_pk_bf16(o[db][i], o[db][i + 1]);
            attn_pass<64>(o, qd + (size_t)(bh * 2) * SEQ * 64, kd + (size_t)(bh * 2) * SEQ * 64, vtd + (size_t)bh * 128 * SEQ, q0, lds, tid, wave, lane);
#pragma unroll
            for (int db = 0; db < 4; ++db)
#pragma unroll
                for (int i = 0; i < 16; i += 2) { const unsigned wv = st[(db * 8 + (i >> 1)) * 64]; o[db][i] -= lam * bflo(wv); o[db][i + 1] -= lam * bfhi(wv); }
            attn_out_store(o, p.in[16], 1.0f - LAMBDA_INIT, ao + (size_t)(b * SEQ + q0 + 32 * wave + r32) * DM + hd * 128 + 1024, h);
        }
    }
}

#define XB_TMO      128
#define XB_XCNT(j)  (256  + 64 * (j))
#define XB_XSUB(j)  (1280 + 64 * (j))
#define XB_XGEN(j)  (2304 + 64 * (j))
#define XB_TOP      3328
#define XB_TOPGEN   3392
#define XCD_BAR_WORDS 3456
#define XB_SPIN_CAP (1u << 18)

__device__ __forceinline__ unsigned xb_ld(unsigned* p)              { return __hip_atomic_load(p, __ATOMIC_RELAXED, __HIP_MEMORY_SCOPE_AGENT); }
__device__ __forceinline__ unsigned xb_add(unsigned* p, unsigned v) { return __hip_atomic_fetch_add(p, v, __ATOMIC_RELAXED, __HIP_MEMORY_SCOPE_AGENT); }
__device__ __forceinline__ unsigned xb_xcc_id() { return (unsigned)__builtin_amdgcn_s_getreg((3 << 11) | 20) & 0xFu; }
#define XB_SPIN(cond, bar) do { unsigned _sp = 0; while (cond) { __builtin_amdgcn_s_sleep(1); \
    if ((++_sp & 255u) == 0u) { if (xb_ld(&(bar)[XB_TMO])) break; if (_sp > XB_SPIN_CAP) { atomicAdd(&(bar)[XB_TMO], 1u); break; } } } } while (0)

struct XcdBarrier {
    unsigned* bar; unsigned x;
    volatile LAS unsigned* st;
};

__device__ __forceinline__ XcdBarrier xcd_barrier_post(unsigned* bar, volatile LAS unsigned* st) {
    XcdBarrier b; b.bar = bar; b.x = xb_xcc_id(); b.st = st;
    if (threadIdx.x == 0) (void)xb_add(&bar[XB_XCNT(b.x)], 1u);
    return b;
}
__device__ __forceinline__ void xcd_barrier_complete(unsigned* bar, unsigned x, unsigned& nloc, unsigned& nx) {
    const unsigned G = gridDim.x * gridDim.y * gridDim.z;
    unsigned sum, cnt, mine, sp = 0u;
    for (;;) {
        sum = 0u; cnt = 0u; mine = 0u;
#pragma unroll
        for (unsigned j = 0; j < 16; ++j) { const unsigned c = xb_ld(&bar[XB_XCNT(j)]); sum += c; cnt += (c > 0u) ? 1u : 0u; mine = (j == x) ? c : mine; }
        if (sum == G) break;
        __builtin_amdgcn_s_sleep(1);
        if ((++sp & 255u) == 0u) { if (xb_ld(&bar[XB_TMO])) break; if (sp > XB_SPIN_CAP) { atomicAdd(&bar[XB_TMO], 1u); break; } }
    }
    nloc = mine > 0u ? mine : 1u; nx = cnt > 0u ? cnt : 1u;
}

__device__ __forceinline__ void xcd_barrier(const XcdBarrier& b) {
    asm volatile("s_waitcnt vmcnt(0)" ::: "memory");
    __syncthreads();
    if (threadIdx.x == 0) {
        unsigned* bar = b.bar;
        __builtin_amdgcn_s_waitcnt(0);
        unsigned nloc = b.st[0], nx = b.st[1];
        if (nloc == 0u) { xcd_barrier_complete(bar, b.x, nloc, nx); b.st[0] = nloc; b.st[1] = nx; }
        const unsigned old = xb_add(&bar[XB_XSUB(b.x)], 1u);
        const unsigned gen = old / nloc;
        if (old + 1u == (gen + 1u) * nloc) {
            __builtin_amdgcn_fence(__ATOMIC_RELEASE, "agent");
            asm volatile("s_waitcnt vmcnt(0)" ::: "memory");
            const unsigned og = xb_add(&bar[XB_TOP], 1u);
            const unsigned tg = og / nx;
            if (og + 1u == (tg + 1u) * nx) xb_add(&bar[XB_TOPGEN], 1u);
            else XB_SPIN(xb_ld(&bar[XB_TOPGEN]) == tg, bar);
            __builtin_amdgcn_fence(__ATOMIC_ACQUIRE, "agent");
            xb_add(&bar[XB_XGEN(b.x)], 1u);
            asm volatile("s_waitcnt vmcnt(0)" ::: "memory");
        } else {
            XB_SPIN(xb_ld(&bar[XB_XGEN(b.x)]) == gen, bar);
            __builtin_amdgcn_fence(__ATOMIC_ACQUIRE, "agent");
            asm volatile("s_waitcnt vmcnt(0)" ::: "memory");
        }
    }
    __syncthreads();
}

__global__ void __launch_bounds__(NTHR, 2) fwd_kernel(Params p) {
    extern __shared__ __attribute__((aligned(16))) unsigned char lds_raw[];
    LAS unsigned char* lds = (LAS unsigned char*)lds_raw;
    const int tid = threadIdx.x, lane = tid & 63, wave = __builtin_amdgcn_readfirstlane(tid >> 6);
    const int G = gridDim.x, bx = blockIdx.x;
    const int gw = bx * NWAVES + wave, NGW = G * NWAVES;
    unsigned char* ws = p.ws;
    unsigned* ctl = MK_ONE_LAUNCH ? g_ctl : (unsigned*)(ws + WS_CTL);
    const int lo = p.ph_lo, hi = p.ph_hi;
    volatile LAS unsigned* bst = (volatile LAS unsigned*)(lds + 163808);
    if (tid == 0) { bst[0] = 0u; bst[1] = 0u; }
    __syncthreads();
    XcdBarrier bar; bar.bar = ctl + 1024; bar.x = 0; bar.st = bst;
    if (hi > lo) bar = xcd_barrier_post(ctl + 1024, bst);
    if (hi > 1000) cg::this_grid().sync();
#define IN(k) (lo <= (k) && (k) < hi)
#define SEAM(k) do { if (IN(k) && IN((k) + 1)) { xcd_barrier(bar); } } while (0)
    if (IN(0)) { if (bx == 0 && tid == 0) { ctl[0] = 0u; ctl[64] = 0u; }
        phase0(p, lds, gw, NGW, wave, lane); }
    SEAM(0);
    if (IN(1)) {
        pg8::Gemm g{(const bf16_t*)(ws + WS_HB), (const bf16_t*)(ws + WS_WIN), M, NPROJ, 2048}; pg8::StaticOrder S; S.init(M, NPROJ, G, bx);
        EpiProj E{(bf16_t*)(ws + WS_QLAT), (bf16_t*)(ws + WS_KVLAT), (float*)(ws + WS_SSQL), (bf16_t*)(ws + WS_PROJ), (bf16_t*)(ws + WS_VTD)};
        pg8::gemm_phase<EpiProj, pg8::StaticOrder, true, true>(lds, g, S, E);
    }
    SEAM(1);
    if (IN(3)) {
        p3_pre(p, lds, bx, G, tid, wave, lane);
        __syncthreads();
        { pg8::Gemm g{(const bf16_t*)(ws + WS_QLAT), (const bf16_t*)(ws + WS_WQ), 2 * M, 3584, 512}; StackedOrder S{G, bx};
          EpiQKv E{EpiPlain{(bf16_t*)(ws + WS_QF), 1536}, EpiKv{(bf16_t*)(ws + WS_KNOPE), (bf16_t*)(ws + WS_VTM), (const float*)(ws + WS_SSQL)}};
          pg8::gemm_phase<EpiQKv, StackedOrder, true, true>(lds, g, S, E); }
    }
    SEAM(3);
    if (IN(4)) phase4(p, gw, NGW, lane);
    SEAM(4);
    if (IN(5)) phase5(p, lds, ctl, tid, wave, lane);
    SEAM(5);
    if (IN(6)) {
        pg8::Gemm g{(const bf16_t*)(ws + WS_AO), (const bf16_t*)(ws + WS_WO), M, DM, 2048}; pg8::StaticOrder S; S.init(M, DM, G, bx);
        EpiWo E{p.in[0], p.out, (bf16_t*)(ws + WS_X1B), (float*)(ws + WS_SSQ)};
        pg8::gemm_phase<EpiWo, pg8::StaticOrder, true, true>(lds, g, S, E);
    }
    SEAM(6);
    if (IN(7)) {
        pg8::Gemm g{(const bf16_t*)(ws + WS_X1B), (const bf16_t*)(ws + WS_WGU), M, 2 * DFF, 2048}; pg8::StaticOrder S; S.init(M, 2 * DFF, G, bx);
        EpiGateUp E{(const float*)(ws + WS_SSQ), (bf16_t*)(ws + WS_HMID)};
        pg8::gemm_phase<EpiGateUp, pg8::StaticOrder, true, true>(lds, g, S, E);
        { const int nwg = (M / 256) * (2 * DFF / 256), rem = nwg % G;
          if (rem == 0) p0_convert(p, lds, P0_NITEMS - P0_ITEMS_WD, P0_NITEMS, gw, NGW, wave, lane);
          else if (bx >= rem) p0_convert(p, lds, P0_NITEMS - P0_ITEMS_WD, P0_NITEMS, (bx - rem) * NWAVES + wave, (G - rem) * NWAVES, wave, lane); }
    }
    SEAM(7);
    if (IN(8)) {
        pg8::Gemm g{(const bf16_t*)(ws + WS_HMID), (const bf16_t*)(ws + WS_WD), M, DM, DFF}; pg8::StaticOrder S; S.init(M, DM, G, bx);
        EpiDown E{(const bf16_t*)(ws + WS_X1B), p.out};
        pg8::gemm_phase<EpiDown, pg8::StaticOrder, true, true>(lds, g, S, E);
    }
#if MK_ONE_LAUNCH
    if (hi > lo) {
        LAS unsigned* shx = (LAS unsigned*)(lds + 163828);
        __syncthreads();
        if (tid == 0) { __threadfence(); shx[0] = (atomicAdd(&ctl[128], 1u) == (unsigned)(G - 1)) ? 1u : 0u; }
        __syncthreads();
        if (shx[0]) { for (int i = tid; i < 8192; i += NTHR) __hip_atomic_store(&ctl[i], 0u, __ATOMIC_RELAXED, __HIP_MEMORY_SCOPE_AGENT); }
    }
#endif
#undef IN
#undef SEAM
}
}

extern "C" void kernel_launch(void* const* d_in, const int* in_sizes, int n_in, void* d_out, int out_size, void* d_ws, size_t ws_size, hipStream_t stream) {
    static int grid = 0;
    if (grid == 0) {
        if (n_in != 22 || out_size != mk::M * mk::DM || ws_size < mk::WS_END) { fprintf(stderr, "kernel_launch: unexpected shapes (n_in %d out %d ws %zu)\n", n_in, out_size, ws_size); grid = -1; return; }
        int dev = 0, cus = 0, per_cu = 0;
        if (hipGetDevice(&dev) != hipSuccess || hipDeviceGetAttribute(&cus, hipDeviceAttributeMultiprocessorCount, dev) != hipSuccess) { grid = -1; return; }
        if (hipFuncSetAttribute((const void*)mk::fwd_kernel, hipFuncAttributeMaxDynamicSharedMemorySize, mk::LDS_BYTES) != hipSuccess) { fprintf(stderr, "kernel_launch: hipFuncSetAttribute failed\n"); grid = -1; return; }
        if (hipOccupancyMaxActiveBlocksPerMultiprocessor(&per_cu, (const void*)mk::fwd_kernel, mk::NTHR, mk::LDS_BYTES) != hipSuccess || per_cu < 1) { fprintf(stderr, "kernel_launch: occupancy query says %d\n", per_cu); per_cu = 1; }
        (void)hipGetLastError();
        grid = cus * per_cu;
    }
    if (grid < 0) return;
#if !MK_ONE_LAUNCH
    if (hipMemsetAsync((char*)d_ws + mk::WS_CTL, 0, 32768, stream) != hipSuccess) { fprintf(stderr, "kernel_launch: hipMemsetAsync failed\n"); return; }
#endif
    mk::Params p{};
    for (int i = 0; i < 22; ++i) p.in[i] = (const float*)d_in[i];
    p.out = (float*)d_out; p.ws = (unsigned char*)d_ws;
#if MK_ONE_LAUNCH
    p.ph_lo = 0; p.ph_hi = 9;
    void* args[] = {&p};
    hipError_t e = hipLaunchCooperativeKernel((const void*)mk::fwd_kernel, dim3(grid), dim3(mk::NTHR), args, mk::LDS_BYTES, stream);
    if (e != hipSuccess) fprintf(stderr, "cooperative launch failed: %s (grid %d)\n", hipGetErrorString(e), grid);
#else
    for (int k = 0; k < 9; ++k) { p.ph_lo = k; p.ph_hi = k + 1; hipLaunchKernelGGL(mk::fwd_kernel, dim3(grid), dim3(mk::NTHR), mk::LDS_BYTES, stream, p); }
#endif
}
```

```cpp
#include <hip/hip_runtime.h>
#include <hip/hip_cooperative_groups.h>
#include <cstdio>
#include <cstdint>
namespace cg = cooperative_groups;
namespace pg8 {
#define PG8_LAS __attribute__((address_space(3)))
typedef unsigned short bf16_t;
typedef short bf16x8 __attribute__((ext_vector_type(8)));
typedef float f32x4 __attribute__((ext_vector_type(4)));
typedef unsigned u32x4 __attribute__((ext_vector_type(4)));
constexpr int BM = 256, BK = 64, HALF = 128, HTB = HALF * BK * 2  , STAGE_BYTES = 8 * HTB, NXCD = 8, WGM = 2;

__host__ __device__ __forceinline__ int lds_byte(int r, int c) { const int st = (r >> 4) * 2 + (c >> 5), rr = r & 15, cc = c & 31, ob = rr * 64 + cc * 2; return st * 1024 + (ob ^ (((ob >> 9) & 1) << 5)); }
__host__ __device__ __forceinline__ void stage_rc(int b, int& R, int& C) { const int st = b / 1024, sb = b % 1024, swz = sb ^ (((sb >> 9) & 1) << 5); R = (st >> 1) * 16 + swz / 64; C = (st & 1) * 32 + (swz % 64) / 2; }
__host__ __device__ __forceinline__ int perm32(int rho) { const int n = rho >> 4, i = rho & 15; return 8 * (i >> 2) + 4 * n + (i & 3); }

struct Unit { int pm, pn; };
struct Gemm { const bf16_t* A; const bf16_t* Bt; int M, N, K; };

struct StaticOrder {
    int nM, nN, nwg, G, c;
    __host__ __device__ void init(int M, int N, int G_, int c_) { nM = M / BM; nN = N / BM; nwg = nM * nN; G = G_; c = c_; }
    __host__ __device__ bool next(int i, Unit& u) const {
        const long L = (long)i * G + c; if (L >= nwg) return false;
        int wgid = (int)L; { const int q = nwg / NXCD, r = nwg % NXCD, xcd = wgid % NXCD, off = wgid / NXCD; wgid = (xcd < r ? xcd * (q + 1) : r * (q + 1) + (xcd - r) * q) + off; }
        const int nig = WGM * nN, gid = wgid / nig, fm = gid * WGM, gsz = (nM - fm) < WGM ? (nM - fm) : WGM;
        u.pm = fm + ((wgid % nig) % gsz); u.pn = (wgid % nig) / gsz; return true;
    }
    __device__ __forceinline__ void a_ready(const Unit&) const {}
    __device__ __forceinline__ void done(const Unit&) const {}
};

__device__ __forceinline__ unsigned cvt_pk_bf16(float lo, float hi) { unsigned r; asm volatile("v_cvt_pk_bf16_f32 %0, %1, %2" : "=v"(r) : "v"(lo), "v"(hi)); return r; }
typedef float f32x2 __attribute__((ext_vector_type(2)));
template <class Epi, class Sched, bool ALIGN_EPI = false, bool SP2 = false>
__device__ __forceinline__ void gemm_phase(PG8_LAS unsigned char* lds, const Gemm g, const Sched& S, const Epi& E) {
    const int tid = threadIdx.x, wid = __builtin_amdgcn_readfirstlane(tid >> 6), lane = tid & 63, wr = wid >> 2, wc = wid & 3, fr = lane & 15, fq = lane >> 4;
    const int K = g.K, nt = K / BK;
    unsigned voffA[2], voffB[2];
#pragma unroll
    for (int i = 0; i < 2; ++i) { int R, C; stage_rc(tid * 16 + i * 8192, R, C); const int Rb = Epi::PERM ? ((R & ~31) + perm32(R & 31)) : R;
        voffA[i] = (unsigned)(R * K + C) * 2u; voffB[i] = (unsigned)(Rb * K + C) * 2u; }
    const size_t kstep = (size_t)(BK * 2);
    const size_t hstep = (size_t)HALF * K * 2;
    const size_t tstep = 2 * hstep;
    const unsigned ldsw = (unsigned)wid * 1024u;
    const int aoff = lds_byte(wr * 64 + fr, fq * 8), boff = lds_byte(wc * 32 + fr, fq * 8);
#define PG8_SA(b, h) (((b) * 2 + (h)) * HTB)
#define PG8_SB(b, h) ((4 + (b) * 2 + (h)) * HTB)
#define PG8_STAGE(bufoff, gbase, voff) do { _Pragma("unroll") for (int _i = 0; _i < 2; ++_i) \
        __builtin_amdgcn_global_load_lds((const unsigned*)((const char*)(gbase) + (voff)[_i]), (PG8_LAS unsigned*)(lds + (bufoff) + ldsw + _i * 8192), 16, 0, 0); } while (0)
#define PG8_LDA(dst, b, h) do { _Pragma("unroll") for (int m = 0; m < 4; ++m) _Pragma("unroll") for (int k = 0; k < 2; ++k) dst[m][k] = *(const PG8_LAS bf16x8*)(lds + PG8_SA(b, h) + aoff + m * 2048 + k * 1024); } while (0)
#define PG8_LDB(dst, b, h) do { _Pragma("unroll") for (int n = 0; n < 2; ++n) _Pragma("unroll") for (int k = 0; k < 2; ++k) dst[n][k] = *(const PG8_LAS bf16x8*)(lds + PG8_SB(b, h) + boff + n * 2048 + k * 1024); } while (0)
#define PG8_MMA(ai, bj, At, Bt) do { __builtin_amdgcn_s_setprio(1); _Pragma("unroll") for (int m = 0; m < 4; ++m) _Pragma("unroll") for (int n = 0; n < 2; ++n) _Pragma("unroll") for (int k = 0; k < 2; ++k) \
        acc[ai][bj][m][n] = __builtin_amdgcn_mfma_f32_16x16x32_bf16(Bt[n][k], At[m][k], acc[ai][bj][m][n], 0, 0, 0); __builtin_amdgcn_s_setprio(0); } while (0)
#define PG8_WAIT_V(n) asm volatile("s_waitcnt vmcnt(" #n ")" ::: "memory")
#define PG8_WAIT_L(n) asm volatile("s_waitcnt lgkmcnt(" #n ")" ::: "memory")
#define PG8_BAR __builtin_amdgcn_s_barrier()
#define PG8_SCHED __builtin_amdgcn_sched_barrier(0)
    Unit cur, nxt; int ui = 0;
    if (!S.next(0, cur)) return;
    f32x4 acc[2][2][4][2];
#pragma unroll
    for (int a = 0; a < 2; ++a)
#pragma unroll
        for (int b = 0; b < 2; ++b)
#pragma unroll
            for (int m = 0; m < 4; ++m)
#pragma unroll
                for (int n = 0; n < 2; ++n) acc[a][b][m][n] = (f32x4){0.f, 0.f, 0.f, 0.f};
    bf16x8 At[4][2], B0[2][2], B1[2][2];
    const char* cA = (const char*)g.A + (size_t)cur.pm * tstep; const char* cB = (const char*)g.Bt + (size_t)cur.pn * tstep;
    S.a_ready(cur);
    if constexpr (SP2) {
        PG8_STAGE(PG8_SB(0, 0), cB, voffB); PG8_STAGE(PG8_SB(0, 1), cB + hstep, voffB); PG8_STAGE(PG8_SA(0, 0), cA, voffA); PG8_STAGE(PG8_SA(0, 1), cA + hstep, voffA);
        if (wr == 1) PG8_BAR;
        PG8_WAIT_V(2); PG8_BAR;
        PG8_STAGE(PG8_SB(1, 0), cB + kstep, voffB); PG8_STAGE(PG8_SA(1, 0), cA + kstep, voffA); PG8_STAGE(PG8_SB(1, 1), cB + hstep + kstep, voffB);
        PG8_WAIT_V(6); PG8_BAR;
    } else {
        PG8_STAGE(PG8_SB(0, 0), cB, voffB); PG8_STAGE(PG8_SA(0, 0), cA, voffA); PG8_STAGE(PG8_SB(0, 1), cB + hstep, voffB); PG8_STAGE(PG8_SA(0, 1), cA + hstep, voffA);
        if (wr == 1) PG8_BAR;
        PG8_WAIT_V(4); PG8_BAR;
        PG8_STAGE(PG8_SB(1, 0), cB + kstep, voffB); PG8_STAGE(PG8_SA(1, 0), cA + kstep, voffA); PG8_STAGE(PG8_SB(1, 1), cB + hstep + kstep, voffB);
        PG8_WAIT_V(6); PG8_BAR;
    }
    for (;;) {
        const bool has_next = S.next(ui + 1, nxt);
        const char* nA = has_next ? (const char*)g.A + (size_t)nxt.pm * tstep : cA; const char* nB = has_next ? (const char*)g.Bt + (size_t)nxt.pn * tstep : cB;
        for (int t = 0; t < nt; t += 2) {
            const bool last = (t == nt - 2);
            const char* a1 = cA + (size_t)(t + 1) * kstep;
            const char* a2 = last ? nA : cA + (size_t)(t + 2) * kstep; const char* b2 = last ? nB : cB + (size_t)(t + 2) * kstep;
            const char* a3 = a2 + kstep; const char* b3 = b2 + kstep;
            if (last && has_next) S.a_ready(nxt);
            if constexpr (SP2) {
            PG8_LDB(B0, 0, 0); PG8_LDB(B1, 0, 1); PG8_SCHED; PG8_LDA(At, 0, 0); PG8_STAGE(PG8_SA(1, 1), a1 + hstep, voffA);
            PG8_WAIT_V(8); PG8_WAIT_L(0); PG8_BAR; PG8_MMA(0, 0, At, B0); PG8_MMA(0, 1, At, B1); PG8_BAR; PG8_SCHED;
            PG8_LDA(At, 0, 1); PG8_STAGE(PG8_SB(0, 0), b2, voffB); PG8_STAGE(PG8_SB(0, 1), b2 + hstep, voffB); PG8_STAGE(PG8_SA(0, 0), a2, voffA);
            PG8_WAIT_V(8); PG8_WAIT_L(0); PG8_BAR; PG8_MMA(1, 0, At, B0); PG8_MMA(1, 1, At, B1); PG8_BAR; PG8_SCHED;
            PG8_LDB(B0, 1, 0); PG8_LDB(B1, 1, 1); PG8_SCHED; PG8_LDA(At, 1, 0); PG8_STAGE(PG8_SA(0, 1), a2 + hstep, voffA);
            PG8_WAIT_V(8); PG8_WAIT_L(0); PG8_BAR; PG8_MMA(0, 0, At, B0); PG8_MMA(0, 1, At, B1); PG8_BAR; PG8_SCHED;
            PG8_LDA(At, 1, 1); PG8_STAGE(PG8_SB(1, 0), b3, voffB); PG8_STAGE(PG8_SB(1, 1), b3 + hstep, voffB); PG8_STAGE(PG8_SA(1, 0), a3, voffA);
            PG8_WAIT_V(8); PG8_WAIT_L(0); PG8_BAR; PG8_MMA(1, 0, At, B0); PG8_MMA(1, 1, At, B1); PG8_BAR; PG8_SCHED;
            } else {
            PG8_LDB(B0, 0, 0); PG8_SCHED; PG8_LDA(At, 0, 0); PG8_STAGE(PG8_SA(1, 1), a1 + hstep, voffA);
            PG8_WAIT_L(8); PG8_BAR; PG8_WAIT_L(0); PG8_MMA(0, 0, At, B0); PG8_BAR; PG8_SCHED;
            PG8_LDB(B1, 0, 1); PG8_STAGE(PG8_SB(0, 0), b2, voffB);
            PG8_BAR; PG8_WAIT_L(0); PG8_MMA(0, 1, At, B1); PG8_BAR;
            PG8_LDA(At, 0, 1); PG8_STAGE(PG8_SA(0, 0), a2, voffA);
            PG8_BAR; PG8_WAIT_L(0); PG8_MMA(1, 0, At, B0); PG8_BAR; PG8_SCHED;
            PG8_STAGE(PG8_SB(0, 1), b2 + hstep, voffB);
            PG8_WAIT_V(6); PG8_BAR; PG8_MMA(1, 1, At, B1); PG8_BAR;
            PG8_LDB(B0, 1, 0); PG8_SCHED; PG8_LDA(At, 1, 0); PG8_STAGE(PG8_SA(0, 1), a2 + hstep, voffA);
            PG8_WAIT_L(8); PG8_BAR; PG8_WAIT_L(0); PG8_MMA(0, 0, At, B0); PG8_BAR; PG8_SCHED;
            PG8_LDB(B1, 1, 1); PG8_STAGE(PG8_SB(1, 0), b3, voffB);
            PG8_BAR; PG8_WAIT_L(0); PG8_MMA(0, 1, At, B1); PG8_BAR;
            PG8_LDA(At, 1, 1); PG8_STAGE(PG8_SA(1, 0), a3, voffA);
            PG8_BAR; PG8_WAIT_L(0); PG8_MMA(1, 0, At, B0); PG8_BAR; PG8_SCHED;
            PG8_STAGE(PG8_SB(1, 1), b3 + hstep, voffB);
            PG8_WAIT_V(6); PG8_BAR; PG8_MMA(1, 1, At, B1); PG8_BAR;
            }
        }
        if constexpr (ALIGN_EPI) { if (wr == 0) PG8_BAR; }
        if constexpr (!Epi::AFTER_DRAIN) { E(acc, cur, wr, wc, fr, fq); S.done(cur); }
        if (!has_next) break;
#pragma unroll
        for (int a = 0; a < 2; ++a)
#pragma unroll
            for (int b = 0; b < 2; ++b)
#pragma unroll
                for (int m = 0; m < 4; ++m)
#pragma unroll
                    for (int n = 0; n < 2; ++n) acc[a][b][m][n] = (f32x4){0.f, 0.f, 0.f, 0.f};
        cur = nxt; cA = nA; cB = nB; ++ui;
        if constexpr (ALIGN_EPI) { if (wr == 1) PG8_BAR; }
    }
    PG8_WAIT_V(0);
    if constexpr (!ALIGN_EPI) { if (wr == 0) PG8_BAR; }
    PG8_BAR;
    if constexpr (Epi::AFTER_DRAIN) { E.fused(acc, cur, wr, wc, fr, fq, lds, wid, lane); S.done(cur); }
#undef PG8_SA
#undef PG8_SB
#undef PG8_STAGE
#undef PG8_LDA
#undef PG8_LDB
#undef PG8_MMA
#undef PG8_WAIT_V
#undef PG8_WAIT_L
#undef PG8_BAR
#undef PG8_SCHED
}
}

#ifndef MK_ONE_LAUNCH
#define MK_ONE_LAUNCH 1
#endif

namespace mk {
#define LAS __attribute__((address_space(3)))
typedef unsigned short bf16_t;
typedef short bf16x8 __attribute__((ext_vector_type(8)));
typedef float f32x4 __attribute__((ext_vector_type(4)));
typedef float f32x16 __attribute__((ext_vector_type(16)));
typedef unsigned u32x4 __attribute__((ext_vector_type(4)));
typedef unsigned u32x2 __attribute__((ext_vector_type(2)));
using pg8::Unit;
using pg8::cvt_pk_bf16;

constexpr int NWAVES = 8, NTHR = 512;
constexpr int M = 8192, DM = 2048, SEQ = 2048;
constexpr int NPROJ = 4096, PROJ_LD = 2048, DFF = 5632;
constexpr float EPS = 1e-6f;
constexpr float LOG2E = 1.4426950408889634f;
constexpr float LOG2_THETA = 18.931568569324174f;
constexpr float LAMBDA_INIT = 0.2f;

constexpr size_t MiB = 1u << 20;
constexpr size_t WS_CTL = 0;
constexpr size_t WS_WIN = 1 * MiB, WS_WQ = 18 * MiB, WS_WKV = 18 * MiB + 1536 * 1024, WS_WO = 22 * MiB, WS_WGU = 30 * MiB, WS_WD = 74 * MiB;
constexpr size_t WS_VTM = 1 * MiB;
constexpr size_t WS_VTD = 74 * MiB;
constexpr size_t WS_HB = 96 * MiB, WS_PROJ = 128 * MiB, WS_QLAT = 160 * MiB, WS_KVLAT = 168 * MiB, WS_SSQL = 176 * MiB, WS_KPE = 177 * MiB;
constexpr size_t WS_QF = 178 * MiB, WS_KNOPE = 202 * MiB, WS_QD = 218 * MiB, WS_KD = 234 * MiB;
constexpr size_t WS_QM = 96 * MiB, WS_KM = 120 * MiB, WS_AO = 144 * MiB, WS_X1B = 96 * MiB, WS_SSQ = 128 * MiB, WS_HMID = 130 * MiB;
constexpr size_t WS_END = 256 * MiB;
constexpr int LDS_BYTES = 163840;

__device__ unsigned g_ctl[8192];
struct Params { const float* in[22]; float* out; unsigned char* ws; int ph_lo, ph_hi; };

__device__ __forceinline__ float bf2f(unsigned short b) { return __uint_as_float((unsigned)b << 16); }
__device__ __forceinline__ float bflo(unsigned w) { return __uint_as_float(w << 16); }
__device__ __forceinline__ float bfhi(unsigned w) { return __uint_as_float(w & 0xffff0000u); }
__device__ __forceinline__ float wave_sum(float v) {
#pragma unroll
    for (int o = 1; o < 64; o <<= 1) v += __shfl_xor(v, o);
    return v;
}
__device__ __forceinline__ int perm16(int s) { return (s & 3) | ((s & 4) << 1) | ((s & 8) >> 1); }
__device__ __forceinline__ void sincos_ang(float ang, float& s, float& c) {
    double rev = (double)ang * 0.15915494309189535;
    rev -= __builtin_rint(rev);
    const float fr = (float)rev;
    s = __builtin_amdgcn_sinf(fr); c = __builtin_amdgcn_cosf(fr);
}
__device__ __forceinline__ float rope_freq(int i, int r) { return exp2f(-(float)(2 * i) / (float)r * LOG2_THETA); }

__device__ __forceinline__ u32x4 pack8(const f32x4& a, const f32x4& b) {
    u32x4 w; w.x = cvt_pk_bf16(a[0], a[1]); w.y = cvt_pk_bf16(a[2], a[3]); w.z = cvt_pk_bf16(b[0], b[1]); w.w = cvt_pk_bf16(b[2], b[3]); return w;
}
__device__ __forceinline__ bf16_t f2bf1(float v) { return (bf16_t)(cvt_pk_bf16(v, v) & 0xffffu); }

__device__ __forceinline__ void store_v(bf16_t* v, int bh, int d0, int r, const f32x4& a, const f32x4& b) {
    *(u32x4*)(v + ((size_t)bh * 2048 + (r & 2047)) * 128 + d0) = pack8(a, b);
}

struct EpiProj {
    static constexpr bool PERM = true, AFTER_DRAIN = false;
    bf16_t* qlat; bf16_t* kvlat; float* ssql; bf16_t* proj; bf16_t* vtd;
    __device__ __forceinline__ void operator()(const f32x4 (&acc)[2][2][4][2], const Unit& u, int wr, int wc, int fr, int fq) const {
        const int row0 = u.pm * 256 + wr * 64 + fr;
        if (u.pn < 4) {
            bf16_t* dst = (u.pn < 2) ? qlat : kvlat; const int t2 = u.pn & 1, lat = u.pn >> 1, col0 = t2 * 256 + wc * 32 + 8 * fq;
#pragma unroll
            for (int ai = 0; ai < 2; ++ai)
#pragma unroll
                for (int m = 0; m < 4; ++m) { const int r = row0 + ai * 128 + m * 16; bf16_t* rowp = dst + (size_t)r * 512 + col0; float sq = 0.f;
#pragma unroll
                    for (int bj = 0; bj < 2; ++bj) { const f32x4 v0 = acc[ai][bj][m][0], v1 = acc[ai][bj][m][1]; *(u32x4*)(rowp + bj * 128) = pack8(v0, v1);
                        sq += (v0[0] * v0[0] + v0[1] * v0[1]) + (v0[2] * v0[2] + v0[3] * v0[3]) + (v1[0] * v1[0] + v1[1] * v1[1]) + (v1[2] * v1[2] + v1[3] * v1[3]); }
                    sq += __shfl_xor(sq, 16); sq += __shfl_xor(sq, 32);
                    if (fq == 0) ssql[(size_t)r * 16 + lat * 8 + t2 * 4 + wc] = sq; }
        } else if (u.pn < 12) {
            const int col0 = (u.pn - 4) * 256 + wc * 32 + 8 * fq;
#pragma unroll
            for (int ai = 0; ai < 2; ++ai)
#pragma unroll
                for (int m = 0; m < 4; ++m) { bf16_t* rowp = proj + (size_t)(row0 + ai * 128 + m * 16) * PROJ_LD + col0;
#pragma unroll
                    for (int bj = 0; bj < 2; ++bj) *(u32x4*)(rowp + bj * 128) = pack8(acc[ai][bj][m][0], acc[ai][bj][m][1]); }
        } else {
#pragma unroll
            for (int ai = 0; ai < 2; ++ai)
#pragma unroll
                for (int m = 0; m < 4; ++m) { const int r = row0 + ai * 128 + m * 16; const int b = r >> 11;
#pragma unroll
                    for (int bj = 0; bj < 2; ++bj) store_v(vtd, b * 8 + 2 * (u.pn - 12) + bj, wc * 32 + 8 * fq, r, acc[ai][bj][m][0], acc[ai][bj][m][1]); }
        }
    }
};
__device__ __forceinline__ float latent_rs(const float* ssql_row8) {
    const f32x4 a = *(const f32x4*)ssql_row8, b = *(const f32x4*)(ssql_row8 + 4);
    return 1.0f / sqrtf((((a[0] + a[1]) + (a[2] + a[3])) + ((b[0] + b[1]) + (b[2] + b[3]))) * (1.0f / 512.0f) + EPS);
}
struct EpiPlain {
    static constexpr bool PERM = true, AFTER_DRAIN = false;
    bf16_t* O; int ldc;
    __device__ __forceinline__ void operator()(const f32x4 (&acc)[2][2][4][2], const Unit& u, int wr, int wc, int fr, int fq) const {
        const int row0 = u.pm * 256 + wr * 64 + fr, col0 = u.pn * 256 + wc * 32 + 8 * fq;
#pragma unroll
        for (int ai = 0; ai < 2; ++ai)
#pragma unroll
            for (int m = 0; m < 4; ++m) { bf16_t* rowp = O + (size_t)(row0 + ai * 128 + m * 16) * ldc + col0;
#pragma unroll
                for (int bj = 0; bj < 2; ++bj) *(u32x4*)(rowp + bj * 128) = pack8(acc[ai][bj][m][0], acc[ai][bj][m][1]); }
    }
};
struct EpiKv {
    static constexpr bool PERM = true, AFTER_DRAIN = false;
    bf16_t* knope; bf16_t* vtm; const float* ssql;
    __device__ __forceinline__ void operator()(const f32x4 (&acc)[2][2][4][2], const Unit& u, int wr, int wc, int fr, int fq) const {
        const int row0 = u.pm * 256 + wr * 64 + fr;
        f32x4 sv[8][2];
#pragma unroll
        for (int k = 0; k < 8; ++k) { const f32x4* sp = (const f32x4*)(ssql + (size_t)(row0 + (k >> 2) * 128 + (k & 3) * 16) * 16 + 8); sv[k][0] = sp[0]; sv[k][1] = sp[1]; }
#pragma unroll
        for (int ai = 0; ai < 2; ++ai)
#pragma unroll
            for (int m = 0; m < 4; ++m) { const int r = row0 + ai * 128 + m * 16; const f32x4 a = sv[ai * 4 + m][0], b = sv[ai * 4 + m][1];
                const float rs = 1.0f / sqrtf((((a[0] + a[1]) + (a[2] + a[3])) + ((b[0] + b[1]) + (b[2] + b[3]))) * (1.0f / 512.0f) + EPS);
                *(u32x4*)(knope + (size_t)r * 1024 + u.pn * 128 + wc * 32 + 8 * fq) = pack8(acc[ai][0][m][0], acc[ai][0][m][1]);
                store_v(vtm, (r >> 11) * 8 + u.pn, wc * 32 + 8 * fq, r, acc[ai][1][m][0] * rs, acc[ai][1][m][1] * rs); }
    }
};
struct EpiWo {
    static constexpr bool PERM = false, AFTER_DRAIN = false;
    const float* x; float* out; bf16_t* x1b; float* ssq;
    __device__ __forceinline__ void operator()(const f32x4 (&acc)[2][2][4][2], const Unit& u, int wr, int wc, int fr, int fq) const {
        const int row0 = u.pm * 256 + wr * 64 + fr, col0 = u.pn * 256 + wc * 32 + 4 * fq;
#pragma unroll
        for (int ai = 0; ai < 2; ++ai) {
            f32x4 xv[4][2][2];
#pragma unroll
            for (int m = 0; m < 4; ++m)
#pragma unroll
                for (int bj = 0; bj < 2; ++bj)
#pragma unroll
                    for (int n = 0; n < 2; ++n) xv[m][bj][n] = __builtin_nontemporal_load((const f32x4*)(x + (size_t)(row0 + ai * 128 + m * 16) * DM + col0 + bj * 128 + n * 16));
#pragma unroll
            for (int m = 0; m < 4; ++m) { const int r = row0 + ai * 128 + m * 16; const size_t off = (size_t)r * DM + col0; float s = 0.f;
#pragma unroll
                for (int bj = 0; bj < 2; ++bj)
#pragma unroll
                    for (int n = 0; n < 2; ++n) { const size_t o2 = off + bj * 128 + n * 16; const f32x4 v = xv[m][bj][n] + acc[ai][bj][m][n];
                        s += (v[0] * v[0] + v[1] * v[1]) + (v[2] * v[2] + v[3] * v[3]);
                        u32x2 w; w.x = cvt_pk_bf16(v[0], v[1]); w.y = cvt_pk_bf16(v[2], v[3]); *(u32x2*)(x1b + o2) = w; }
                s += __shfl_xor(s, 16); s += __shfl_xor(s, 32);
                if (fq == 0) ssq[(size_t)r * 32 + u.pn * 4 + wc] = s; }
        }
    }
};
struct EpiGateUp {
    static constexpr bool PERM = true, AFTER_DRAIN = false;
    const float* ssq; bf16_t* hmid;
    __device__ __forceinline__ void operator()(const f32x4 (&acc)[2][2][4][2], const Unit& u, int wr, int wc, int fr, int fq) const {
        const int row0 = u.pm * 256 + wr * 64 + fr, col0 = u.pn * 128 + wc * 32 + 8 * fq;
        f32x4 sv[8][2];
#pragma unroll
        for (int k = 0; k < 8; ++k) { const f32x4* sp = (const f32x4*)(ssq + (size_t)(row0 + (k >> 2) * 128 + (k & 3) * 16) * 32) + 2 * fq; sv[k][0] = sp[0]; sv[k][1] = sp[1]; }
        float r2[8];
#pragma unroll
        for (int k = 0; k < 8; ++k) { float s = ((sv[k][0][0] + sv[k][0][1]) + (sv[k][0][2] + sv[k][0][3])) + ((sv[k][1][0] + sv[k][1][1]) + (sv[k][1][2] + sv[k][1][3]));
            s += __shfl_xor(s, 16); s += __shfl_xor(s, 32); r2[k] = 1.0f / sqrtf(s * (1.0f / DM) + EPS); }
#pragma unroll
        for (int ai = 0; ai < 2; ++ai)
#pragma unroll
            for (int m = 0; m < 4; ++m) { const int r = row0 + ai * 128 + m * 16; const float rr = r2[ai * 4 + m];
                f32x4 hv[2];
#pragma unroll
                for (int n = 0; n < 2; ++n)
#pragma unroll
                    for (int e = 0; e < 4; ++e) { const float g = acc[ai][0][m][n][e] * rr, up = acc[ai][1][m][n][e] * rr;
                        const float sg = g * __builtin_amdgcn_rcpf(1.0f + __builtin_amdgcn_exp2f(-g * LOG2E)); hv[n][e] = sg * up; }
                __builtin_nontemporal_store(pack8(hv[0], hv[1]), (u32x4*)(hmid + (size_t)r * DFF + col0)); }
    }
};
struct EpiDown {
    static constexpr bool PERM = false, AFTER_DRAIN = false;
    const bf16_t* x1b; float* out;
    __device__ __forceinline__ void operator()(const f32x4 (&acc)[2][2][4][2], const Unit& u, int wr, int wc, int fr, int fq) const {
        const int row0 = u.pm * 256 + wr * 64 + fr, col0 = u.pn * 256 + wc * 32 + 4 * fq;
#pragma unroll
        for (int ai = 0; ai < 2; ++ai) {
            u32x2 xv[4][2][2];
#pragma unroll
            for (int m = 0; m < 4; ++m)
#pragma unroll
                for (int bj = 0; bj < 2; ++bj)
#pragma unroll
                    for (int n = 0; n < 2; ++n) xv[m][bj][n] = *(const u32x2*)(x1b + (size_t)(row0 + ai * 128 + m * 16) * DM + col0 + bj * 128 + n * 16);
#pragma unroll
            for (int m = 0; m < 4; ++m)
#pragma unroll
                for (int bj = 0; bj < 2; ++bj)
#pragma unroll
                    for (int n = 0; n < 2; ++n) { const u32x2 w = xv[m][bj][n]; const f32x4 r = {bflo(w.x), bfhi(w.x), bflo(w.y), bfhi(w.y)};
                        __builtin_nontemporal_store(r + acc[ai][bj][m][n], (f32x4*)(out + (size_t)(row0 + ai * 128 + m * 16) * DM + col0 + bj * 128 + n * 16)); }
        }
    }
};

struct StackedOrder {
    int G, c;
    __device__ __forceinline__ bool next(int i, Unit& u) const {
        const long L = (long)i * G + c; if (L >= 448) return false;
        pg8::StaticOrder t; t.G = 1; t.c = 0;
        if (L < 256) { t.nM = 32; t.nN = 8; t.nwg = 256; t.next((int)L, u); u.pm += 32; u.pn += 6; }
        else { t.nM = 32; t.nN = 6; t.nwg = 192; t.next((int)L - 256, u); }
        return true;
    }
    __device__ __forceinline__ void a_ready(const Unit&) const {}
    __device__ __forceinline__ void done(const Unit&) const {}
};
struct EpiQKv {
    static constexpr bool PERM = true, AFTER_DRAIN = false;
    EpiPlain q; EpiKv kv;
    __device__ __forceinline__ void operator()(const f32x4 (&acc)[2][2][4][2], const Unit& u, int wr, int wc, int fr, int fq) const {
        if (u.pn < 6) q(acc, u, wr, wc, fr, fq);
        else { Unit v; v.pm = u.pm - 32; v.pn = u.pn - 6; kv(acc, v, wr, wc, fr, fq); }
    }
};

struct TItem { const float* src; const float* gain; bf16_t* dst; int ldw, K; bool zero; };
__device__ __forceinline__ TItem p0_item(const Params& p, unsigned char* ws, int it) {
    constexpr int I_IN = 32 * 65, I_Q = 8 * 24, I_KV = 8 * 32, I_O = 32 * 32, I_GU = 32 * 176;
    TItem t; t.gain = nullptr; t.zero = false; int r = it;
    if (r < I_IN) { const int kb = r / 65, nb = r % 65; const int nd = nb * 64; const int ns = nd < 1024 ? nd : (nd < 4096 ? nd + 64 : 1024);
        t.src = p.in[2] + (size_t)(kb * 64) * 4160 + ns; t.ldw = 4160; t.dst = (bf16_t*)(ws + WS_WIN) + (size_t)nd * 2048 + kb * 64; t.K = 2048; return t; } r -= I_IN;
    if (r < I_Q) { const int kb = r / 24, nb = r % 24; t.src = p.in[4] + (size_t)(kb * 64) * 1536 + nb * 64; t.ldw = 1536; t.gain = p.in[3] + kb * 64; t.dst = (bf16_t*)(ws + WS_WQ) + (size_t)(nb * 64) * 512 + kb * 64; t.K = 512; return t; } r -= I_Q;
    if (r < I_KV) { const int kb = r / 32, nb = r % 32; t.src = p.in[6] + (size_t)(kb * 64) * 2048 + nb * 64; t.ldw = 2048; t.gain = p.in[5] + kb * 64; t.dst = (bf16_t*)(ws + WS_WKV) + (size_t)(nb * 64) * 512 + kb * 64; t.K = 512; return t; } r -= I_KV;
    if (r < I_O) { const int kb = r / 32, nb = r % 32; t.src = p.in[17] + (size_t)(kb * 64) * 2048 + nb * 64; t.ldw = 2048; t.dst = (bf16_t*)(ws + WS_WO) + (size_t)(nb * 64) * 2048 + kb * 64; t.K = 2048; return t; } r -= I_O;
    if (r < I_GU) { const int kb = r / 176, nb = r % 176; const int nd = nb * 64; const int tt = nd >> 8, bj = (nd >> 7) & 1, j = nd & 127;
        t.src = (bj ? p.in[20] : p.in[19]) + (size_t)(kb * 64) * DFF + tt * 128 + j; t.ldw = DFF; t.gain = p.in[18] + kb * 64;
        t.dst = (bf16_t*)(ws + WS_WGU) + (size_t)nd * 2048 + kb * 64; t.K = 2048; return t; } r -= I_GU;
    { const int kb = r / 32, nb = r % 32; t.src = p.in[21] + (size_t)(kb * 64) * 2048 + nb * 64; t.ldw = 2048; t.dst = (bf16_t*)(ws + WS_WD) + (size_t)(nb * 64) * DFF + kb * 64; t.K = DFF; return t; }
}
constexpr int P0_NITEMS = 32 * 65 + 8 * 24 + 8 * 32 + 32 * 32 + 32 * 176 + 88 * 32, P0_ITEMS_WD = 88 * 32, P0_ITEMS_EARLY = 32 * 65 + 8 * 24 + 8 * 32, P0_ITEMS_MID = 32 * 32 + 32 * 176;
static_assert(P0_ITEMS_MID == 416 * 16 && P0_ITEMS_EARLY + P0_ITEMS_MID + P0_ITEMS_WD == P0_NITEMS, "conversion item split");
__device__ __forceinline__ void p0_convert(const Params& p, LAS unsigned char* lds, int it0, int NITEMS, int gw, int NGW, int wave, int lane) {
    unsigned char* ws = p.ws;
    LAS float* scr = (LAS float*)(lds + wave * 16640);
    const int ksub = lane >> 4, n4 = (lane & 15) * 4;
    f32x4 v[16];
#define P0_LOAD(T) do { const float* sp_ = (T).src + (size_t)ksub * (T).ldw + n4; \
        _Pragma("unroll") for (int i = 0; i < 16; ++i) v[i] = __builtin_nontemporal_load((const f32x4*)(sp_ + (size_t)(4 * i) * (T).ldw)); } while (0)
    int it = it0 + gw; TItem cur;
    if (it < NITEMS) { cur = p0_item(p, ws, it); P0_LOAD(cur); }
    while (it < NITEMS) {
        if (cur.gain) {
#pragma unroll
            for (int i = 0; i < 16; ++i) v[i] = v[i] * cur.gain[4 * i + ksub];
        }
#pragma unroll
        for (int i = 0; i < 16; ++i) { LAS float* d = scr + (4 * i + ksub) * 65 + n4; d[0] = v[i][0]; d[1] = v[i][1]; d[2] = v[i][2]; d[3] = v[i][3]; }
        const int itn = it + NGW; TItem nxt = cur;
        if (itn < NITEMS) { nxt = p0_item(p, ws, itn); P0_LOAD(nxt); }
        asm volatile("s_waitcnt lgkmcnt(0)" ::: "memory");
        const int c = lane & 7;
#pragma unroll
        for (int j = 0; j < 8; ++j) { const int n = (lane >> 3) + 8 * j; const LAS float* s = scr + (8 * c) * 65 + n;
            u32x4 o; o.x = cvt_pk_bf16(s[0 * 65], s[1 * 65]); o.y = cvt_pk_bf16(s[2 * 65], s[3 * 65]); o.z = cvt_pk_bf16(s[4 * 65], s[5 * 65]); o.w = cvt_pk_bf16(s[6 * 65], s[7 * 65]);
            *(u32x4*)(cur.dst + (size_t)n * cur.K + 8 * c) = o; }
        asm volatile("s_waitcnt lgkmcnt(0)" ::: "memory");
        it = itn; cur = nxt;
    }
#undef P0_LOAD
}
__device__ __forceinline__ void phase0(const Params& p, LAS unsigned char* lds, int gw, int NGW, int wave, int lane) {
    unsigned char* ws = p.ws;
    p0_convert(p, lds, 0, P0_ITEMS_EARLY, gw, NGW, wave, lane);
    const float* x = p.in[0]; const float* g = p.in[1]; bf16_t* hb = (bf16_t*)(ws + WS_HB);
    f32x4 v[8], vn[8];
    if (gw < M) {
#pragma unroll
        for (int j = 0; j < 8; ++j) vn[j] = __builtin_nontemporal_load((const f32x4*)(x + (size_t)gw * DM) + lane + 64 * j);
    }
    for (int m = gw; m < M; m += NGW) {
        float s = 0.f;
#pragma unroll
        for (int j = 0; j < 8; ++j) { v[j] = vn[j]; s += (v[j][0] * v[j][0] + v[j][1] * v[j][1]) + (v[j][2] * v[j][2] + v[j][3] * v[j][3]); }
        if (m + NGW < M) {
#pragma unroll
            for (int j = 0; j < 8; ++j) vn[j] = __builtin_nontemporal_load((const f32x4*)(x + (size_t)(m + NGW) * DM) + lane + 64 * j);
        }
        const float rs = 1.0f / sqrtf(wave_sum(s) * (1.0f / DM) + EPS);
        u32x2* o = (u32x2*)(hb + (size_t)m * DM) + lane;
#pragma unroll
        for (int j = 0; j < 8; ++j) { const f32x4 gv = ((const f32x4*)g)[lane + 64 * j]; u32x2 w;
            w.x = cvt_pk_bf16(v[j][0] * rs * gv[0], v[j][1] * rs * gv[1]); w.y = cvt_pk_bf16(v[j][2] * rs * gv[2], v[j][3] * rs * gv[3]); o[64 * j] = w; }
    }
}

__device__ __forceinline__ void unpack8(const u32x4& w, float (&f)[8]) {
    f[0] = bflo(w.x); f[1] = bfhi(w.x); f[2] = bflo(w.y); f[3] = bfhi(w.y); f[4] = bflo(w.z); f[5] = bfhi(w.z); f[6] = bflo(w.w); f[7] = bfhi(w.w);
}
__device__ __forceinline__ u32x4 pack8f(const float (&f)[8]) {
    u32x4 w; w.x = cvt_pk_bf16(f[0], f[1]); w.y = cvt_pk_bf16(f[2], f[3]); w.z = cvt_pk_bf16(f[4], f[5]); w.w = cvt_pk_bf16(f[6], f[7]); return w;
}
__device__ __forceinline__ void latent_norm(const bf16_t* src, const float* g, bf16_t* dst, int lane) {
    float f[8]; unpack8(*(const u32x4*)(src + lane * 8), f); float s = 0.f;
#pragma unroll
    for (int j = 0; j < 8; ++j) s += f[j] * f[j];
    const float rs = 1.0f / sqrtf(wave_sum(s) * (1.0f / 512.0f) + EPS);
#pragma unroll
    for (int j = 0; j < 8; ++j) f[j] = f[j] * rs * g[lane * 8 + j];
    *(u32x4*)(dst + lane * 8) = pack8f(f);
}
__device__ __forceinline__ void diff_row(const u32x4& raw0, const u32x4& raw1, const float (&g)[16], const float (&sn)[8], const float (&cs)[8], bf16_t* o, int sub) {
    float f[16]; { float t[8]; unpack8(raw0, t);
#pragma unroll
        for (int j = 0; j < 8; ++j) f[j] = t[j];
        unpack8(raw1, t);
#pragma unroll
        for (int j = 0; j < 8; ++j) f[8 + j] = t[j]; }
    float ss = 0.f;
#pragma unroll
    for (int j = 0; j < 16; ++j) ss += f[j] * f[j];
    ss += __shfl_xor(ss, 1); ss += __shfl_xor(ss, 2);
    const float rs = 1.0f / sqrtf(ss * (1.0f / 64.0f) + EPS);
#pragma unroll
    for (int j = 0; j < 16; ++j) f[j] = f[j] * rs * g[j];
    if (sub == 0) {
#pragma unroll
        for (int i = 0; i < 8; ++i) { const float a = f[i], bb = f[8 + i]; f[i] = a * cs[i] - bb * sn[i]; f[8 + i] = bb * cs[i] + a * sn[i]; }
    }
    { float t[8];
#pragma unroll
      for (int j = 0; j < 8; ++j) t[j] = f[j];
      *(u32x4*)o = pack8f(t);
#pragma unroll
      for (int j = 0; j < 8; ++j) t[j] = f[8 + j];
      *(u32x4*)(o + 8) = pack8f(t); }
}
__device__ __forceinline__ void kpe_gemm(unsigned char* ws, LAS unsigned char* lds, int blk0, int bstep, int bend, int tid, int wave, int lane) {
    const bf16_t* hb = (const bf16_t*)(ws + WS_HB); const bf16_t* wk = (const bf16_t*)(ws + WS_WIN) + (size_t)4096 * 2048; bf16_t* kpe = (bf16_t*)(ws + WS_KPE);
    const int r32 = lane & 31, h = lane >> 5;
    LAS float* red = (LAS float*)lds;
    for (int blk = blk0; blk < bend; blk += bstep) {
        const int m0 = blk * 32;
        const bf16_t* ap = hb + (size_t)(m0 + r32) * 2048 + wave * 256 + 8 * h;
        const bf16_t* bp = wk + (size_t)r32 * 2048 + wave * 256 + 8 * h;
        f32x16 c0, c1;
#pragma unroll
        for (int i = 0; i < 16; ++i) { c0[i] = 0.f; c1[i] = 0.f; }
#pragma unroll
        for (int ks = 0; ks < 16; ++ks) {
            const bf16x8 a = *(const bf16x8*)(ap + 16 * ks), b0 = *(const bf16x8*)(bp + 16 * ks), b1 = *(const bf16x8*)(bp + (size_t)32 * 2048 + 16 * ks);
            c0 = __builtin_amdgcn_mfma_f32_32x32x16_bf16(a, b0, c0, 0, 0, 0); c1 = __builtin_amdgcn_mfma_f32_32x32x16_bf16(a, b1, c1, 0, 0, 0);
        }
        __syncthreads();
#pragma unroll
        for (int i = 0; i < 16; ++i) { const int tok = (i & 3) + 8 * (i >> 2) + 4 * h; red[(wave * 32 + tok) * 64 + r32] = c0[i]; red[(wave * 32 + tok) * 64 + 32 + r32] = c1[i]; }
        __syncthreads();
        { const int tok = tid >> 4, n4 = (tid & 15) * 4; f32x4 sacc = {0.f, 0.f, 0.f, 0.f};
#pragma unroll
          for (int w8 = 0; w8 < 8; ++w8) sacc = sacc + *(const LAS f32x4*)(red + (w8 * 32 + tok) * 64 + n4);
          u32x2 w; w.x = cvt_pk_bf16(sacc[0], sacc[1]); w.y = cvt_pk_bf16(sacc[2], sacc[3]); *(u32x2*)(kpe + (size_t)(m0 + tok) * 64 + n4) = w; }
    }
}
__device__ __forceinline__ void p3_pre(const Params& p, LAS unsigned char* lds, int bx, int G, int tid, int wave, int lane) {
    unsigned char* ws = p.ws;
    const bf16_t* proj = (const bf16_t*)(ws + WS_PROJ); bf16_t* qd = (bf16_t*)(ws + WS_QD); bf16_t* kd = (bf16_t*)(ws + WS_KD);
    constexpr int NQU = (M / 256) * (1536 / 256);
    int row0, rstep, rend, blk0, bstep, bend;
    if (G == 256) {
        if (bx >= NQU) { row0 = (bx - NQU) * NWAVES + wave; rstep = (256 - NQU) * NWAVES; rend = 4096; blk0 = bx - NQU; bstep = 256 - NQU; bend = 128; }
        else { row0 = 4096 + bx * NWAVES + wave; rstep = NQU * NWAVES; rend = M; blk0 = 128 + bx; bstep = 256; bend = 256; }
    } else { row0 = bx * NWAVES + wave; rstep = G * NWAVES; rend = M; blk0 = bx; bstep = G; bend = 256; }
    kpe_gemm(ws, lds, blk0, bstep, bend, tid, wave, lane);
    const int sub = lane & 3, hc = lane >> 2;
    float gq[16], gk[16], frq[8];
#pragma unroll
    for (int j = 0; j < 16; ++j) { gq[j] = p.in[10][sub * 16 + j] * (0.125f * LOG2E); gk[j] = p.in[11][sub * 16 + j]; }
#pragma unroll
    for (int i = 0; i < 8; ++i) frq[i] = rope_freq(i, 16);
    for (int m = row0; m < rend; m += rstep) {
        const bf16_t* pr = proj + (size_t)m * PROJ_LD + lane * 16; const int b = m >> 11, sp = m & 2047;
        const u32x4 q0 = *(const u32x4*)(pr), q1 = *(const u32x4*)(pr + 8), k0 = *(const u32x4*)(pr + 1024), k1 = *(const u32x4*)(pr + 1032);
        float sn[8], cs[8];
#pragma unroll
        for (int i = 0; i < 8; ++i) sincos_ang((float)sp * frq[i], sn[i], cs[i]);
        const size_t off = ((size_t)((b * 16 + hc) * SEQ + sp)) * 64 + sub * 16;
        diff_row(q0, q1, gq, sn, cs, qd + off, sub);
        diff_row(k0, k1, gk, sn, cs, kd + off, sub);
    }
}

__device__ __forceinline__ void mla_row(const u32x4& n0, const u32x4& n1, const u32x4& r0, float rn, float rr, const float (&gn)[16], const float (&gr)[8], const float (&sns)[8], const float (&cs)[8], bf16_t* o, int sub) {
    float fn[16], fr[8];
    { float t[8]; unpack8(n0, t);
#pragma unroll
      for (int j = 0; j < 8; ++j) fn[j] = t[j] * rn;
      unpack8(n1, t);
#pragma unroll
      for (int j = 0; j < 8; ++j) fn[8 + j] = t[j] * rn;
      unpack8(r0, t);
#pragma unroll
      for (int j = 0; j < 8; ++j) fr[j] = t[j] * rr; }
    float ss = 0.f;
#pragma unroll
    for (int j = 0; j < 16; ++j) ss += fn[j] * fn[j];
#pragma unroll
    for (int j = 0; j < 8; ++j) ss += fr[j] * fr[j];
    ss += __shfl_xor(ss, 1); ss += __shfl_xor(ss, 2); ss += __shfl_xor(ss, 4);
    const float rs = 1.0f / sqrtf(ss * (1.0f / 192.0f) + EPS);
#pragma unroll
    for (int j = 0; j < 16; ++j) fn[j] = fn[j] * rs * gn[j];
    float ro[8];
#pragma unroll
    for (int j = 0; j < 8; ++j) { const float v = fr[j] * rs * gr[j]; const float pv = __shfl_xor(v, 4); ro[j] = v * cs[j] + pv * sns[j]; }
    { float t[8];
#pragma unroll
      for (int j = 0; j < 8; ++j) t[j] = fn[j];
      *(u32x4*)(o + sub * 16) = pack8f(t);
#pragma unroll
      for (int j = 0; j < 8; ++j) t[j] = fn[8 + j];
      *(u32x4*)(o + sub * 16 + 8) = pack8f(t); }
    *(u32x4*)(o + 128 + sub * 8) = pack8f(ro);
}
__device__ __forceinline__ void phase4(const Params& p, int gw, int NGW, int lane) {
    unsigned char* ws = p.ws;
    const bf16_t* qf = (const bf16_t*)(ws + WS_QF); const bf16_t* knope = (const bf16_t*)(ws + WS_KNOPE); const bf16_t* kpe = (const bf16_t*)(ws + WS_KPE);
    bf16_t* qm = (bf16_t*)(ws + WS_QM); bf16_t* km = (bf16_t*)(ws + WS_KM);
    const int h = lane >> 3, sub = lane & 7;
    const float qscale = LOG2E / sqrtf(192.0f), sgn = sub < 4 ? -1.0f : 1.0f;
    float gqn[16], gkn[16], gqr[8], gkr[8], frq[8];
#pragma unroll
    for (int j = 0; j < 16; ++j) { gqn[j] = p.in[7][sub * 16 + j] * qscale; gkn[j] = p.in[8][sub * 16 + j]; }
#pragma unroll
    for (int j = 0; j < 8; ++j) { gqr[j] = p.in[7][128 + sub * 8 + j] * qscale; gkr[j] = p.in[8][128 + sub * 8 + j]; frq[j] = rope_freq((sub * 8 + j) & 31, 64); }
    for (int m = gw; m < M; m += NGW) {
        const int b = m >> 11, sp = m & 2047;
        const bf16_t* q0 = qf + (size_t)m * 1536 + h * 192; const bf16_t* k0 = knope + (size_t)m * 1024 + h * 128 + sub * 16;
        const u32x4 qa = *(const u32x4*)(q0 + sub * 16), qb = *(const u32x4*)(q0 + sub * 16 + 8), qc = *(const u32x4*)(q0 + 128 + sub * 8);
        const u32x4 ka = *(const u32x4*)(k0), kb = *(const u32x4*)(k0 + 8), kc = *(const u32x4*)(kpe + (size_t)m * 64 + sub * 8);
        const float* sq = (const float*)(ws + WS_SSQL) + (size_t)m * 16; const float rq = latent_rs(sq), rkv = latent_rs(sq + 8);
        float sns[8], cs[8];
#pragma unroll
        for (int j = 0; j < 8; ++j) { float sv; sincos_ang((float)sp * frq[j], sv, cs[j]); sns[j] = sv * sgn; }
        const size_t off = ((size_t)((b * 8 + h) * SEQ + sp)) * 192;
        mla_row(qa, qb, qc, rq, rq, gqn, gqr, sns, cs, qm + off, sub);
        mla_row(ka, kb, kc, rkv, 1.0f, gkn, gkr, sns, cs, km + off, sub);
    }
}

#define MFMA32(a, b, c) __builtin_amdgcn_mfma_f32_32x32x16_bf16((a), (b), (c), 0, 0, 0)
typedef short s16x4 __attribute__((ext_vector_type(4)));
__device__ __forceinline__ float max3f(float a, float b, float c) { float r; asm("v_max3_f32 %0, %1, %2, %3" : "=v"(r) : "v"(a), "v"(b), "v"(c)); return r; }
__device__ __forceinline__ s16x4 vtr(const LAS unsigned char* p) { return __builtin_bit_cast(s16x4, __builtin_amdgcn_ds_read_tr16_b64_v4i16((LAS s16x4*)p)); }
template <int DQK>
__device__ __forceinline__ void attn_pass(f32x16 (&o)[4], const bf16_t* Qh, const bf16_t* Kh, const bf16_t* Vth, int q0, LAS unsigned char* lds, int tid, int w, int lane) {
    constexpr int KSTR = DQK * 2 + 16, VSTR = 320, NKC = (64 * DQK * 2 / 16) / NTHR, CPR = DQK / 8, KB = 64 * KSTR, VB = 64 * VSTR;
    static_assert(NKC * NTHR * 16 == 64 * DQK * 2, "K tile chunks");
    constexpr bool PIPE = false; constexpr int KA = PIPE ? 1 : 0;
    constexpr int QKB = (DQK == 64) ? 4 : 2, PVB = (DQK == 64) ? 2 : 1;
    constexpr float THR = 8.0f;
    LAS unsigned char* Ks = lds; LAS unsigned char* Vs = lds + 2 * KB;
    const int r32 = lane & 31, h = lane >> 5;
    bf16x8 qf[DQK / 16];
    { const bf16_t* qrow = Qh + (size_t)(q0 + 32 * w + r32) * DQK + 8 * h;
#pragma unroll
      for (int d0 = 0; d0 < DQK / 16; ++d0) qf[d0] = *(const bf16x8*)(qrow + 16 * d0); }
    float m_run = -INFINITY, l_lane = 0.f;
#pragma unroll
    for (int db = 0; db < 4; ++db)
#pragma unroll
        for (int i = 0; i < 16; ++i) o[db][i] = 0.f;
    const int NT = (q0 + 256) >> 6, tmax = (q0 >> 6) + (w >> 1);
    const int qg = q0 + 32 * w + r32;
    u32x4 kreg[NKC], vreg[2];
#define ATT_LDK(R, t) do { _Pragma("unroll") for (int j = 0; j < NKC; ++j) R[j] = ((const u32x4*)(Kh + (size_t)(t) * 64 * DQK))[tid + NTHR * j]; } while (0)
#define ATT_LDV(t) do { _Pragma("unroll") for (int j = 0; j < 2; ++j) vreg[j] = ((const u32x4*)(Vth + (size_t)(t) * 64 * 128))[tid + NTHR * j]; } while (0)
#define ATT_STK(R, buf) do { _Pragma("unroll") for (int j = 0; j < NKC; ++j) { const int c = tid + NTHR * j; *(LAS u32x4*)(Ks + (buf) * KB + (c / CPR) * KSTR + (c % CPR) * 16) = R[j]; } } while (0)
#define ATT_STV(buf) do { _Pragma("unroll") for (int j = 0; j < 2; ++j) { const int c = tid + NTHR * j; *(LAS u32x4*)(Vs + (buf) * VB + (c >> 4) * VSTR + (c & 15) * 16) = vreg[j]; } } while (0)
#define ATT_QK(P0, P1, buf) do { \
        _Pragma("unroll") for (int i = 0; i < 16; ++i) { P0[i] = 0.f; P1[i] = 0.f; } \
        const LAS unsigned char* ka = Ks + (buf) * KB + r32 * KSTR + h * 16; \
        _Pragma("unroll") for (int g0 = 0; g0 < DQK / 16; g0 += QKB) {         \
            bf16x8 fa[QKB], fb[QKB]; \
            _Pragma("unroll") for (int d = 0; d < QKB; ++d) { fa[d] = *(const LAS bf16x8*)(ka + (g0 + d) * 32); fb[d] = *(const LAS bf16x8*)(ka + 32 * KSTR + (g0 + d) * 32); } \
            _Pragma("unroll") for (int d = 0; d < QKB; ++d) { P0 = MFMA32(fa[d], qf[g0 + d], P0); P1 = MFMA32(fb[d], qf[g0 + d], P1); } \
            __builtin_amdgcn_sched_group_barrier(0x100, 2 * QKB, 0); __builtin_amdgcn_sched_group_barrier(0x008, 2 * QKB, 0); } \
        asm volatile("s_nop 15\n\ts_nop 7" : "+v"(P0), "+v"(P1)); } while (0)
#define ATT_SMPV(P0, P1, t, buf) do { \
        if ((t) == tmax) { const int kb = 64 * (t) + 4 * h; \
            _Pragma("unroll") for (int i = 0; i < 16; ++i) { const int kv = kb + (i & 3) + 8 * (i >> 2); if (kv > qg) P0[i] = -INFINITY; if (kv + 32 > qg) P1[i] = -INFINITY; } } \
        float mxa = max3f(P0[0], P0[1], P1[0]), mxb = max3f(P0[2], P0[3], P1[1]); mxa = max3f(mxa, P1[2], P1[3]); \
        _Pragma("unroll") for (int i = 4; i < 16; i += 4) { mxa = max3f(mxa, P0[i], P0[i + 1]); mxb = max3f(mxb, P0[i + 2], P0[i + 3]); mxa = max3f(mxa, P1[i], P1[i + 1]); mxb = max3f(mxb, P1[i + 2], P1[i + 3]); } \
        float mx = max3f(mxa, mxb, mxb); \
        mx = max3f(mx, __shfl_xor(mx, 32), mx); \
        const bool need = mx > m_run + THR; \
        if (__builtin_amdgcn_ballot_w64(need) != 0ull) { \
            const float mnew = need ? mx : m_run, alpha = __builtin_amdgcn_exp2f(m_run - mnew); m_run = mnew; l_lane *= alpha; \
            _Pragma("unroll") for (int db = 0; db < 4; ++db) _Pragma("unroll") for (int i = 0; i < 16; ++i) o[db][i] *= alpha; } \
        float rs = 0.f; \
        _Pragma("unroll") for (int i = 0; i < 16; ++i) { P0[i] = __builtin_amdgcn_exp2f(P0[i] - m_run); P1[i] = __builtin_amdgcn_exp2f(P1[i] - m_run); rs += P0[i] + P1[i]; } \
        l_lane += rs; \
        bf16x8 pb[4]; \
        { u32x4 t0, t1, t2, t3; \
          t0.x = cvt_pk_bf16(P0[0], P0[1]); t0.y = cvt_pk_bf16(P0[2], P0[3]); t0.z = cvt_pk_bf16(P0[4], P0[5]); t0.w = cvt_pk_bf16(P0[6], P0[7]); \
          t1.x = cvt_pk_bf16(P0[8], P0[9]); t1.y = cvt_pk_bf16(P0[10], P0[11]); t1.z = cvt_pk_bf16(P0[12], P0[13]); t1.w = cvt_pk_bf16(P0[14], P0[15]); \
          t2.x = cvt_pk_bf16(P1[0], P1[1]); t2.y = cvt_pk_bf16(P1[2], P1[3]); t2.z = cvt_pk_bf16(P1[4], P1[5]); t2.w = cvt_pk_bf16(P1[6], P1[7]); \
          t3.x = cvt_pk_bf16(P1[8], P1[9]); t3.y = cvt_pk_bf16(P1[10], P1[11]); t3.z = cvt_pk_bf16(P1[12], P1[13]); t3.w = cvt_pk_bf16(P1[14], P1[15]); \
          pb[0] = __builtin_bit_cast(bf16x8, t0); pb[1] = __builtin_bit_cast(bf16x8, t1); pb[2] = __builtin_bit_cast(bf16x8, t2); pb[3] = __builtin_bit_cast(bf16x8, t3); } \
        const LAS unsigned char* va = Vs + (buf) * VB + (4 * h + ((lane & 15) >> 2)) * VSTR + ((lane >> 4) & 1) * 32 + (lane & 3) * 8; \
        _Pragma("unroll") for (int dp = 0; dp < 4; dp += PVB) { \
            s16x4 lo[PVB][4], hi[PVB][4]; \
            _Pragma("unroll") for (int d2 = 0; d2 < PVB; ++d2) _Pragma("unroll") for (int ks = 0; ks < 4; ++ks) { lo[d2][ks] = vtr(va + (dp + d2) * 64 + (ks * 16) * VSTR); hi[d2][ks] = vtr(va + (dp + d2) * 64 + (ks * 16 + 8) * VSTR); } \
            _Pragma("unroll") for (int ks = 0; ks < 4; ++ks) _Pragma("unroll") for (int d2 = 0; d2 < PVB; ++d2) { \
                const bf16x8 a = (bf16x8){lo[d2][ks][0], lo[d2][ks][1], lo[d2][ks][2], lo[d2][ks][3], hi[d2][ks][0], hi[d2][ks][1], hi[d2][ks][2], hi[d2][ks][3]}; o[dp + d2] = MFMA32(a, pb[ks], o[dp + d2]); } \
            __builtin_amdgcn_sched_group_barrier(0x100, 8 * PVB, 0); __builtin_amdgcn_sched_group_barrier(0x008, 4 * PVB, 0); } } while (0)
#define ATT_ITER(C0, C1, N0, N1, tt, B, NB) do { \
        __syncthreads(); \
        if constexpr (PIPE) { if ((tt) + 2 < NT) ATT_STK(kreg, B); } else { if ((tt) + 1 < NT) ATT_STK(kreg, NB); } \
        if ((tt) + 1 < NT) ATT_STV(NB); \
        if ((tt) + 2 + KA < NT) ATT_LDK(kreg, (tt) + 2 + KA); \
        if ((tt) + 2 < NT) ATT_LDV((tt) + 2); \
        if constexpr (PIPE) { if ((tt) + 1 <= tmax) ATT_QK(N0, N1, NB); if ((tt) <= tmax) ATT_SMPV(C0, C1, tt, B); } \
        else { if ((tt) <= tmax) { ATT_QK(C0, C1, B); ATT_SMPV(C0, C1, tt, B); } } } while (0)
    f32x16 pA0, pA1, pB0, pB1;
    if constexpr (PIPE) {
        u32x4 kreg2[NKC];
        ATT_LDK(kreg, 0); ATT_LDV(0); ATT_LDK(kreg2, 1);
        __syncthreads();
        ATT_STK(kreg, 0); ATT_STV(0); ATT_STK(kreg2, 1);
        ATT_LDK(kreg, 2); ATT_LDV(1);
        __syncthreads();
        ATT_QK(pA0, pA1, 0);
        for (int t = 0; t < NT; t += 2) {
            ATT_ITER(pA0, pA1, pB0, pB1, t, 0, 1);
            ATT_ITER(pB0, pB1, pA0, pA1, t + 1, 1, 0);
        }
    } else {
        u32x4 kreg2[NKC], vreg2[2];
        ATT_LDK(kreg, 0); ATT_LDV(0);
        ATT_LDK(kreg2, 1);
#pragma unroll
        for (int j = 0; j < 2; ++j) vreg2[j] = ((const u32x4*)(Vth + (size_t)64 * 128))[tid + NTHR * j];
        __syncthreads();
        ATT_STK(kreg, 0); ATT_STV(0);
#pragma unroll
        for (int j = 0; j < NKC; ++j) kreg[j] = kreg2[j];
#pragma unroll
        for (int j = 0; j < 2; ++j) vreg[j] = vreg2[j];
        for (int t = 0; t < NT; t += 2) {
            ATT_ITER(pA0, pA1, pA0, pA1, t, 0, 1);
            ATT_ITER(pA0, pA1, pA0, pA1, t + 1, 1, 0);
        }
    }
#undef ATT_LDK
#undef ATT_LDV
#undef ATT_STK
#undef ATT_STV
#undef ATT_QK
#undef ATT_SMPV
#undef ATT_ITER
    float l = l_lane + __shfl_xor(l_lane, 32);
    const float inv = 1.0f / l;
#pragma unroll
    for (int db = 0; db < 4; ++db)
#pragma unroll
        for (int i = 0; i < 16; ++i) o[db][i] *= inv;
}
__device__ __forceinline__ void attn_out_store(const f32x16 (&o)[4], const float* gain, float scale, bf16_t* dst_row, int h) {
    float ss = 0.f;
#pragma unroll
    for (int db = 0; db < 4; ++db)
#pragma unroll
        for (int i = 0; i < 16; ++i) ss += o[db][i] * o[db][i];
    ss += __shfl_xor(ss, 32);
    const float rn = scale / sqrtf(ss * (1.0f / 128.0f) + EPS);
#pragma unroll
    for (int db = 0; db < 4; ++db)
#pragma unroll
        for (int g4 = 0; g4 < 4; ++g4) { const int d = 32 * db + 8 * g4 + 4 * h; const f32x4 gv = *(const f32x4*)(gain + d);
            u32x2 w; w.x = cvt_pk_bf16(o[db][4 * g4] * rn * gv[0], o[db][4 * g4 + 1] * rn * gv[1]); w.y = cvt_pk_bf16(o[db][4 * g4 + 2] * rn * gv[2], o[db][4 * g4 + 3] * rn * gv[3]);
            *(u32x2*)(dst_row + d) = w; }
}
__device__ __forceinline__ void phase5(const Params& p, LAS unsigned char* lds, unsigned* ctr, int tid, int wave, int lane) {
    unsigned char* ws = p.ws;
    const bf16_t* qm = (const bf16_t*)(ws + WS_QM); const bf16_t* km = (const bf16_t*)(ws + WS_KM); const bf16_t* vtm = (const bf16_t*)(ws + WS_VTM);
    const bf16_t* qd = (const bf16_t*)(ws + WS_QD); const bf16_t* kd = (const bf16_t*)(ws + WS_KD); const bf16_t* vtd = (const bf16_t*)(ws + WS_VTD);
    bf16_t* ao = (bf16_t*)(ws + WS_AO);
    LAS unsigned* shw = (LAS unsigned*)(lds + 163824);
    float lam;
    { const float a = p.in[12][lane] * p.in[13][lane], b2 = p.in[14][lane] * p.in[15][lane];
      lam = __expf(wave_sum(a)) - __expf(wave_sum(b2)) + LAMBDA_INIT; }
    const int r32 = lane & 31, h = lane >> 5;
    for (;;) {
        __syncthreads();
        if (tid == 0) shw[0] = atomicAdd(ctr, 1u);
        __syncthreads();
        const unsigned uq = shw[0];
        if (uq >= 928u) break;
        const unsigned grp = uq / 29u, ing = uq % 29u;
        if (ing >= 16u) {
            const int cj = (int)(grp * 13u + ing - 16u);
            p0_convert(p, lds, P0_ITEMS_EARLY + 16 * cj, P0_ITEMS_EARLY + 16 * cj + 16, wave, NWAVES, wave, lane);
            continue;
        }
        const unsigned u = grp * 16u + ing;
        const int cls = (int)(u >> 5), bh = (int)(u & 31u);
        const int isdiff = (0x552B >> cls) & 1, qb = (int)((0x0011223345465767ull >> (4 * cls)) & 15ull);
        const int q0 = qb * 256, b = bh >> 3, hd = bh & 7;
        if (!isdiff) {
            f32x16 o[4];
            attn_pass<192>(o, qm + (size_t)bh * SEQ * 192, km + (size_t)bh * SEQ * 192, vtm + (size_t)bh * 128 * SEQ, q0, lds, tid, wave, lane);
            attn_out_store(o, p.in[9], 1.0f, ao + (size_t)(b * SEQ + q0 + 32 * wave + r32) * DM + hd * 128, h);
        } else {
            f32x16 o[4];
            LAS unsigned* st = (LAS unsigned*)(lds + 59392) + wave * 2048 + lane;
            attn_pass<64>(o, qd + (size_t)(bh * 2 + 1) * SEQ * 64, kd + (size_t)(bh * 2 + 1) * SEQ * 64, vtd + (size_t)bh * 128 * SEQ, q0, lds, tid, wave, lane);
#pragma unroll
            for (int db = 0; db < 4; ++db)
#pragma unroll
                for (int i = 0; i < 16; i += 2) st[(db * 8 + (i >> 1)) * 64] = cvt_pk_bf16(o[db][i], o[db][i + 1]);
            attn_pass<64>(o, qd + (size_t)(bh * 2) * SEQ * 64, kd + (size_t)(bh * 2) * SEQ * 64, vtd + (size_t)bh * 128 * SEQ, q0, lds, tid, wave, lane);
#pragma unroll
            for (int db = 0; db < 4; ++db)
#pragma unroll
                for (int i = 0; i < 16; i += 2) { const unsigned wv = st[(db * 8 + (i >> 1)) * 64]; o[db][i] -= lam * bflo(wv); o[db][i + 1] -= lam * bfhi(wv); }
            attn_out_store(o, p.in[16], 1.0f - LAMBDA_INIT, ao + (size_t)(b * SEQ + q0 + 32 * wave + r32) * DM + hd * 128 + 1024, h);
        }
    }
}

#define XB_TMO      128
#define XB_XCNT(j)  (256  + 64 * (j))
#define XB_XSUB(j)  (1280 + 64 * (j))
#define XB_XGEN(j)  (2304 + 64 * (j))
#define XB_TOP      3328
#define XB_TOPGEN   3392
#define XCD_BAR_WORDS 3456
#define XB_SPIN_CAP (1u << 18)

__device__ __forceinline__ unsigned xb_ld(unsigned* p)              { return __hip_atomic_load(p, __ATOMIC_RELAXED, __HIP_MEMORY_SCOPE_AGENT); }
__device__ __forceinline__ unsigned xb_add(unsigned* p, unsigned v) { return __hip_atomic_fetch_add(p, v, __ATOMIC_RELAXED, __HIP_MEMORY_SCOPE_AGENT); }
__device__ __forceinline__ unsigned xb_xcc_id() { return (unsigned)__builtin_amdgcn_s_getreg((3 << 11) | 20) & 0xFu; }
#define XB_SPIN(cond, bar) do { unsigned _sp = 0; while (cond) { __builtin_amdgcn_s_sleep(1); \
    if ((++_sp & 255u) == 0u) { if (xb_ld(&(bar)[XB_TMO])) break; if (_sp > XB_SPIN_CAP) { atomicAdd(&(bar)[XB_TMO], 1u); break; } } } } while (0)

struct XcdBarrier {
    unsigned* bar; unsigned x;
    volatile LAS unsigned* st;
};

__device__ __forceinline__ XcdBarrier xcd_barrier_post(unsigned* bar, volatile LAS unsigned* st) {
    XcdBarrier b; b.bar = bar; b.x = xb_xcc_id(); b.st = st;
    if (threadIdx.x == 0) (void)xb_add(&bar[XB_XCNT(b.x)], 1u);
    return b;
}
__device__ __forceinline__ void xcd_barrier_complete(unsigned* bar, unsigned x, unsigned& nloc, unsigned& nx) {
    const unsigned G = gridDim.x * gridDim.y * gridDim.z;
    unsigned sum, cnt, mine, sp = 0u;
    for (;;) {
        sum = 0u; cnt = 0u; mine = 0u;
#pragma unroll
        for (unsigned j = 0; j < 16; ++j) { const unsigned c = xb_ld(&bar[XB_XCNT(j)]); sum += c; cnt += (c > 0u) ? 1u : 0u; mine = (j == x) ? c : mine; }
        if (sum == G) break;
        __builtin_amdgcn_s_sleep(1);
        if ((++sp & 255u) == 0u) { if (xb_ld(&bar[XB_TMO])) break; if (sp > XB_SPIN_CAP) { atomicAdd(&bar[XB_TMO], 1u); break; } }
    }
    nloc = mine > 0u ? mine : 1u; nx = cnt > 0u ? cnt : 1u;
}

__device__ __forceinline__ void xcd_barrier(const XcdBarrier& b) {
    asm volatile("s_waitcnt vmcnt(0)" ::: "memory");
    __syncthreads();
    if (threadIdx.x == 0) {
        unsigned* bar = b.bar;
        __builtin_amdgcn_s_waitcnt(0);
        unsigned nloc = b.st[0], nx = b.st[1];
        if (nloc == 0u) { xcd_barrier_complete(bar, b.x, nloc, nx); b.st[0] = nloc; b.st[1] = nx; }
        const unsigned old = xb_add(&bar[XB_XSUB(b.x)], 1u);
        const unsigned gen = old / nloc;
        if (old + 1u == (gen + 1u) * nloc) {
            __builtin_amdgcn_fence(__ATOMIC_RELEASE, "agent");
            asm volatile("s_waitcnt vmcnt(0)" ::: "memory");
            const unsigned og = xb_add(&bar[XB_TOP], 1u);
            const unsigned tg = og / nx;
            if (og + 1u == (tg + 1u) * nx) xb_add(&bar[XB_TOPGEN], 1u);
            else XB_SPIN(xb_ld(&bar[XB_TOPGEN]) == tg, bar);
            __builtin_amdgcn_fence(__ATOMIC_ACQUIRE, "agent");
            xb_add(&bar[XB_XGEN(b.x)], 1u);
            asm volatile("s_waitcnt vmcnt(0)" ::: "memory");
        } else {
            XB_SPIN(xb_ld(&bar[XB_XGEN(b.x)]) == gen, bar);
            __builtin_amdgcn_fence(__ATOMIC_ACQUIRE, "agent");
            asm volatile("s_waitcnt vmcnt(0)" ::: "memory");
        }
    }
    __syncthreads();
}

__global__ void __launch_bounds__(NTHR, 2) fwd_kernel(Params p) {
    extern __shared__ __attribute__((aligned(16))) unsigned char lds_raw[];
    LAS unsigned char* lds = (LAS unsigned char*)lds_raw;
    const int tid = threadIdx.x, lane = tid & 63, wave = __builtin_amdgcn_readfirstlane(tid >> 6);
    const int G = gridDim.x, bx = blockIdx.x;
    const int gw = bx * NWAVES + wave, NGW = G * NWAVES;
    unsigned char* ws = p.ws;
    unsigned* ctl = MK_ONE_LAUNCH ? g_ctl : (unsigned*)(ws + WS_CTL);
    const int lo = p.ph_lo, hi = p.ph_hi;
    volatile LAS unsigned* bst = (volatile LAS unsigned*)(lds + 163808);
    if (tid == 0) { bst[0] = 0u; bst[1] = 0u; }
    __syncthreads();
    XcdBarrier bar; bar.bar = ctl + 1024; bar.x = 0; bar.st = bst;
    if (hi > lo) bar = xcd_barrier_post(ctl + 1024, bst);
    if (hi > 1000) cg::this_grid().sync();
#define IN(k) (lo <= (k) && (k) < hi)
#define SEAM(k) do { if (IN(k) && IN((k) + 1)) { xcd_barrier(bar); } } while (0)
    if (IN(0)) { if (bx == 0 && tid == 0) { ctl[0] = 0u; ctl[64] = 0u; }
        phase0(p, lds, gw, NGW, wave, lane); }
    SEAM(0);
    if (IN(1)) {
        pg8::Gemm g{(const bf16_t*)(ws + WS_HB), (const bf16_t*)(ws + WS_WIN), M, NPROJ, 2048}; pg8::StaticOrder S; S.init(M, NPROJ, G, bx);
        EpiProj E{(bf16_t*)(ws + WS_QLAT), (bf16_t*)(ws + WS_KVLAT), (float*)(ws + WS_SSQL), (bf16_t*)(ws + WS_PROJ), (bf16_t*)(ws + WS_VTD)};
        pg8::gemm_phase<EpiProj, pg8::StaticOrder, true, true>(lds, g, S, E);
    }
    SEAM(1);
    if (IN(3)) {
        p3_pre(p, lds, bx, G, tid, wave, lane);
        __syncthreads();
        { pg8::Gemm g{(const bf16_t*)(ws + WS_QLAT), (const bf16_t*)(ws + WS_WQ), 2 * M, 3584, 512}; StackedOrder S{G, bx};
          EpiQKv E{EpiPlain{(bf16_t*)(ws + WS_QF), 1536}, EpiKv{(bf16_t*)(ws + WS_KNOPE), (bf16_t*)(ws + WS_VTM), (const float*)(ws + WS_SSQL)}};
          pg8::gemm_phase<EpiQKv, StackedOrder, true, true>(lds, g, S, E); }
    }
    SEAM(3);
    if (IN(4)) phase4(p, gw, NGW, lane);
    SEAM(4);
    if (IN(5)) phase5(p, lds, ctl, tid, wave, lane);
    SEAM(5);
    if (IN(6)) {
        pg8::Gemm g{(const bf16_t*)(ws + WS_AO), (const bf16_t*)(ws + WS_WO), M, DM, 2048}; pg8::StaticOrder S; S.init(M, DM, G, bx);
        EpiWo E{p.in[0], p.out, (bf16_t*)(ws + WS_X1B), (float*)(ws + WS_SSQ)};
        pg8::gemm_phase<EpiWo, pg8::StaticOrder, true, true>(lds, g, S, E);
    }
    SEAM(6);
    if (IN(7)) {
        pg8::Gemm g{(const bf16_t*)(ws + WS_X1B), (const bf16_t*)(ws + WS_WGU), M, 2 * DFF, 2048}; pg8::StaticOrder S; S.init(M, 2 * DFF, G, bx);
        EpiGateUp E{(const float*)(ws + WS_SSQ), (bf16_t*)(ws + WS_HMID)};
        pg8::gemm_phase<EpiGateUp, pg8::StaticOrder, true, true>(lds, g, S, E);
        { const int nwg = (M / 256) * (2 * DFF / 256), rem = nwg % G;
          if (rem == 0) p0_convert(p, lds, P0_NITEMS - P0_ITEMS_WD, P0_NITEMS, gw, NGW, wave, lane);
          else if (bx >= rem) p0_convert(p, lds, P0_NITEMS - P0_ITEMS_WD, P0_NITEMS, (bx - rem) * NWAVES + wave, (G - rem) * NWAVES, wave, lane); }
    }
    SEAM(7);
    if (IN(8)) {
        pg8::Gemm g{(const bf16_t*)(ws + WS_HMID), (const bf16_t*)(ws + WS_WD), M, DM, DFF}; pg8::StaticOrder S; S.init(M, DM, G, bx);
        EpiDown E{(const bf16_t*)(ws + WS_X1B), p.out};
        pg8::gemm_phase<EpiDown, pg8::StaticOrder, true, true>(lds, g, S, E);
    }
#if MK_ONE_LAUNCH
    if (hi > lo) {
        LAS unsigned* shx = (LAS unsigned*)(lds + 163828);
        __syncthreads();
        if (tid == 0) { __threadfence(); shx[0] = (atomicAdd(&ctl[128], 1u) == (unsigned)(G - 1)) ? 1u : 0u; }
        __syncthreads();
        if (shx[0]) { for (int i = tid; i < 8192; i += NTHR) __hip_atomic_store(&ctl[i], 0u, __ATOMIC_RELAXED, __HIP_MEMORY_SCOPE_AGENT); }
    }
#endif
#undef IN
#undef SEAM
}
}

extern "C" void kernel_launch(void* const* d_in, const int* in_sizes, int n_in, void* d_out, int out_size, void* d_ws, size_t ws_size, hipStream_t stream) {
    static int grid = 0;
    if (grid == 0) {
        if (n_in != 22 || out_size != mk::M * mk::DM || ws_size < mk::WS_END) { fprintf(stderr, "kernel_launch: unexpected shapes (n_in %d out %d ws %zu)\n", n_in, out_size, ws_size); grid = -1; return; }
        int dev = 0, cus = 0, per_cu = 0;
        if (hipGetDevice(&dev) != hipSuccess || hipDeviceGetAttribute(&cus, hipDeviceAttributeMultiprocessorCount, dev) != hipSuccess) { grid = -1; return; }
        if (hipFuncSetAttribute((const void*)mk::fwd_kernel, hipFuncAttributeMaxDynamicSharedMemorySize, mk::LDS_BYTES) != hipSuccess) { fprintf(stderr, "kernel_launch: hipFuncSetAttribute failed\n"); grid = -1; return; }
        if (hipOccupancyMaxActiveBlocksPerMultiprocessor(&per_cu, (const void*)mk::fwd_kernel, mk::NTHR, mk::LDS_BYTES) != hipSuccess || per_cu < 1) { fprintf(stderr, "kernel_launch: occupancy query says %d\n", per_cu); per_cu = 1; }
        (void)hipGetLastError();
        grid = cus * per_cu;
    }
    if (grid < 0) return;
#if !MK_ONE_LAUNCH
    if (hipMemsetAsync((char*)d_ws + mk::WS_CTL, 0, 32768, stream) != hipSuccess) { fprintf(stderr, "kernel_launch: hipMemsetAsync failed\n"); return; }
#endif
    mk::Params p{};
    for (int i = 0; i < 22; ++i) p.in[i] = (const float*)d_in[i];
    p.out = (float*)d_out; p.ws = (unsigned char*)d_ws;
#if MK_ONE_LAUNCH
    p.ph_lo = 0; p.ph_hi = 9;
    void* args[] = {&p};
    hipError_t e = hipLaunchCooperativeKernel((const void*)mk::fwd_kernel, dim3(grid), dim3(mk::NTHR), args, mk::LDS_BYTES, stream);
    if (e != hipSuccess) fprintf(stderr, "cooperative launch failed: %s (grid %d)\n", hipGetErrorString(e), grid);
#else
    for (int k = 0; k < 9; ++k) { p.ph_lo = k; p.ph_hi = k + 1; hipLaunchKernelGGL(mk::fwd_kernel, dim3(grid), dim3(mk::NTHR), mk::LDS_BYTES, stream, p); }
#endif
}
```

```cpp
#include <hip/hip_runtime.h>
#include <hip/hip_cooperative_groups.h>
#include <cstdio>
#include <cstdint>
namespace cg = cooperative_groups;
namespace pg8 {
#define PG8_LAS __attribute__((address_space(3)))
typedef unsigned short bf16_t;
typedef short bf16x8 __attribute__((ext_vector_type(8)));
typedef float f32x4 __attribute__((ext_vector_type(4)));
typedef unsigned u32x4 __attribute__((ext_vector_type(4)));
constexpr int BM = 256, BK = 64, HALF = 128, HTB = HALF * BK * 2  , STAGE_BYTES = 8 * HTB, NXCD = 8, WGM = 2;

__host__ __device__ __forceinline__ int lds_byte(int r, int c) { const int st = (r >> 4) * 2 + (c >> 5), rr = r & 15, cc = c & 31, ob = rr * 64 + cc * 2; return st * 1024 + (ob ^ (((ob >> 9) & 1) << 5)); }
__host__ __device__ __forceinline__ void stage_rc(int b, int& R, int& C) { const int st = b / 1024, sb = b % 1024, swz = sb ^ (((sb >> 9) & 1) << 5); R = (st >> 1) * 16 + swz / 64; C = (st & 1) * 32 + (swz % 64) / 2; }
__host__ __device__ __forceinline__ int perm32(int rho) { const int n = rho >> 4, i = rho & 15; return 8 * (i >> 2) + 4 * n + (i & 3); }

struct Unit { int pm, pn; };
struct Gemm { const bf16_t* A; const bf16_t* Bt; int M, N, K; };

struct StaticOrder {
    int nM, nN, nwg, G, c;
    __host__ __device__ void init(int M, int N, int G_, int c_) { nM = M / BM; nN = N / BM; nwg = nM * nN; G = G_; c = c_; }
    __host__ __device__ bool next(int i, Unit& u) const {
        const long L = (long)i * G + c; if (L >= nwg) return false;
        int wgid = (int)L; { const int q = nwg / NXCD, r = nwg % NXCD, xcd = wgid % NXCD, off = wgid / NXCD; wgid = (xcd < r ? xcd * (q + 1) : r * (q + 1) + (xcd - r) * q) + off; }
        const int nig = WGM * nN, gid = wgid / nig, fm = gid * WGM, gsz = (nM - fm) < WGM ? (nM - fm) : WGM;
        u.pm = fm + ((wgid % nig) % gsz); u.pn = (wgid % nig) / gsz; return true;
    }
    __device__ __forceinline__ void a_ready(const Unit&) const {}
    __device__ __forceinline__ void done(const Unit&) const {}
};

__device__ __forceinline__ unsigned cvt_pk_bf16(float lo, float hi) { unsigned r; asm volatile("v_cvt_pk_bf16_f32 %0, %1, %2" : "=v"(r) : "v"(lo), "v"(hi)); return r; }
typedef float f32x2 __attribute__((ext_vector_type(2)));
template <class Epi, class Sched, bool ALIGN_EPI = false, bool SP2 = false>
__device__ __forceinline__ void gemm_phase(PG8_LAS unsigned char* lds, const Gemm g, const Sched& S, const Epi& E) {
    const int tid = threadIdx.x, wid = __builtin_amdgcn_readfirstlane(tid >> 6), lane = tid & 63, wr = wid >> 2, wc = wid & 3, fr = lane & 15, fq = lane >> 4;
    const int K = g.K, nt = K / BK;
    unsigned voffA[2], voffB[2];
#pragma unroll
    for (int i = 0; i < 2; ++i) { int R, C; stage_rc(tid * 16 + i * 8192, R, C); const int Rb = Epi::PERM ? ((R & ~31) + perm32(R & 31)) : R;
        voffA[i] = (unsigned)(R * K + C) * 2u; voffB[i] = (unsigned)(Rb * K + C) * 2u; }
    const size_t kstep = (size_t)(BK * 2);
    const size_t hstep = (size_t)HALF * K * 2;
    const size_t tstep = 2 * hstep;
    const unsigned ldsw = (unsigned)wid * 1024u;
    const int aoff = lds_byte(wr * 64 + fr, fq * 8), boff = lds_byte(wc * 32 + fr, fq * 8);
#define PG8_SA(b, h) (((b) * 2 + (h)) * HTB)
#define PG8_SB(b, h) ((4 + (b) * 2 + (h)) * HTB)
#define PG8_STAGE(bufoff, gbase, voff) do { _Pragma("unroll") for (int _i = 0; _i < 2; ++_i) \
        __builtin_amdgcn_global_load_lds((const unsigned*)((const char*)(gbase) + (voff)[_i]), (PG8_LAS unsigned*)(lds + (bufoff) + ldsw + _i * 8192), 16, 0, 0); } while (0)
#define PG8_LDA(dst, b, h) do { _Pragma("unroll") for (int m = 0; m < 4; ++m) _Pragma("unroll") for (int k = 0; k < 2; ++k) dst[m][k] = *(const PG8_LAS bf16x8*)(lds + PG8_SA(b, h) + aoff + m * 2048 + k * 1024); } while (0)
#define PG8_LDB(dst, b, h) do { _Pragma("unroll") for (int n = 0; n < 2; ++n) _Pragma("unroll") for (int k = 0; k < 2; ++k) dst[n][k] = *(const PG8_LAS bf16x8*)(lds + PG8_SB(b, h) + boff + n * 2048 + k * 1024); } while (0)
#define PG8_MMA(ai, bj, At, Bt) do { __builtin_amdgcn_s_setprio(1); _Pragma("unroll") for (int m = 0; m < 4; ++m) _Pragma("unroll") for (int n = 0; n < 2; ++n) _Pragma("unroll") for (int k = 0; k < 2; ++k) \
        acc[ai][bj][m][n] = __builtin_amdgcn_mfma_f32_16x16x32_bf16(Bt[n][k], At[m][k], acc[ai][bj][m][n], 0, 0, 0); __builtin_amdgcn_s_setprio(0); } while (0)
#define PG8_WAIT_V(n) asm volatile("s_waitcnt vmcnt(" #n ")" ::: "memory")
#define PG8_WAIT_L(n) asm volatile("s_waitcnt lgkmcnt(" #n ")" ::: "memory")
#define PG8_BAR __builtin_amdgcn_s_barrier()
#define PG8_SCHED __builtin_amdgcn_sched_barrier(0)
    Unit cur, nxt; int ui = 0;
    if (!S.next(0, cur)) return;
    f32x4 acc[2][2][4][2];
#pragma unroll
    for (int a = 0; a < 2; ++a)
#pragma unroll
        for (int b = 0; b < 2; ++b)
#pragma unroll
            for (int m = 0; m < 4; ++m)
#pragma unroll
                for (int n = 0; n < 2; ++n) acc[a][b][m][n] = (f32x4){0.f, 0.f, 0.f, 0.f};
    bf16x8 At[4][2], B0[2][2], B1[2][2];
    const char* cA = (const char*)g.A + (size_t)cur.pm * tstep; const char* cB = (const char*)g.Bt + (size_t)cur.pn * tstep;
    S.a_ready(cur);
    if constexpr (SP2) {
        PG8_STAGE(PG8_SB(0, 0), cB, voffB); PG8_STAGE(PG8_SB(0, 1), cB + hstep, voffB); PG8_STAGE(PG8_SA(0, 0), cA, voffA); PG8_STAGE(PG8_SA(0, 1), cA + hstep, voffA);
        if (wr == 1) PG8_BAR;
        PG8_WAIT_V(2); PG8_BAR;
        PG8_STAGE(PG8_SB(1, 0), cB + kstep, voffB); PG8_STAGE(PG8_SA(1, 0), cA + kstep, voffA); PG8_STAGE(PG8_SB(1, 1), cB + hstep + kstep, voffB);
        PG8_WAIT_V(6); PG8_BAR;
    } else {
        PG8_STAGE(PG8_SB(0, 0), cB, voffB); PG8_STAGE(PG8_SA(0, 0), cA, voffA); PG8_STAGE(PG8_SB(0, 1), cB + hstep, voffB); PG8_STAGE(PG8_SA(0, 1), cA + hstep, voffA);
        if (wr == 1) PG8_BAR;
        PG8_WAIT_V(4); PG8_BAR;
        PG8_STAGE(PG8_SB(1, 0), cB + kstep, voffB); PG8_STAGE(PG8_SA(1, 0), cA + kstep, voffA); PG8_STAGE(PG8_SB(1, 1), cB + hstep + kstep, voffB);
        PG8_WAIT_V(6); PG8_BAR;
    }
    for (;;) {
        const bool has_next = S.next(ui + 1, nxt);
        const char* nA = has_next ? (const char*)g.A + (size_t)nxt.pm * tstep : cA; const char* nB = has_next ? (const char*)g.Bt + (size_t)nxt.pn * tstep : cB;
        for (int t = 0; t < nt; t += 2) {
            const bool last = (t == nt - 2);
            const char* a1 = cA + (size_t)(t + 1) * kstep;
            const char* a2 = last ? nA : cA + (size_t)(t + 2) * kstep; const char* b2 = last ? nB : cB + (size_t)(t + 2) * kstep;
            const char* a3 = a2 + kstep; const char* b3 = b2 + kstep;
            if (last && has_next) S.a_ready(nxt);
            if constexpr (SP2) {
            PG8_LDB(B0, 0, 0); PG8_LDB(B1, 0, 1); PG8_SCHED; PG8_LDA(At, 0, 0); PG8_STAGE(PG8_SA(1, 1), a1 + hstep, voffA);
            PG8_WAIT_V(8); PG8_WAIT_L(0); PG8_BAR; PG8_MMA(0, 0, At, B0); PG8_MMA(0, 1, At, B1); PG8_BAR; PG8_SCHED;
            PG8_LDA(At, 0, 1); PG8_STAGE(PG8_SB(0, 0), b2, voffB); PG8_STAGE(PG8_SB(0, 1), b2 + hstep, voffB); PG8_STAGE(PG8_SA(0, 0), a2, voffA);
            PG8_WAIT_V(8); PG8_WAIT_L(0); PG8_BAR; PG8_MMA(1, 0, At, B0); PG8_MMA(1, 1, At, B1); PG8_BAR; PG8_SCHED;
            PG8_LDB(B0, 1, 0); PG8_LDB(B1, 1, 1); PG8_SCHED; PG8_LDA(At, 1, 0); PG8_STAGE(PG8_SA(0, 1), a2 + hstep, voffA);
            PG8_WAIT_V(8); PG8_WAIT_L(0); PG8_BAR; PG8_MMA(0, 0, At, B0); PG8_MMA(0, 1, At, B1); PG8_BAR; PG8_SCHED;
            PG8_LDA(At, 1, 1); PG8_STAGE(PG8_SB(1, 0), b3, voffB); PG8_STAGE(PG8_SB(1, 1), b3 + hstep, voffB); PG8_STAGE(PG8_SA(1, 0), a3, voffA);
            PG8_WAIT_V(8); PG8_WAIT_L(0); PG8_BAR; PG8_MMA(1, 0, At, B0); PG8_MMA(1, 1, At, B1); PG8_BAR; PG8_SCHED;
            } else {
            PG8_LDB(B0, 0, 0); PG8_SCHED; PG8_LDA(At, 0, 0); PG8_STAGE(PG8_SA(1, 1), a1 + hstep, voffA);
            PG8_WAIT_L(8); PG8_BAR; PG8_WAIT_L(0); PG8_MMA(0, 0, At, B0); PG8_BAR; PG8_SCHED;
            PG8_LDB(B1, 0, 1); PG8_STAGE(PG8_SB(0, 0), b2, voffB);
            PG8_BAR; PG8_WAIT_L(0); PG8_MMA(0, 1, At, B1); PG8_BAR;
            PG8_LDA(At, 0, 1); PG8_STAGE(PG8_SA(0, 0), a2, voffA);
            PG8_BAR; PG8_WAIT_L(0); PG8_MMA(1, 0, At, B0); PG8_BAR; PG8_SCHED;
            PG8_STAGE(PG8_SB(0, 1), b2 + hstep, voffB);
            PG8_WAIT_V(6); PG8_BAR; PG8_MMA(1, 1, At, B1); PG8_BAR;
            PG8_LDB(B0, 1, 0); PG8_SCHED; PG8_LDA(At, 1, 0); PG8_STAGE(PG8_SA(0, 1), a2 + hstep, voffA);
            PG8_WAIT_L(8); PG8_BAR; PG8_WAIT_L(0); PG8_MMA(0, 0, At, B0); PG8_BAR; PG8_SCHED;
            PG8_LDB(B1, 1, 1); PG8_STAGE(PG8_SB(1, 0), b3, voffB);
            PG8_BAR; PG8_WAIT_L(0); PG8_MMA(0, 1, At, B1); PG8_BAR;
            PG8_LDA(At, 1, 1); PG8_STAGE(PG8_SA(1, 0), a3, voffA);
            PG8_BAR; PG8_WAIT_L(0); PG8_MMA(1, 0, At, B0); PG8_BAR; PG8_SCHED;
            PG8_STAGE(PG8_SB(1, 1), b3 + hstep, voffB);
            PG8_WAIT_V(6); PG8_BAR; PG8_MMA(1, 1, At, B1); PG8_BAR;
            }
        }
        if constexpr (ALIGN_EPI) { if (wr == 0) PG8_BAR; }
        if constexpr (!Epi::AFTER_DRAIN) { E(acc, cur, wr, wc, fr, fq); S.done(cur); }
        if (!has_next) break;
#pragma unroll
        for (int a = 0; a < 2; ++a)
#pragma unroll
            for (int b = 0; b < 2; ++b)
#pragma unroll
                for (int m = 0; m < 4; ++m)
#pragma unroll
                    for (int n = 0; n < 2; ++n) acc[a][b][m][n] = (f32x4){0.f, 0.f, 0.f, 0.f};
        cur = nxt; cA = nA; cB = nB; ++ui;
        if constexpr (ALIGN_EPI) { if (wr == 1) PG8_BAR; }
    }
    PG8_WAIT_V(0);
    if constexpr (!ALIGN_EPI) { if (wr == 0) PG8_BAR; }
    PG8_BAR;
    if constexpr (Epi::AFTER_DRAIN) { E.fused(acc, cur, wr, wc, fr, fq, lds, wid, lane); S.done(cur); }
#undef PG8_SA
#undef PG8_SB
#undef PG8_STAGE
#undef PG8_LDA
#undef PG8_LDB
#undef PG8_MMA
#undef PG8_WAIT_V
#undef PG8_WAIT_L
#undef PG8_BAR
#undef PG8_SCHED
}
}

#ifndef MK_ONE_LAUNCH
#define MK_ONE_LAUNCH 1
#endif

namespace mk {
#define LAS __attribute__((address_space(3)))
typedef unsigned short bf16_t;
typedef short bf16x8 __attribute__((ext_vector_type(8)));
typedef float f32x4 __attribute__((ext_vector_type(4)));
typedef float f32x16 __attribute__((ext_vector_type(16)));
typedef unsigned u32x4 __attribute__((ext_vector_type(4)));
typedef unsigned u32x2 __attribute__((ext_vector_type(2)));
using pg8::Unit;
using pg8::cvt_pk_bf16;

constexpr int NWAVES = 8, NTHR = 512;
constexpr int M = 8192, DM = 2048, SEQ = 2048;
constexpr int NPROJ = 4096, PROJ_LD = 2048, DFF = 5632;
constexpr float EPS = 1e-6f;
constexpr float LOG2E = 1.4426950408889634f;
constexpr float LOG2_THETA = 18.931568569324174f;
constexpr float LAMBDA_INIT = 0.2f;

constexpr size_t MiB = 1u << 20;
constexpr size_t WS_CTL = 0;
constexpr size_t WS_WIN = 1 * MiB, WS_WQ = 18 * MiB, WS_WKV = 18 * MiB + 1536 * 1024, WS_WO = 22 * MiB, WS_WGU = 30 * MiB, WS_WD = 74 * MiB;
constexpr size_t WS_VTM = 1 * MiB;
constexpr size_t WS_VTD = 74 * MiB;
constexpr size_t WS_HB = 96 * MiB, WS_PROJ = 128 * MiB, WS_QLAT = 160 * MiB, WS_KVLAT = 168 * MiB, WS_SSQL = 176 * MiB, WS_KPE = 177 * MiB;
constexpr size_t WS_QF = 178 * MiB, WS_KNOPE = 202 * MiB, WS_QD = 218 * MiB, WS_KD = 234 * MiB;
constexpr size_t WS_QM = 96 * MiB, WS_KM = 120 * MiB, WS_AO = 144 * MiB, WS_X1B = 96 * MiB, WS_SSQ = 128 * MiB, WS_HMID = 130 * MiB;
constexpr size_t WS_END = 256 * MiB;
constexpr int LDS_BYTES = 163840;

__device__ unsigned g_ctl[8192];
struct Params { const float* in[22]; float* out; unsigned char* ws; int ph_lo, ph_hi; };

__device__ __forceinline__ float bf2f(unsigned short b) { return __uint_as_float((unsigned)b << 16); }
__device__ __forceinline__ float bflo(unsigned w) { return __uint_as_float(w << 16); }
__device__ __forceinline__ float bfhi(unsigned w) { return __uint_as_float(w & 0xffff0000u); }
__device__ __forceinline__ float wave_sum(float v) {
#pragma unroll
    for (int o = 1; o < 64; o <<= 1) v += __shfl_xor(v, o);
    return v;
}
__device__ __forceinline__ int perm16(int s) { return (s & 3) | ((s & 4) << 1) | ((s & 8) >> 1); }
__device__ __forceinline__ void sincos_ang(float ang, float& s, float& c) {
    double rev = (double)ang * 0.15915494309189535;
    rev -= __builtin_rint(rev);
    const float fr = (float)rev;
    s = __builtin_amdgcn_sinf(fr); c = __builtin_amdgcn_cosf(fr);
}
__device__ __forceinline__ float rope_freq(int i, int r) { return exp2f(-(float)(2 * i) / (float)r * LOG2_THETA); }

__device__ __forceinline__ u32x4 pack8(const f32x4& a, const f32x4& b) {
    u32x4 w; w.x = cvt_pk_bf16(a[0], a[1]); w.y = cvt_pk_bf16(a[2], a[3]); w.z = cvt_pk_bf16(b[0], b[1]); w.w = cvt_pk_bf16(b[2], b[3]); return w;
}
__device__ __forceinline__ bf16_t f2bf1(float v) { return (bf16_t)(cvt_pk_bf16(v, v) & 0xffffu); }

__device__ __forceinline__ void store_v(bf16_t* v, int bh, int d0, int r, const f32x4& a, const f32x4& b) {
    *(u32x4*)(v + ((size_t)bh * 2048 + (r & 2047)) * 128 + d0) = pack8(a, b);
}

struct EpiProj {
    static constexpr bool PERM = true, AFTER_DRAIN = false;
    bf16_t* qlat; bf16_t* kvlat; float* ssql; bf16_t* proj; bf16_t* vtd;
    __device__ __forceinline__ void operator()(const f32x4 (&acc)[2][2][4][2], const Unit& u, int wr, int wc, int fr, int fq) const {
        const int row0 = u.pm * 256 + wr * 64 + fr;
        if (u.pn < 4) {
            bf16_t* dst = (u.pn < 2) ? qlat : kvlat; const int t2 = u.pn & 1, lat = u.pn >> 1, col0 = t2 * 256 + wc * 32 + 8 * fq;
#pragma unroll
            for (int ai = 0; ai < 2; ++ai)
#pragma unroll
                for (int m = 0; m < 4; ++m) { const int r = row0 + ai * 128 + m * 16; bf16_t* rowp = dst + (size_t)r * 512 + col0; float sq = 0.f;
#pragma unroll
                    for (int bj = 0; bj < 2; ++bj) { const f32x4 v0 = acc[ai][bj][m][0], v1 = acc[ai][bj][m][1]; *(u32x4*)(rowp + bj * 128) = pack8(v0, v1);
                        sq += (v0[0] * v0[0] + v0[1] * v0[1]) + (v0[2] * v0[2] + v0[3] * v0[3]) + (v1[0] * v1[0] + v1[1] * v1[1]) + (v1[2] * v1[2] + v1[3] * v1[3]); }
                    sq += __shfl_xor(sq, 16); sq += __shfl_xor(sq, 32);
                    if (fq == 0) ssql[(size_t)r * 16 + lat * 8 + t2 * 4 + wc] = sq; }
        } else if (u.pn < 12) {
            const int col0 = (u.pn - 4) * 256 + wc * 32 + 8 * fq;
#pragma unroll
            for (int ai = 0; ai < 2; ++ai)
#pragma unroll
                for (int m = 0; m < 4; ++m) { bf16_t* rowp = proj + (size_t)(row0 + ai * 128 + m * 16) * PROJ_LD + col0;
#pragma unroll
                    for (int bj = 0; bj < 2; ++bj) *(u32x4*)(rowp + bj * 128) = pack8(acc[ai][bj][m][0], acc[ai][bj][m][1]); }
        } else {
#pragma unroll
            for (int ai = 0; ai < 2; ++ai)
#pragma unroll
                for (int m = 0; m < 4; ++m) { const int r = row0 + ai * 128 + m * 16; const int b = r >> 11;
#pragma unroll
                    for (int bj = 0; bj < 2; ++bj) store_v(vtd, b * 8 + 2 * (u.pn - 12) + bj, wc * 32 + 8 * fq, r, acc[ai][bj][m][0], acc[ai][bj][m][1]); }
        }
    }
};
__device__ __forceinline__ float latent_rs(const float* ssql_row8) {
    const f32x4 a = *(const f32x4*)ssql_row8, b = *(const f32x4*)(ssql_row8 + 4);
    return 1.0f / sqrtf((((a[0] + a[1]) + (a[2] + a[3])) + ((b[0] + b[1]) + (b[2] + b[3]))) * (1.0f / 512.0f) + EPS);
}
struct EpiPlain {
    static constexpr bool PERM = true, AFTER_DRAIN = false;
    bf16_t* O; int ldc;
    __device__ __forceinline__ void operator()(const f32x4 (&acc)[2][2][4][2], const Unit& u, int wr, int wc, int fr, int fq) const {
        const int row0 = u.pm * 256 + wr * 64 + fr, col0 = u.pn * 256 + wc * 32 + 8 * fq;
#pragma unroll
        for (int ai = 0; ai < 2; ++ai)
#pragma unroll
            for (int m = 0; m < 4; ++m) { bf16_t* rowp = O + (size_t)(row0 + ai * 128 + m * 16) * ldc + col0;
#pragma unroll
                for (int bj = 0; bj < 2; ++bj) *(u32x4*)(rowp + bj * 128) = pack8(acc[ai][bj][m][0], acc[ai][bj][m][1]); }
    }
};
struct EpiKv {
    static constexpr bool PERM = true, AFTER_DRAIN = false;
    bf16_t* knope; bf16_t* vtm; const float* ssql;
    __device__ __forceinline__ void operator()(const f32x4 (&acc)[2][2][4][2], const Unit& u, int wr, int wc, int fr, int fq) const {
        const int row0 = u.pm * 256 + wr * 64 + fr;
        f32x4 sv[8][2];
#pragma unroll
        for (int k = 0; k < 8; ++k) { const f32x4* sp = (const f32x4*)(ssql + (size_t)(row0 + (k >> 2) * 128 + (k & 3) * 16) * 16 + 8); sv[k][0] = sp[0]; sv[k][1] = sp[1]; }
#pragma unroll
        for (int ai = 0; ai < 2; ++ai)
#pragma unroll
            for (int m = 0; m < 4; ++m) { const int r = row0 + ai * 128 + m * 16; const f32x4 a = sv[ai * 4 + m][0], b = sv[ai * 4 + m][1];
                const float rs = 1.0f / sqrtf((((a[0] + a[1]) + (a[2] + a[3])) + ((b[0] + b[1]) + (b[2] + b[3]))) * (1.0f / 512.0f) + EPS);
                *(u32x4*)(knope + (size_t)r * 1024 + u.pn * 128 + wc * 32 + 8 * fq) = pack8(acc[ai][0][m][0], acc[ai][0][m][1]);
                store_v(vtm, (r >> 11) * 8 + u.pn, wc * 32 + 8 * fq, r, acc[ai][1][m][0] * rs, acc[ai][1][m][1] * rs); }
    }
};
struct EpiWo {
    static constexpr bool PERM = false, AFTER_DRAIN = false;
    const float* x; float* out; bf16_t* x1b; float* ssq;
    __device__ __forceinline__ void operator()(const f32x4 (&acc)[2][2][4][2], const Unit& u, int wr, int wc, int fr, int fq) const {
        const int row0 = u.pm * 256 + wr * 64 + fr, col0 = u.pn * 256 + wc * 32 + 4 * fq;
#pragma unroll
        for (int ai = 0; ai < 2; ++ai) {
            f32x4 xv[4][2][2];
#pragma unroll
            for (int m = 0; m < 4; ++m)
#pragma unroll
                for (int bj = 0; bj < 2; ++bj)
#pragma unroll
                    for (int n = 0; n < 2; ++n) xv[m][bj][n] = __builtin_nontemporal_load((const f32x4*)(x + (size_t)(row0 + ai * 128 + m * 16) * DM + col0 + bj * 128 + n * 16));
#pragma unroll
            for (int m = 0; m < 4; ++m) { const int r = row0 + ai * 128 + m * 16; const size_t off = (size_t)r * DM + col0; float s = 0.f;
#pragma unroll
                for (int bj = 0; bj < 2; ++bj)
#pragma unroll
                    for (int n = 0; n < 2; ++n) { const size_t o2 = off + bj * 128 + n * 16; const f32x4 v = xv[m][bj][n] + acc[ai][bj][m][n];
                        s += (v[0] * v[0] + v[1] * v[1]) + (v[2] * v[2] + v[3] * v[3]);
                        u32x2 w; w.x = cvt_pk_bf16(v[0], v[1]); w.y = cvt_pk_bf16(v[2], v[3]); *(u32x2*)(x1b + o2) = w; }
                s += __shfl_xor(s, 16); s += __shfl_xor(s, 32);
                if (fq == 0) ssq[(size_t)r * 32 + u.pn * 4 + wc] = s; }
        }
    }
};
struct EpiGateUp {
    static constexpr bool PERM = true, AFTER_DRAIN = false;
    const float* ssq; bf16_t* hmid;
    __device__ __forceinline__ void operator()(const f32x4 (&acc)[2][2][4][2], const Unit& u, int wr, int wc, int fr, int fq) const {
        const int row0 = u.pm * 256 + wr * 64 + fr, col0 = u.pn * 128 + wc * 32 + 8 * fq;
        f32x4 sv[8][2];
#pragma unroll
        for (int k = 0; k < 8; ++k) { const f32x4* sp = (const f32x4*)(ssq + (size_t)(row0 + (k >> 2) * 128 + (k & 3) * 16) * 32) + 2 * fq; sv[k][0] = sp[0]; sv[k][1] = sp[1]; }
        float r2[8];
#pragma unroll
        for (int k = 0; k < 8; ++k) { float s = ((sv[k][0][0] + sv[k][0][1]) + (sv[k][0][2] + sv[k][0][3])) + ((sv[k][1][0] + sv[k][1][1]) + (sv[k][1][2] + sv[k][1][3]));
            s += __shfl_xor(s, 16); s += __shfl_xor(s, 32); r2[k] = 1.0f / sqrtf(s * (1.0f / DM) + EPS); }
#pragma unroll
        for (int ai = 0; ai < 2; ++ai)
#pragma unroll
            for (int m = 0; m < 4; ++m) { const int r = row0 + ai * 128 + m * 16; const float rr = r2[ai * 4 + m];
                f32x4 hv[2];
#pragma unroll
                for (int n = 0; n < 2; ++n)
#pragma unroll
                    for (int e = 0; e < 4; ++e) { const float g = acc[ai][0][m][n][e] * rr, up = acc[ai][1][m][n][e] * rr;
                        const float sg = g * __builtin_amdgcn_rcpf(1.0f + __builtin_amdgcn_exp2f(-g * LOG2E)); hv[n][e] = sg * up; }
                __builtin_nontemporal_store(pack8(hv[0], hv[1]), (u32x4*)(hmid + (size_t)r * DFF + col0)); }
    }
};
struct EpiDown {
    static constexpr bool PERM = false, AFTER_DRAIN = false;
    const bf16_t* x1b; float* out;
    __device__ __forceinline__ void operator()(const f32x4 (&acc)[2][2][4][2], const Unit& u, int wr, int wc, int fr, int fq) const {
        const int row0 = u.pm * 256 + wr * 64 + fr, col0 = u.pn * 256 + wc * 32 + 4 * fq;
#pragma unroll
        for (int ai = 0; ai < 2; ++ai) {
            u32x2 xv[4][2][2];
#pragma unroll
            for (int m = 0; m < 4; ++m)
#pragma unroll
                for (int bj = 0; bj < 2; ++bj)
#pragma unroll
                    for (int n = 0; n < 2; ++n) xv[m][bj][n] = *(const u32x2*)(x1b + (size_t)(row0 + ai * 128 + m * 16) * DM + col0 + bj * 128 + n * 16);
#pragma unroll
            for (int m = 0; m < 4; ++m)
#pragma unroll
                for (int bj = 0; bj < 2; ++bj)
#pragma unroll
                    for (int n = 0; n < 2; ++n) { const u32x2 w = xv[m][bj][n]; const f32x4 r = {bflo(w.x), bfhi(w.x), bflo(w.y), bfhi(w.y)};
                        __builtin_nontemporal_store(r + acc[ai][bj][m][n], (f32x4*)(out + (size_t)(row0 + ai * 128 + m * 16) * DM + col0 + bj * 128 + n * 16)); }
        }
    }
};

struct StackedOrder {
    int G, c;
    __device__ __forceinline__ bool next(int i, Unit& u) const {
        const long L = (long)i * G + c; if (L >= 448) return false;
        pg8::StaticOrder t; t.G = 1; t.c = 0;
        if (L < 256) { t.nM = 32; t.nN = 8; t.nwg = 256; t.next((int)L, u); u.pm += 32; u.pn += 6; }
        else { t.nM = 32; t.nN = 6; t.nwg = 192; t.next((int)L - 256, u); }
        return true;
    }
    __device__ __forceinline__ void a_ready(const Unit&) const {}
    __device__ __forceinline__ void done(const Unit&) const {}
};
struct EpiQKv {
    static constexpr bool PERM = true, AFTER_DRAIN = false;
    EpiPlain q; EpiKv kv;
    __device__ __forceinline__ void operator()(const f32x4 (&acc)[2][2][4][2], const Unit& u, int wr, int wc, int fr, int fq) const {
        if (u.pn < 6) q(acc, u, wr, wc, fr, fq);
        else { Unit v; v.pm = u.pm - 32; v.pn = u.pn - 6; kv(acc, v, wr, wc, fr, fq); }
    }
};

struct TItem { const float* src; const float* gain; bf16_t* dst; int ldw, K; bool zero; };
__device__ __forceinline__ TItem p0_item(const Params& p, unsigned char* ws, int it) {
    constexpr int I_IN = 32 * 65, I_Q = 8 * 24, I_KV = 8 * 32, I_O = 32 * 32, I_GU = 32 * 176;
    TItem t; t.gain = nullptr; t.zero = false; int r = it;
    if (r < I_IN) { const int kb = r / 65, nb = r % 65; const int nd = nb * 64; const int ns = nd < 1024 ? nd : (nd < 4096 ? nd + 64 : 1024);
        t.src = p.in[2] + (size_t)(kb * 64) * 4160 + ns; t.ldw = 4160; t.dst = (bf16_t*)(ws + WS_WIN) + (size_t)nd * 2048 + kb * 64; t.K = 2048; return t; } r -= I_IN;
    if (r < I_Q) { const int kb = r / 24, nb = r % 24; t.src = p.in[4] + (size_t)(kb * 64) * 1536 + nb * 64; t.ldw = 1536; t.gain = p.in[3] + kb * 64; t.dst = (bf16_t*)(ws + WS_WQ) + (size_t)(nb * 64) * 512 + kb * 64; t.K = 512; return t; } r -= I_Q;
    if (r < I_KV) { const int kb = r / 32, nb = r % 32; t.src = p.in[6] + (size_t)(kb * 64) * 2048 + nb * 64; t.ldw = 2048; t.gain = p.in[5] + kb * 64; t.dst = (bf16_t*)(ws + WS_WKV) + (size_t)(nb * 64) * 512 + kb * 64; t.K = 512; return t; } r -= I_KV;
    if (r < I_O) { const int kb = r / 32, nb = r % 32; t.src = p.in[17] + (size_t)(kb * 64) * 2048 + nb * 64; t.ldw = 2048; t.dst = (bf16_t*)(ws + WS_WO) + (size_t)(nb * 64) * 2048 + kb * 64; t.K = 2048; return t; } r -= I_O;
    if (r < I_GU) { const int kb = r / 176, nb = r % 176; const int nd = nb * 64; const int tt = nd >> 8, bj = (nd >> 7) & 1, j = nd & 127;
        t.src = (bj ? p.in[20] : p.in[19]) + (size_t)(kb * 64) * DFF + tt * 128 + j; t.ldw = DFF; t.gain = p.in[18] + kb * 64;
        t.dst = (bf16_t*)(ws + WS_WGU) + (size_t)nd * 2048 + kb * 64; t.K = 2048; return t; } r -= I_GU;
    { const int kb = r / 32, nb = r % 32; t.src = p.in[21] + (size_t)(kb * 64) * 2048 + nb * 64; t.ldw = 2048; t.dst = (bf16_t*)(ws + WS_WD) + (size_t)(nb * 64) * DFF + kb * 64; t.K = DFF; return t; }
}
constexpr int P0_NITEMS = 32 * 65 + 8 * 24 + 8 * 32 + 32 * 32 + 32 * 176 + 88 * 32, P0_ITEMS_WD = 88 * 32, P0_ITEMS_EARLY = 32 * 65 + 8 * 24 + 8 * 32, P0_ITEMS_MID = 32 * 32 + 32 * 176;
static_assert(P0_ITEMS_MID == 416 * 16 && P0_ITEMS_EARLY + P0_ITEMS_MID + P0_ITEMS_WD == P0_NITEMS, "conversion item split");
__device__ __forceinline__ void p0_convert(const Params& p, LAS unsigned char* lds, int it0, int NITEMS, int gw, int NGW, int wave, int lane) {
    unsigned char* ws = p.ws;
    LAS float* scr = (LAS float*)(lds + wave * 16640);
    const int ksub = lane >> 4, n4 = (lane & 15) * 4;
    f32x4 v[16];
#define P0_LOAD(T) do { const float* sp_ = (T).src + (size_t)ksub * (T).ldw + n4; \
        _Pragma("unroll") for (int i = 0; i < 16; ++i) v[i] = __builtin_nontemporal_load((const f32x4*)(sp_ + (size_t)(4 * i) * (T).ldw)); } while (0)
    int it = it0 + gw; TItem cur;
    if (it < NITEMS) { cur = p0_item(p, ws, it); P0_LOAD(cur); }
    while (it < NITEMS) {
        if (cur.gain) {
#pragma unroll
            for (int i = 0; i < 16; ++i) v[i] = v[i] * cur.gain[4 * i + ksub];
        }
#pragma unroll
        for (int i = 0; i < 16; ++i) { LAS float* d = scr + (4 * i + ksub) * 65 + n4; d[0] = v[i][0]; d[1] = v[i][1]; d[2] = v[i][2]; d[3] = v[i][3]; }
        const int itn = it + NGW; TItem nxt = cur;
        if (itn < NITEMS) { nxt = p0_item(p, ws, itn); P0_LOAD(nxt); }
        asm volatile("s_waitcnt lgkmcnt(0)" ::: "memory");
        const int c = lane & 7;
#pragma unroll
        for (int j = 0; j < 8; ++j) { const int n = (lane >> 3) + 8 * j; const LAS float* s = scr + (8 * c) * 65 + n;
            u32x4 o; o.x = cvt_pk_bf16(s[0 * 65], s[1 * 65]); o.y = cvt_pk_bf16(s[2 * 65], s[3 * 65]); o.z = cvt_pk_bf16(s[4 * 65], s[5 * 65]); o.w = cvt_pk_bf16(s[6 * 65], s[7 * 65]);
            *(u32x4*)(cur.dst + (size_t)n * cur.K + 8 * c) = o; }
        asm volatile("s_waitcnt lgkmcnt(0)" ::: "memory");
        it = itn; cur = nxt;
    }
#undef P0_LOAD
}
__device__ __forceinline__ void phase0(const Params& p, LAS unsigned char* lds, int gw, int NGW, int wave, int lane) {
    unsigned char* ws = p.ws;
    p0_convert(p, lds, 0, P0_ITEMS_EARLY, gw, NGW, wave, lane);
    const float* x = p.in[0]; const float* g = p.in[1]; bf16_t* hb = (bf16_t*)(ws + WS_HB);
    f32x4 v[8], vn[8];
    if (gw < M) {
#pragma unroll
        for (int j = 0; j < 8; ++j) vn[j] = __builtin_nontemporal_load((const f32x4*)(x + (size_t)gw * DM) + lane + 64 * j);
    }
    for (int m = gw; m < M; m += NGW) {
        float s = 0.f;
#pragma unroll
        for (int j = 0; j < 8; ++j) { v[j] = vn[j]; s += (v[j][0] * v[j][0] + v[j][1] * v[j][1]) + (v[j][2] * v[j][2] + v[j][3] * v[j][3]); }
        if (m + NGW < M) {
#pragma unroll
            for (int j = 0; j < 8; ++j) vn[j] = __builtin_nontemporal_load((const f32x4*)(x + (size_t)(m + NGW) * DM) + lane + 64 * j);
        }
        const float rs = 1.0f / sqrtf(wave_sum(s) * (1.0f / DM) + EPS);
        u32x2* o = (u32x2*)(hb + (size_t)m * DM) + lane;
#pragma unroll
        for (int j = 0; j < 8; ++j) { const f32x4 gv = ((const f32x4*)g)[lane + 64 * j]; u32x2 w;
            w.x = cvt_pk_bf16(v[j][0] * rs * gv[0], v[j][1] * rs * gv[1]); w.y = cvt_pk_bf16(v[j][2] * rs * gv[2], v[j][3] * rs * gv[3]); o[64 * j] = w; }
    }
}

__device__ __forceinline__ void unpack8(const u32x4& w, float (&f)[8]) {
    f[0] = bflo(w.x); f[1] = bfhi(w.x); f[2] = bflo(w.y); f[3] = bfhi(w.y); f[4] = bflo(w.z); f[5] = bfhi(w.z); f[6] = bflo(w.w); f[7] = bfhi(w.w);
}
__device__ __forceinline__ u32x4 pack8f(const float (&f)[8]) {
    u32x4 w; w.x = cvt_pk_bf16(f[0], f[1]); w.y = cvt_pk_bf16(f[2], f[3]); w.z = cvt_pk_bf16(f[4], f[5]); w.w = cvt_pk_bf16(f[6], f[7]); return w;
}
__device__ __forceinline__ void latent_norm(const bf16_t* src, const float* g, bf16_t* dst, int lane) {
    float f[8]; unpack8(*(const u32x4*)(src + lane * 8), f); float s = 0.f;
#pragma unroll
    for (int j = 0; j < 8; ++j) s += f[j] * f[j];
    const float rs = 1.0f / sqrtf(wave_sum(s) * (1.0f / 512.0f) + EPS);
#pragma unroll
    for (int j = 0; j < 8; ++j) f[j] = f[j] * rs * g[lane * 8 + j];
    *(u32x4*)(dst + lane * 8) = pack8f(f);
}
__device__ __forceinline__ void diff_row(const u32x4& raw0, const u32x4& raw1, const float (&g)[16], const float (&sn)[8], const float (&cs)[8], bf16_t* o, int sub) {
    float f[16]; { float t[8]; unpack8(raw0, t);
#pragma unroll
        for (int j = 0; j < 8; ++j) f[j] = t[j];
        unpack8(raw1, t);
#pragma unroll
        for (int j = 0; j < 8; ++j) f[8 + j] = t[j]; }
    float ss = 0.f;
#pragma unroll
    for (int j = 0; j < 16; ++j) ss += f[j] * f[j];
    ss += __shfl_xor(ss, 1); ss += __shfl_xor(ss, 2);
    const float rs = 1.0f / sqrtf(ss * (1.0f / 64.0f) + EPS);
#pragma unroll
    for (int j = 0; j < 16; ++j) f[j] = f[j] * rs * g[j];
    if (sub == 0) {
#pragma unroll
        for (int i = 0; i < 8; ++i) { const float a = f[i], bb = f[8 + i]; f[i] = a * cs[i] - bb * sn[i]; f[8 + i] = bb * cs[i] + a * sn[i]; }
    }
    { float t[8];
#pragma unroll
      for (int j = 0; j < 8; ++j) t[j] = f[j];
      *(u32x4*)o = pack8f(t);
#pragma unroll
      for (int j = 0; j < 8; ++j) t[j] = f[8 + j];
      *(u32x4*)(o + 8) = pack8f(t); }
}
__device__ __forceinline__ void kpe_gemm(unsigned char* ws, LAS unsigned char* lds, int blk0, int bstep, int bend, int tid, int wave, int lane) {
    const bf16_t* hb = (const bf16_t*)(ws + WS_HB); const bf16_t* wk = (const bf16_t*)(ws + WS_WIN) + (size_t)4096 * 2048; bf16_t* kpe = (bf16_t*)(ws + WS_KPE);
    const int r32 = lane & 31, h = lane >> 5;
    LAS float* red = (LAS float*)lds;
    for (int blk = blk0; blk < bend; blk += bstep) {
        const int m0 = blk * 32;
        const bf16_t* ap = hb + (size_t)(m0 + r32) * 2048 + wave * 256 + 8 * h;
        const bf16_t* bp = wk + (size_t)r32 * 2048 + wave * 256 + 8 * h;
        f32x16 c0, c1;
#pragma unroll
        for (int i = 0; i < 16; ++i) { c0[i] = 0.f; c1[i] = 0.f; }
#pragma unroll
        for (int ks = 0; ks < 16; ++ks) {
            const bf16x8 a = *(const bf16x8*)(ap + 16 * ks), b0 = *(const bf16x8*)(bp + 16 * ks), b1 = *(const bf16x8*)(bp + (size_t)32 * 2048 + 16 * ks);
            c0 = __builtin_amdgcn_mfma_f32_32x32x16_bf16(a, b0, c0, 0, 0, 0); c1 = __builtin_amdgcn_mfma_f32_32x32x16_bf16(a, b1, c1, 0, 0, 0);
        }
        __syncthreads();
#pragma unroll
        for (int i = 0; i < 16; ++i) { const int tok = (i & 3) + 8 * (i >> 2) + 4 * h; red[(wave * 32 + tok) * 64 + r32] = c0[i]; red[(wave * 32 + tok) * 64 + 32 + r32] = c1[i]; }
        __syncthreads();
        { const int tok = tid >> 4, n4 = (tid & 15) * 4; f32x4 sacc = {0.f, 0.f, 0.f, 0.f};
#pragma unroll
          for (int w8 = 0; w8 < 8; ++w8) sacc = sacc + *(const LAS f32x4*)(red + (w8 * 32 + tok) * 64 + n4);
          u32x2 w; w.x = cvt_pk_bf16(sacc[0], sacc[1]); w.y = cvt_pk_bf16(sacc[2], sacc[3]); *(u32x2*)(kpe + (size_t)(m0 + tok) * 64 + n4) = w; }
    }
}
__device__ __forceinline__ void p3_pre(const Params& p, LAS unsigned char* lds, int bx, int G, int tid, int wave, int lane) {
    unsigned char* ws = p.ws;
    const bf16_t* proj = (const bf16_t*)(ws + WS_PROJ); bf16_t* qd = (bf16_t*)(ws + WS_QD); bf16_t* kd = (bf16_t*)(ws + WS_KD);
    constexpr int NQU = (M / 256) * (1536 / 256);
    int row0, rstep, rend, blk0, bstep, bend;
    if (G == 256) {
        if (bx >= NQU) { row0 = (bx - NQU) * NWAVES + wave; rstep = (256 - NQU) * NWAVES; rend = 4096; blk0 = bx - NQU; bstep = 256 - NQU; bend = 128; }
        else { row0 = 4096 + bx * NWAVES + wave; rstep = NQU * NWAVES; rend = M; blk0 = 128 + bx; bstep = 256; bend = 256; }
    } else { row0 = bx * NWAVES + wave; rstep = G * NWAVES; rend = M; blk0 = bx; bstep = G; bend = 256; }
    kpe_gemm(ws, lds, blk0, bstep, bend, tid, wave, lane);
    const int sub = lane & 3, hc = lane >> 2;
    float gq[16], gk[16], frq[8];
#pragma unroll
    for (int j = 0; j < 16; ++j) { gq[j] = p.in[10][sub * 16 + j] * (0.125f * LOG2E); gk[j] = p.in[11][sub * 16 + j]; }
#pragma unroll
    for (int i = 0; i < 8; ++i) frq[i] = rope_freq(i, 16);
    for (int m = row0; m < rend; m += rstep) {
        const bf16_t* pr = proj + (size_t)m * PROJ_LD + lane * 16; const int b = m >> 11, sp = m & 2047;
        const u32x4 q0 = *(const u32x4*)(pr), q1 = *(const u32x4*)(pr + 8), k0 = *(const u32x4*)(pr + 1024), k1 = *(const u32x4*)(pr + 1032);
        float sn[8], cs[8];
#pragma unroll
        for (int i = 0; i < 8; ++i) sincos_ang((float)sp * frq[i], sn[i], cs[i]);
        const size_t off = ((size_t)((b * 16 + hc) * SEQ + sp)) * 64 + sub * 16;
        diff_row(q0, q1, gq, sn, cs, qd + off, sub);
        diff_row(k0, k1, gk, sn, cs, kd + off, sub);
    }
}

__device__ __forceinline__ void mla_row(const u32x4& n0, const u32x4& n1, const u32x4& r0, float rn, float rr, const float (&gn)[16], const float (&gr)[8], const float (&sns)[8], const float (&cs)[8], bf16_t* o, int sub) {
    float fn[16], fr[8];
    { float t[8]; unpack8(n0, t);
#pragma unroll
      for (int j = 0; j < 8; ++j) fn[j] = t[j] * rn;
      unpack8(n1, t);
#pragma unroll
      for (int j = 0; j < 8; ++j) fn[8 + j] = t[j] * rn;
      unpack8(r0, t);
#pragma unroll
      for (int j = 0; j < 8; ++j) fr[j] = t[j] * rr; }
    float ss = 0.f;
#pragma unroll
    for (int j = 0; j < 16; ++j) ss += fn[j] * fn[j];
#pragma unroll
    for (int j = 0; j < 8; ++j) ss += fr[j] * fr[j];
    ss += __shfl_xor(ss, 1); ss += __shfl_xor(ss, 2); ss += __shfl_xor(ss, 4);
    const float rs = 1.0f / sqrtf(ss * (1.0f / 192.0f) + EPS);
#pragma unroll
    for (int j = 0; j < 16; ++j) fn[j] = fn[j] * rs * gn[j];
    float ro[8];
#pragma unroll
    for (int j = 0; j < 8; ++j) { const float v = fr[j] * rs * gr[j]; const float pv = __shfl_xor(v, 4); ro[j] = v * cs[j] + pv * sns[j]; }
    { float t[8];
#pragma unroll
      for (int j = 0; j < 8; ++j) t[j] = fn[j];
      *(u32x4*)(o + sub * 16) = pack8f(t);
#pragma unroll
      for (int j = 0; j < 8; ++j) t[j] = fn[8 + j];
      *(u32x4*)(o + sub * 16 + 8) = pack8f(t); }
    *(u32x4*)(o + 128 + sub * 8) = pack8f(ro);
}
__device__ __forceinline__ void phase4(const Params& p, int gw, int NGW, int lane) {
    unsigned char* ws = p.ws;
    const bf16_t* qf = (const bf16_t*)(ws + WS_QF); const bf16_t* knope = (const bf16_t*)(ws + WS_KNOPE); const bf16_t* kpe = (const bf16_t*)(ws + WS_KPE);
    bf16_t* qm = (bf16_t*)(ws + WS_QM); bf16_t* km = (bf16_t*)(ws + WS_KM);
    const int h = lane >> 3, sub = lane & 7;
    const float qscale = LOG2E / sqrtf(192.0f), sgn = sub < 4 ? -1.0f : 1.0f;
    float gqn[16], gkn[16], gqr[8], gkr[8], frq[8];
#pragma unroll
    for (int j = 0; j < 16; ++j) { gqn[j] = p.in[7][sub * 16 + j] * qscale; gkn[j] = p.in[8][sub * 16 + j]; }
#pragma unroll
    for (int j = 0; j < 8; ++j) { gqr[j] = p.in[7][128 + sub * 8 + j] * qscale; gkr[j] = p.in[8][128 + sub * 8 + j]; frq[j] = rope_freq((sub * 8 + j) & 31, 64); }
    for (int m = gw; m < M; m += NGW) {
        const int b = m >> 11, sp = m & 2047;
        const bf16_t* q0 = qf + (size_t)m * 1536 + h * 192; const bf16_t* k0 = knope + (size_t)m * 1024 + h * 128 + sub * 16;
        const u32x4 qa = *(const u32x4*)(q0 + sub * 16), qb = *(const u32x4*)(q0 + sub * 16 + 8), qc = *(const u32x4*)(q0 + 128 + sub * 8);
        const u32x4 ka = *(const u32x4*)(k0), kb = *(const u32x4*)(k0 + 8), kc = *(const u32x4*)(kpe + (size_t)m * 64 + sub * 8);
        const float* sq = (const float*)(ws + WS_SSQL) + (size_t)m * 16; const float rq = latent_rs(sq), rkv = latent_rs(sq + 8);
        float sns[8], cs[8];
#pragma unroll
        for (int j = 0; j < 8; ++j) { float sv; sincos_ang((float)sp * frq[j], sv, cs[j]); sns[j] = sv * sgn; }
        const size_t off = ((size_t)((b * 8 + h) * SEQ + sp)) * 192;
        mla_row(qa, qb, qc, rq, rq, gqn, gqr, sns, cs, qm + off, sub);
        mla_row(ka, kb, kc, rkv, 1.0f, gkn, gkr, sns, cs, km + off, sub);
    }
}

#define MFMA32(a, b, c) __builtin_amdgcn_mfma_f32_32x32x16_bf16((a), (b), (c), 0, 0, 0)
typedef short s16x4 __attribute__((ext_vector_type(4)));
__device__ __forceinline__ float max3f(float a, float b, float c) { float r; asm("v_max3_f32 %0, %1, %2, %3" : "=v"(r) : "v"(a), "v"(b), "v"(c)); return r; }
__device__ __forceinline__ s16x4 vtr(const LAS unsigned char* p) { return __builtin_bit_cast(s16x4, __builtin_amdgcn_ds_read_tr16_b64_v4i16((LAS s16x4*)p)); }
template <int DQK>
__device__ __forceinline__ void attn_pass(f32x16 (&o)[4], const bf16_t* Qh, const bf16_t* Kh, const bf16_t* Vth, int q0, LAS unsigned char* lds, int tid, int w, int lane) {
    constexpr int KSTR = DQK * 2 + 16, VSTR = 320, NKC = (64 * DQK * 2 / 16) / NTHR, CPR = DQK / 8, KB = 64 * KSTR, VB = 64 * VSTR;
    static_assert(NKC * NTHR * 16 == 64 * DQK * 2, "K tile chunks");
    constexpr bool PIPE = false; constexpr int KA = PIPE ? 1 : 0;
    constexpr int QKB = (DQK == 64) ? 4 : 2, PVB = (DQK == 64) ? 2 : 1;
    constexpr float THR = 8.0f;
    LAS unsigned char* Ks = lds; LAS unsigned char* Vs = lds + 2 * KB;
    const int r32 = lane & 31, h = lane >> 5;
    bf16x8 qf[DQK / 16];
    { const bf16_t* qrow = Qh + (size_t)(q0 + 32 * w + r32) * DQK + 8 * h;
#pragma unroll
      for (int d0 = 0; d0 < DQK / 16; ++d0) qf[d0] = *(const bf16x8*)(qrow + 16 * d0); }
    float m_run = -INFINITY, l_lane = 0.f;
#pragma unroll
    for (int db = 0; db < 4; ++db)
#pragma unroll
        for (int i = 0; i < 16; ++i) o[db][i] = 0.f;
    const int NT = (q0 + 256) >> 6, tmax = (q0 >> 6) + (w >> 1);
    const int qg = q0 + 32 * w + r32;
    u32x4 kreg[NKC], vreg[2];
#define ATT_LDK(R, t) do { _Pragma("unroll") for (int j = 0; j < NKC; ++j) R[j] = ((const u32x4*)(Kh + (size_t)(t) * 64 * DQK))[tid + NTHR * j]; } while (0)
#define ATT_LDV(t) do { _Pragma("unroll") for (int j = 0; j < 2; ++j) vreg[j] = ((const u32x4*)(Vth + (size_t)(t) * 64 * 128))[tid + NTHR * j]; } while (0)
#define ATT_STK(R, buf) do { _Pragma("unroll") for (int j = 0; j < NKC; ++j) { const int c = tid + NTHR * j; *(LAS u32x4*)(Ks + (buf) * KB + (c / CPR) * KSTR + (c % CPR) * 16) = R[j]; } } while (0)
#define ATT_STV(buf) do { _Pragma("unroll") for (int j = 0; j < 2; ++j) { const int c = tid + NTHR * j; *(LAS u32x4*)(Vs + (buf) * VB + (c >> 4) * VSTR + (c & 15) * 16) = vreg[j]; } } while (0)
#define ATT_QK(P0, P1, buf) do { \
        _Pragma("unroll") for (int i = 0; i < 16; ++i) { P0[i] = 0.f; P1[i] = 0.f; } \
        const LAS unsigned char* ka = Ks + (buf) * KB + r32 * KSTR + h * 16; \
        _Pragma("unroll") for (int g0 = 0; g0 < DQK / 16; g0 += QKB) {         \
            bf16x8 fa[QKB], fb[QKB]; \
            _Pragma("unroll") for (int d = 0; d < QKB; ++d) { fa[d] = *(const LAS bf16x8*)(ka + (g0 + d) * 32); fb[d] = *(const LAS bf16x8*)(ka + 32 * KSTR + (g0 + d) * 32); } \
            _Pragma("unroll") for (int d = 0; d < QKB; ++d) { P0 = MFMA32(fa[d], qf[g0 + d], P0); P1 = MFMA32(fb[d], qf[g0 + d], P1); } \
            __builtin_amdgcn_sched_group_barrier(0x100, 2 * QKB, 0); __builtin_amdgcn_sched_group_barrier(0x008, 2 * QKB, 0); } \
        asm volatile("s_nop 15\n\ts_nop 7" : "+v"(P0), "+v"(P1)); } while (0)
#define ATT_SMPV(P0, P1, t, buf) do { \
        if ((t) == tmax) { const int kb = 64 * (t) + 4 * h; \
            _Pragma("unroll") for (int i = 0; i < 16; ++i) { const int kv = kb + (i & 3) + 8 * (i >> 2); if (kv > qg) P0[i] = -INFINITY; if (kv + 32 > qg) P1[i] = -INFINITY; } } \
        float mxa = max3f(P0[0], P0[1], P1[0]), mxb = max3f(P0[2], P0[3], P1[1]); mxa = max3f(mxa, P1[2], P1[3]); \
        _Pragma("unroll") for (int i = 4; i < 16; i += 4) { mxa = max3f(mxa, P0[i], P0[i + 1]); mxb = max3f(mxb, P0[i + 2], P0[i + 3]); mxa = max3f(mxa, P1[i], P1[i + 1]); mxb = max3f(mxb, P1[i + 2], P1[i + 3]); } \
        float mx = max3f(mxa, mxb, mxb); \
        mx = max3f(mx, __shfl_xor(mx, 32), mx); \
        const bool need = mx > m_run + THR; \
        if (__builtin_amdgcn_ballot_w64(need) != 0ull) { \
            const float mnew = need ? mx : m_run, alpha = __builtin_amdgcn_exp2f(m_run - mnew); m_run = mnew; l_lane *= alpha; \
            _Pragma("unroll") for (int db = 0; db < 4; ++db) _Pragma("unroll") for (int i = 0; i < 16; ++i) o[db][i] *= alpha; } \
        float rs = 0.f; \
        _Pragma("unroll") for (int i = 0; i < 16; ++i) { P0[i] = __builtin_amdgcn_exp2f(P0[i] - m_run); P1[i] = __builtin_amdgcn_exp2f(P1[i] - m_run); rs += P0[i] + P1[i]; } \
        l_lane += rs; \
        bf16x8 pb[4]; \
        { u32x4 t0, t1, t2, t3; \
          t0.x = cvt_pk_bf16(P0[0], P0[1]); t0.y = cvt_pk_bf16(P0[2], P0[3]); t0.z = cvt_pk_bf16(P0[4], P0[5]); t0.w = cvt_pk_bf16(P0[6], P0[7]); \
          t1.x = cvt_pk_bf16(P0[8], P0[9]); t1.y = cvt_pk_bf16(P0[10], P0[11]); t1.z = cvt_pk_bf16(P0[12], P0[13]); t1.w = cvt_pk_bf16(P0[14], P0[15]); \
          t2.x = cvt_pk_bf16(P1[0], P1[1]); t2.y = cvt_pk_bf16(P1[2], P1[3]); t2.z = cvt_pk_bf16(P1[4], P1[5]); t2.w = cvt_pk_bf16(P1[6], P1[7]); \
          t3.x = cvt_pk_bf16(P1[8], P1[9]); t3.y = cvt_pk_bf16(P1[10], P1[11]); t3.z = cvt_pk_bf16(P1[12], P1[13]); t3.w = cvt_pk_bf16(P1[14], P1[15]); \
          pb[0] = __builtin_bit_cast(bf16x8, t0); pb[1] = __builtin_bit_cast(bf16x8, t1); pb[2] = __builtin_bit_cast(bf16x8, t2); pb[3] = __builtin_bit_cast(bf16x8, t3); } \
        const LAS unsigned char* va = Vs + (buf) * VB + (4 * h + ((lane & 15) >> 2)) * VSTR + ((lane >> 4) & 1) * 32 + (lane & 3) * 8; \
        _Pragma("unroll") for (int dp = 0; dp < 4; dp += PVB) { \
            s16x4 lo[PVB][4], hi[PVB][4]; \
            _Pragma("unroll") for (int d2 = 0; d2 < PVB; ++d2) _Pragma("unroll") for (int ks = 0; ks < 4; ++ks) { lo[d2][ks] = vtr(va + (dp + d2) * 64 + (ks * 16) * VSTR); hi[d2][ks] = vtr(va + (dp + d2) * 64 + (ks * 16 + 8) * VSTR); } \
            _Pragma("unroll") for (int ks = 0; ks < 4; ++ks) _Pragma("unroll") for (int d2 = 0; d2 < PVB; ++d2) { \
                const bf16x8 a = (bf16x8){lo[d2][ks][0], lo[d2][ks][1], lo[d2][ks][2], lo[d2][ks][3], hi[d2][ks][0], hi[d2][ks][1], hi[d2][ks][2], hi[d2][ks][3]}; o[dp + d2] = MFMA32(a, pb[ks], o[dp + d2]); } \
            __builtin_amdgcn_sched_group_barrier(0x100, 8 * PVB, 0); __builtin_amdgcn_sched_group_barrier(0x008, 4 * PVB, 0); } } while (0)
#define ATT_ITER(C0, C1, N0, N1, tt, B, NB) do { \
        __syncthreads(); \
        if constexpr (PIPE) { if ((tt) + 2 < NT) ATT_STK(kreg, B); } else { if ((tt) + 1 < NT) ATT_STK(kreg, NB); } \
        if ((tt) + 1 < NT) ATT_STV(NB); \
        if ((tt) + 2 + KA < NT) ATT_LDK(kreg, (tt) + 2 + KA); \
        if ((tt) + 2 < NT) ATT_LDV((tt) + 2); \
        if constexpr (PIPE) { if ((tt) + 1 <= tmax) ATT_QK(N0, N1, NB); if ((tt) <= tmax) ATT_SMPV(C0, C1, tt, B); } \
        else { if ((tt) <= tmax) { ATT_QK(C0, C1, B); ATT_SMPV(C0, C1, tt, B); } } } while (0)
    f32x16 pA0, pA1, pB0, pB1;
    if constexpr (PIPE) {
        u32x4 kreg2[NKC];
        ATT_LDK(kreg, 0); ATT_LDV(0); ATT_LDK(kreg2, 1);
        __syncthreads();
        ATT_STK(kreg, 0); ATT_STV(0); ATT_STK(kreg2, 1);
        ATT_LDK(kreg, 2); ATT_LDV(1);
        __syncthreads();
        ATT_QK(pA0, pA1, 0);
        for (int t = 0; t < NT; t += 2) {
            ATT_ITER(pA0, pA1, pB0, pB1, t, 0, 1);
            ATT_ITER(pB0, pB1, pA0, pA1, t + 1, 1, 0);
        }
    } else {
        u32x4 kreg2[NKC], vreg2[2];
        ATT_LDK(kreg, 0); ATT_LDV(0);
        ATT_LDK(kreg2, 1);
#pragma unroll
        for (int j = 0; j < 2; ++j) vreg2[j] = ((const u32x4*)(Vth + (size_t)64 * 128))[tid + NTHR * j];
        __syncthreads();
        ATT_STK(kreg, 0); ATT_STV(0);
#pragma unroll
        for (int j = 0; j < NKC; ++j) kreg[j] = kreg2[j];
#pragma unroll
        for (int j = 0; j < 2; ++j) vreg[j] = vreg2[j];
        for (int t = 0; t < NT; t += 2) {
            ATT_ITER(pA0, pA1, pA0, pA1, t, 0, 1);
            ATT_ITER(pA0, pA1, pA0, pA1, t + 1, 1, 0);
        }
    }
#undef ATT_LDK
#undef ATT_LDV
#undef ATT_STK
#undef ATT_STV
#undef ATT_QK
#undef ATT_SMPV
#undef ATT_ITER
    float l = l_lane + __shfl_xor(l_lane, 32);
    const float inv = 1.0f / l;
#pragma unroll
    for (int db = 0; db < 4; ++db)
#pragma unroll
        for (int i = 0; i < 16; ++i) o[db][i] *= inv;
}
__device__ __forceinline__ void attn_out_store(const f32x16 (&o)[4], const float* gain, float scale, bf16_t* dst_row, int h) {
    float ss = 0.f;
#pragma unroll
    for (int db = 0; db < 4; ++db)
#pragma unroll
        for (int i = 0; i < 16; ++i) ss += o[db][i] * o[db][i];
    ss += __shfl_xor(ss, 32);
    const float rn = scale / sqrtf(ss * (1.0f / 128.0f) + EPS);
#pragma unroll
    for (int db = 0; db < 4; ++db)
#pragma unroll
        for (int g4 = 0; g4 < 4; ++g4) { const int d = 32 * db + 8 * g4 + 4 * h; const f32x4 gv = *(const f32x4*)(gain + d);
            u32x2 w; w.x = cvt_pk_bf16(o[db][4 * g4] * rn * gv[0], o[db][4 * g4 + 1] * rn * gv[1]); w.y = cvt_pk_bf16(o[db][4 * g4 + 2] * rn * gv[2], o[db][4 * g4 + 3] * rn * gv[3]);
            *(u32x2*)(dst_row + d) = w; }
}
__device__ __forceinline__ void phase5(const Params& p, LAS unsigned char* lds, unsigned* ctr, int tid, int wave, int lane) {
    unsigned char* ws = p.ws;
    const bf16_t* qm = (const bf16_t*)(ws + WS_QM); const bf16_t* km = (const bf16_t*)(ws + WS_KM); const bf16_t* vtm = (const bf16_t*)(ws + WS_VTM);
    const bf16_t* qd = (const bf16_t*)(ws + WS_QD); const bf16_t* kd = (const bf16_t*)(ws + WS_KD); const bf16_t* vtd = (const bf16_t*)(ws + WS_VTD);
    bf16_t* ao = (bf16_t*)(ws + WS_AO);
    LAS unsigned* shw = (LAS unsigned*)(lds + 163824);
    float lam;
    { const float a = p.in[12][lane] * p.in[13][lane], b2 = p.in[14][lane] * p.in[15][lane];
      lam = __expf(wave_sum(a)) - __expf(wave_sum(b2)) + LAMBDA_INIT; }
    const int r32 = lane & 31, h = lane >> 5;
    for (;;) {
        __syncthreads();
        if (tid == 0) shw[0] = atomicAdd(ctr, 1u);
        __syncthreads();
        const unsigned uq = shw[0];
        if (uq >= 928u) break;
        const unsigned grp = uq / 29u, ing = uq % 29u;
        if (ing >= 16u) {
            const int cj = (int)(grp * 13u + ing - 16u);
            p0_convert(p, lds, P0_ITEMS_EARLY + 16 * cj, P0_ITEMS_EARLY + 16 * cj + 16, wave, NWAVES, wave, lane);
            continue;
        }
        const unsigned u = grp * 16u + ing;
        const int cls = (int)(u >> 5), bh = (int)(u & 31u);
        const int isdiff = (0x552B >> cls) & 1, qb = (int)((0x0011223345465767ull >> (4 * cls)) & 15ull);
        const int q0 = qb * 256, b = bh >> 3, hd = bh & 7;
        if (!isdiff) {
            f32x16 o[4];
            attn_pass<192>(o, qm + (size_t)bh * SEQ * 192, km + (size_t)bh * SEQ * 192, vtm + (size_t)bh * 128 * SEQ, q0, lds, tid, wave, lane);
            attn_out_store(o, p.in[9], 1.0f, ao + (size_t)(b * SEQ + q0 + 32 * wave + r32) * DM + hd * 128, h);
        } else {
            f32x16 o[4];
            LAS unsigned* st = (LAS unsigned*)(lds + 59392) + wave * 2048 + lane;
            attn_pass<64>(o, qd + (size_t)(bh * 2 + 1) * SEQ * 64, kd + (size_t)(bh * 2 + 1) * SEQ * 64, vtd + (size_t)bh * 128 * SEQ, q0, lds, tid, wave, lane);
#pragma unroll
            for (int db = 0; db < 4; ++db)
#pragma unroll
                for (int i = 0; i < 16; i += 2) st[(db * 8 + (i >> 1)) * 64] = cvt_pk_bf16(o[db][i], o[db][i + 1]);
            attn_pass<64>(o, qd + (size_t)(bh * 2) * SEQ * 64, kd + (size_t)(bh * 2) * SEQ * 64, vtd + (size_t)bh * 128 * SEQ, q0, lds, tid, wave, lane);
#pragma unroll
            for (int db = 0; db < 4; ++db)
#pragma unroll
                for (int i = 0; i < 16; i += 2) { const unsigned wv = st[(db * 8 + (i >> 1)) * 64]; o[db][i] -= lam * bflo(wv); o[db][i + 1] -= lam * bfhi(wv); }
            attn_out_store(o, p.in[16], 1.0f - LAMBDA_INIT, ao + (size_t)(b * SEQ + q0 + 32 * wave + r32) * DM + hd * 128 + 1024, h);
        }
    }
}

#define XB_TMO      128
#define XB_XCNT(j)  (256  + 64 * (j))
#define XB_XSUB(j)  (1280 + 64 * (j))
#define XB_XGEN(j)  (2304 + 64 * (j))
#define XB_TOP      3328
#define XB_TOPGEN   3392
#define XCD_BAR_WORDS 3456
#define XB_SPIN_CAP (1u << 18)

__device__ __forceinline__ unsigned xb_ld(unsigned* p)              { return __hip_atomic_load(p, __ATOMIC_RELAXED, __HIP_MEMORY_SCOPE_AGENT); }
__device__ __forceinline__ unsigned xb_add(unsigned* p, unsigned v) { return __hip_atomic_fetch_add(p, v, __ATOMIC_RELAXED, __HIP_MEMORY_SCOPE_AGENT); }
__device__ __forceinline__ unsigned xb_xcc_id() { return (unsigned)__builtin_amdgcn_s_getreg((3 << 11) | 20) & 0xFu; }
#define XB_SPIN(cond, bar) do { unsigned _sp = 0; while (cond) { __builtin_amdgcn_s_sleep(1); \
    if ((++_sp & 255u) == 0u) { if (xb_ld(&(bar)[XB_TMO])) break; if (_sp > XB_SPIN_CAP) { atomicAdd(&(bar)[XB_TMO], 1u); break; } } } } while (0)

struct XcdBarrier {
    unsigned* bar; unsigned x;
    volatile LAS unsigned* st;
};

__device__ __forceinline__ XcdBarrier xcd_barrier_post(unsigned* bar, volatile LAS unsigned* st) {
    XcdBarrier b; b.bar = bar; b.x = xb_xcc_id(); b.st = st;
    if (threadIdx.x == 0) (void)xb_add(&bar[XB_XCNT(b.x)], 1u);
    return b;
}
__device__ __forceinline__ void xcd_barrier_complete(unsigned* bar, unsigned x, unsigned& nloc, unsigned& nx) {
    const unsigned G = gridDim.x * gridDim.y * gridDim.z;
    unsigned sum, cnt, mine, sp = 0u;
    for (;;) {
        sum = 0u; cnt = 0u; mine = 0u;
#pragma unroll
        for (unsigned j = 0; j < 16; ++j) { const unsigned c = xb_ld(&bar[XB_XCNT(j)]); sum += c; cnt += (c > 0u) ? 1u : 0u; mine = (j == x) ? c : mine; }
        if (sum == G) break;
        __builtin_amdgcn_s_sleep(1);
        if ((++sp & 255u) == 0u) { if (xb_ld(&bar[XB_TMO])) break; if (sp > XB_SPIN_CAP) { atomicAdd(&bar[XB_TMO], 1u); break; } }
    }
    nloc = mine > 0u ? mine : 1u; nx = cnt > 0u ? cnt : 1u;
}

__device__ __forceinline__ void xcd_barrier(const XcdBarrier& b) {
    asm volatile("s_waitcnt vmcnt(0)" ::: "memory");
    __syncthreads();
    if (threadIdx.x == 0) {
        unsigned* bar = b.bar;
        __builtin_amdgcn_s_waitcnt(0);
        unsigned nloc = b.st[0], nx = b.st[1];
        if (nloc == 0u) { xcd_barrier_complete(bar, b.x, nloc, nx); b.st[0] = nloc; b.st[1] = nx; }
        const unsigned old = xb_add(&bar[XB_XSUB(b.x)], 1u);
        const unsigned gen = old / nloc;
        if (old + 1u == (gen + 1u) * nloc) {
            __builtin_amdgcn_fence(__ATOMIC_RELEASE, "agent");
            asm volatile("s_waitcnt vmcnt(0)" ::: "memory");
            const unsigned og = xb_add(&bar[XB_TOP], 1u);
            const unsigned tg = og / nx;
            if (og + 1u == (tg + 1u) * nx) xb_add(&bar[XB_TOPGEN], 1u);
            else XB_SPIN(xb_ld(&bar[XB_TOPGEN]) == tg, bar);
            __builtin_amdgcn_fence(__ATOMIC_ACQUIRE, "agent");
            xb_add(&bar[XB_XGEN(b.x)], 1u);
            asm volatile("s_waitcnt vmcnt(0)" ::: "memory");
        } else {
            XB_SPIN(xb_ld(&bar[XB_XGEN(b.x)]) == gen, bar);
            __builtin_amdgcn_fence(__ATOMIC_ACQUIRE, "agent");
            asm volatile("s_waitcnt vmcnt(0)" ::: "memory");
        }
    }
    __syncthreads();
}

__global__ void __launch_bounds__(NTHR, 2) fwd_kernel(Params p) {
    extern __shared__ __attribute__((aligned(16))) unsigned char lds_raw[];
    LAS unsigned char* lds = (LAS unsigned char*)lds_raw;
    const int tid = threadIdx.x, lane = tid & 63, wave = __builtin_amdgcn_readfirstlane(tid >> 6);
    const int G = gridDim.x, bx = blockIdx.x;
    const int gw = bx * NWAVES + wave, NGW = G * NWAVES;
    unsigned char* ws = p.ws;
    unsigned* ctl = MK_ONE_LAUNCH ? g_ctl : (unsigned*)(ws + WS_CTL);
    const int lo = p.ph_lo, hi = p.ph_hi;
    volatile LAS unsigned* bst = (volatile LAS unsigned*)(lds + 163808);
    if (tid == 0) { bst[0] = 0u; bst[1] = 0u; }
    __syncthreads();
    XcdBarrier bar; bar.bar = ctl + 1024; bar.x = 0; bar.st = bst;
    if (hi > lo) bar = xcd_barrier_post(ctl + 1024, bst);
    if (hi > 1000) cg::this_grid().sync();
#define IN(k) (lo <= (k) && (k) < hi)
#define SEAM(k) do { if (IN(k) && IN((k) + 1)) { xcd_barrier(bar); } } while (0)
    if (IN(0)) { if (bx == 0 && tid == 0) { ctl[0] = 0u; ctl[64] = 0u; }
        phase0(p, lds, gw, NGW, wave, lane); }
    SEAM(0);
    if (IN(1)) {
        pg8::Gemm g{(const bf16_t*)(ws + WS_HB), (const bf16_t*)(ws + WS_WIN), M, NPROJ, 2048}; pg8::StaticOrder S; S.init(M, NPROJ, G, bx);
        EpiProj E{(bf16_t*)(ws + WS_QLAT), (bf16_t*)(ws + WS_KVLAT), (float*)(ws + WS_SSQL), (bf16_t*)(ws + WS_PROJ), (bf16_t*)(ws + WS_VTD)};
        pg8::gemm_phase<EpiProj, pg8::StaticOrder, true, true>(lds, g, S, E);
    }
    SEAM(1);
    if (IN(3)) {
        p3_pre(p, lds, bx, G, tid, wave, lane);
        __syncthreads();
        { pg8::Gemm g{(const bf16_t*)(ws + WS_QLAT), (const bf16_t*)(ws + WS_WQ), 2 * M, 3584, 512}; StackedOrder S{G, bx};
          EpiQKv E{EpiPlain{(bf16_t*)(ws + WS_QF), 1536}, EpiKv{(bf16_t*)(ws + WS_KNOPE), (bf16_t*)(ws + WS_VTM), (const float*)(ws + WS_SSQL)}};
          pg8::gemm_phase<EpiQKv, StackedOrder, true, true>(lds, g, S, E); }
    }
    SEAM(3);
    if (IN(4)) phase4(p, gw, NGW, lane);
    SEAM(4);
    if (IN(5)) phase5(p, lds, ctl, tid, wave, lane);
    SEAM(5);
    if (IN(6)) {
        pg8::Gemm g{(const bf16_t*)(ws + WS_AO), (const bf16_t*)(ws + WS_WO), M, DM, 2048}; pg8::StaticOrder S; S.init(M, DM, G, bx);
        EpiWo E{p.in[0], p.out, (bf16_t*)(ws + WS_X1B), (float*)(ws + WS_SSQ)};
        pg8::gemm_phase<EpiWo, pg8::StaticOrder, true, true>(lds, g, S, E);
    }
    SEAM(6);
    if (IN(7)) {
        pg8::Gemm g{(const bf16_t*)(ws + WS_X1B), (const bf16_t*)(ws + WS_WGU), M, 2 * DFF, 2048}; pg8::StaticOrder S; S.init(M, 2 * DFF, G, bx);
        EpiGateUp E{(const float*)(ws + WS_SSQ), (bf16_t*)(ws + WS_HMID)};
        pg8::gemm_phase<EpiGateUp, pg8::StaticOrder, true, true>(lds, g, S, E);
        { const int nwg = (M / 256) * (2 * DFF / 256), rem = nwg % G;
          if (rem == 0) p0_convert(p, lds, P0_NITEMS - P0_ITEMS_WD, P0_NITEMS, gw, NGW, wave, lane);
          else if (bx >= rem) p0_convert(p, lds, P0_NITEMS - P0_ITEMS_WD, P0_NITEMS, (bx - rem) * NWAVES + wave, (G - rem) * NWAVES, wave, lane); }
    }
    SEAM(7);
    if (IN(8)) {
        pg8::Gemm g{(const bf16_t*)(ws + WS_HMID), (const bf16_t*)(ws + WS_WD), M, DM, DFF}; pg8::StaticOrder S; S.init(M, DM, G, bx);
        EpiDown E{(const bf16_t*)(ws + WS_X1B), p.out};
        pg8::gemm_phase<EpiDown, pg8::StaticOrder, true, true>(lds, g, S, E);
    }
#if MK_ONE_LAUNCH
    if (hi > lo) {
        LAS unsigned* shx = (LAS unsigned*)(lds + 163828);
        __syncthreads();
        if (tid == 0) { __threadfence(); shx[0] = (atomicAdd(&ctl[128], 1u) == (unsigned)(G - 1)) ? 1u : 0u; }
        __syncthreads();
        if (shx[0]) {
            unsigned* bw = ctl + 1024;
            if (tid < 16) { __hip_atomic_store(&bw[XB_XCNT(tid)], 0u, __ATOMIC_RELAXED, __HIP_MEMORY_SCOPE_AGENT); __hip_atomic_store(&bw[XB_XSUB(tid)], 0u, __ATOMIC_RELAXED, __HIP_MEMORY_SCOPE_AGENT);
                            __hip_atomic_store(&bw[XB_XGEN(tid)], 0u, __ATOMIC_RELAXED, __HIP_MEMORY_SCOPE_AGENT); }
            if (tid == 16) { __hip_atomic_store(&bw[XB_TMO], 0u, __ATOMIC_RELAXED, __HIP_MEMORY_SCOPE_AGENT); __hip_atomic_store(&bw[XB_TOP], 0u, __ATOMIC_RELAXED, __HIP_MEMORY_SCOPE_AGENT);
                             __hip_atomic_store(&bw[XB_TOPGEN], 0u, __ATOMIC_RELAXED, __HIP_MEMORY_SCOPE_AGENT);
                             __hip_atomic_store(&ctl[0], 0u, __ATOMIC_RELAXED, __HIP_MEMORY_SCOPE_AGENT); __hip_atomic_store(&ctl[64], 0u, __ATOMIC_RELAXED, __HIP_MEMORY_SCOPE_AGENT);
                             __hip_atomic_store(&ctl[128], 0u, __ATOMIC_RELAXED, __HIP_MEMORY_SCOPE_AGENT); }
        }
    }
#endif
#undef IN
#undef SEAM
}
}

extern "C" void kernel_launch(void* const* d_in, const int* in_sizes, int n_in, void* d_out, int out_size, void* d_ws, size_t ws_size, hipStream_t stream) {
    static int grid = 0;
    if (grid == 0) {
        if (n_in != 22 || out_size != mk::M * mk::DM || ws_size < mk::WS_END) { fprintf(stderr, "kernel_launch: unexpected shapes (n_in %d out %d ws %zu)\n", n_in, out_size, ws_size); grid = -1; return; }
        int dev = 0, cus = 0, per_cu = 0;
        if (hipGetDevice(&dev) != hipSuccess || hipDeviceGetAttribute(&cus, hipDeviceAttributeMultiprocessorCount, dev) != hipSuccess) { grid = -1; return; }
        if (hipFuncSetAttribute((const void*)mk::fwd_kernel, hipFuncAttributeMaxDynamicSharedMemorySize, mk::LDS_BYTES) != hipSuccess) { fprintf(stderr, "kernel_launch: hipFuncSetAttribute failed\n"); grid = -1; return; }
        if (hipOccupancyMaxActiveBlocksPerMultiprocessor(&per_cu, (const void*)mk::fwd_kernel, mk::NTHR, mk::LDS_BYTES) != hipSuccess || per_cu < 1) { fprintf(stderr, "kernel_launch: occupancy query says %d\n", per_cu); per_cu = 1; }
        (void)hipGetLastError();
        grid = cus * per_cu;
    }
    if (grid < 0) return;
#if !MK_ONE_LAUNCH
    if (hipMemsetAsync((char*)d_ws + mk::WS_CTL, 0, 32768, stream) != hipSuccess) { fprintf(stderr, "kernel_launch: hipMemsetAsync failed\n"); return; }
#endif
    mk::Params p{};
    for (int i = 0; i < 22; ++i) p.in[i] = (const float*)d_in[i];
    p.out = (float*)d_out; p.ws = (unsigned char*)d_ws;
#if MK_ONE_LAUNCH
    p.ph_lo = 0; p.ph_hi = 9;
    void* args[] = {&p};
    hipError_t e = hipLaunchCooperativeKernel((const void*)mk::fwd_kernel, dim3(grid), dim3(mk::NTHR), args, mk::LDS_BYTES, stream);
    if (e != hipSuccess) fprintf(stderr, "cooperative launch failed: %s (grid %d)\n", hipGetErrorString(e), grid);
#else
    for (int k = 0; k < 9; ++k) { p.ph_lo = k; p.ph_hi = k + 1; hipLaunchKernelGGL(mk::fwd_kernel, dim3(grid), dim3(mk::NTHR), mk::LDS_BYTES, stream, p); }
#endif
}
```
